# Optimizing an MI355X kernel written in HIP

```python
import math
import jax, jax.numpy as jnp
from jax import lax
import numpy as np

D_MODEL = 2048
BATCH = 2
SEQ = 4096
DEPTH = 1

N_META = 16
BLOCK = 128
EPS = 1e-6
ATT_HEADS = 8
ATT_SUB_DIM = 64
ATT_V_DIM = 2 * ATT_SUB_DIM
ATT_WIDTH = ATT_HEADS * 2 * ATT_SUB_DIM
ROPE_THETA = 10000.0
SSM_WIDTH = D_MODEL // 2
SSM_GROUP = 16
SSM_GROUPS = SSM_WIDTH // SSM_GROUP
SSM_STATE = 64
PEER_HEADS = 8
PEER_KEYS = 128
PEER_EXPERTS = PEER_KEYS * PEER_KEYS
PEER_QDIM = 256
PEER_HALF = PEER_QDIM // 2
PEER_TOPK = 16
IN_WIDTH = 3 * ATT_WIDTH + SSM_WIDTH + 2 * D_MODEL
IN_SPLITS = [ATT_WIDTH, 2 * ATT_WIDTH, 3 * ATT_WIDTH, 3 * ATT_WIDTH + SSM_WIDTH, 3 * ATT_WIDTH + SSM_WIDTH + D_MODEL]

kernel_name = "hybrid_diffattn_s5_peer_block"


def rms_norm(x, g):
    xf = x.astype(jnp.float32)
    y = xf * lax.rsqrt(jnp.mean(xf * xf, axis=-1, keepdims=True) + EPS)
    return (y * g.astype(jnp.float32)).astype(x.dtype)


def rotary(t, pos):
    half = t.shape[-1] // 2
    inv_freq = jnp.power(ROPE_THETA, -jnp.arange(half, dtype=jnp.float32) / half)
    ang = pos.astype(jnp.float32)[:, None] * inv_freq[None, :]
    cos = jnp.cos(ang)[:, None, None, :]
    sin = jnp.sin(ang)[:, None, None, :]
    tf = t.astype(jnp.float32)
    t1, t2 = tf[..., :half], tf[..., half:]
    return jnp.concatenate([t1 * cos - t2 * sin, t2 * cos + t1 * sin], axis=-1).astype(t.dtype)


def diff_attention(q, k, v, lam):
    B, Lp = q.shape[0], q.shape[1]
    nb = Lp // BLOCK
    scale = ATT_SUB_DIM ** -0.5
    qb = q.reshape(B, nb, BLOCK, ATT_HEADS, 2, ATT_SUB_DIM).transpose(1, 0, 2, 3, 4, 5)
    kpos = jnp.arange(Lp)

    def one_block(args):
        qi, i = args
        s = jnp.einsum('bqhcd,bkhcd->bhcqk', qi, k, preferred_element_type=jnp.float32) * scale
        qpos = i * BLOCK + jnp.arange(BLOCK)
        mask = kpos[None, :] <= qpos[:, None]
        s = jnp.where(mask, s, -1e30)
        p = jax.nn.softmax(s, axis=-1)
        w = p[:, :, 0] - lam * p[:, :, 1]
        return jnp.einsum('bhqk,bkhd->bqhd', w.astype(v.dtype), v)

    out = lax.map(one_block, (qb, jnp.arange(nb)))
    return out.transpose(1, 0, 2, 3, 4).reshape(B, Lp, ATT_HEADS, ATT_V_DIM)


def s5_ssm(u, a_re, a_im, log_dt, b_re, b_im, c_re, c_im, d_skip):
    B, L = u.shape[0], u.shape[1]
    uf = u.astype(jnp.float32).reshape(B, L, SSM_GROUPS, SSM_GROUP)
    lam = lax.complex(a_re.astype(jnp.float32), a_im.astype(jnp.float32))
    dt = jnp.exp(log_dt.astype(jnp.float32))[:, None]
    a_bar = jnp.exp(lam * dt)
    b = lax.complex(b_re.astype(jnp.float32), b_im.astype(jnp.float32))
    b_bar = ((a_bar - 1.0) / lam)[..., None] * b
    bu = jnp.einsum('gpc,blgc->blgp', b_bar, uf.astype(jnp.complex64))
    a_elems = jnp.broadcast_to(a_bar, bu.shape)

    def combine(e1, e2):
        a1, s1 = e1
        a2, s2 = e2
        return a1 * a2, a2 * s1 + s2

    _, states = lax.associative_scan(combine, (a_elems, bu), axis=1)
    c = lax.complex(c_re.astype(jnp.float32), c_im.astype(jnp.float32))
    y = jnp.einsum('gcp,blgp->blgc', c, states).real.reshape(B, L, SSM_WIDTH)
    y = y + d_skip.astype(jnp.float32) * u.astype(jnp.float32)
    return y.astype(u.dtype)


def peer(h, w_q, sub_k1, sub_k2, u_emb, v_emb):
    B, L, D = h.shape
    q = (h @ w_q).reshape(B, L, PEER_HEADS, 2, PEER_HALF)
    s1 = jnp.einsum('blhd,hnd->blhn', q[..., 0, :], sub_k1, preferred_element_type=jnp.float32)
    s2 = jnp.einsum('blhd,hnd->blhn', q[..., 1, :], sub_k2, preferred_element_type=jnp.float32)
    v1, i1 = lax.top_k(s1, PEER_TOPK)
    v2, i2 = lax.top_k(s2, PEER_TOPK)
    cand = (v1[..., :, None] + v2[..., None, :]).reshape(B, L, PEER_HEADS, PEER_TOPK * PEER_TOPK)
    cand_idx = (i1[..., :, None] * PEER_KEYS + i2[..., None, :]).reshape(B, L, PEER_HEADS, PEER_TOPK * PEER_TOPK)
    vals, sel = lax.top_k(cand, PEER_TOPK)
    idx = jnp.take_along_axis(cand_idx, sel, axis=-1)
    g = jax.nn.softmax(vals, axis=-1)
    T = B * L
    nb = T // BLOCK
    hb = h.reshape(nb, BLOCK, D)
    ib = idx.reshape(nb, BLOCK, PEER_HEADS * PEER_TOPK)
    gb = g.reshape(nb, BLOCK, PEER_HEADS * PEER_TOPK).astype(h.dtype)

    def one_block(args):
        hi, ii, gi = args
        u = u_emb[ii]
        a = jnp.einsum('td,tkd->tk', hi, u)
        w = gi * jax.nn.gelu(a, approximate=False)
        return jnp.einsum('tk,tkd->td', w, v_emb[ii])

    out = lax.map(one_block, (hb, ib, gb))
    return out.reshape(B, L, D)


def setup_inputs(seed: int = 0) -> dict:
    key = jax.random.key(seed)
    ks = jax.random.split(key, 32)
    f32 = jnp.float32
    nrm = lambda k, shape, s: jax.random.normal(k, shape, f32) * s
    gain = lambda k, shape: 1.0 + 0.01 * jax.random.normal(k, shape, f32)
    Dp = DEPTH
    a_im_base = jnp.pi * jnp.arange(SSM_STATE, dtype=f32)
    return {
        "x": nrm(ks[0], (BATCH, SEQ, D_MODEL), 1.0),
        "meta_tokens": nrm(ks[1], (N_META, D_MODEL), 1.0),
        "norm1_g": gain(ks[2], (Dp, D_MODEL)),
        "w_in": nrm(ks[3], (Dp, D_MODEL, IN_WIDTH), D_MODEL ** -0.5),
        "q_norm_g": gain(ks[4], (Dp, ATT_SUB_DIM)),
        "k_norm_g": gain(ks[5], (Dp, ATT_SUB_DIM)),
        "lambda_q1": nrm(ks[6], (Dp, ATT_SUB_DIM), 0.1),
        "lambda_k1": nrm(ks[7], (Dp, ATT_SUB_DIM), 0.1),
        "lambda_q2": nrm(ks[8], (Dp, ATT_SUB_DIM), 0.1),
        "lambda_k2": nrm(ks[9], (Dp, ATT_SUB_DIM), 0.1),
        "subln_g": gain(ks[10], (Dp, ATT_V_DIM)),
        "w_attn_branch": nrm(ks[11], (Dp, ATT_WIDTH, D_MODEL), ATT_WIDTH ** -0.5),
        "ssm_a_re": -0.5 + 0.01 * jax.random.normal(ks[12], (Dp, SSM_GROUPS, SSM_STATE), f32),
        "ssm_a_im": a_im_base + 0.01 * jax.random.normal(ks[13], (Dp, SSM_GROUPS, SSM_STATE), f32),
        "ssm_log_dt": jax.random.uniform(ks[14], (Dp, SSM_GROUPS), f32, math.log(0.001), math.log(0.1)),
        "ssm_b_re": nrm(ks[15], (Dp, SSM_GROUPS, SSM_STATE, SSM_GROUP), (2 * SSM_GROUP) ** -0.5),
        "ssm_b_im": nrm(ks[16], (Dp, SSM_GROUPS, SSM_STATE, SSM_GROUP), (2 * SSM_GROUP) ** -0.5),
        "ssm_c_re": nrm(ks[17], (Dp, SSM_GROUPS, SSM_GROUP, SSM_STATE), (2 * SSM_STATE) ** -0.5),
        "ssm_c_im": nrm(ks[18], (Dp, SSM_GROUPS, SSM_GROUP, SSM_STATE), (2 * SSM_STATE) ** -0.5),
        "ssm_d": nrm(ks[19], (Dp, SSM_WIDTH), 1.0),
        "w_glu": nrm(ks[20], (Dp, SSM_WIDTH, 2 * D_MODEL), SSM_WIDTH ** -0.5),
        "w_out": nrm(ks[21], (Dp, D_MODEL, D_MODEL), D_MODEL ** -0.5),
        "norm2_g": gain(ks[22], (Dp, D_MODEL)),
        "peer_w_q": nrm(ks[23], (Dp, D_MODEL, PEER_HEADS * PEER_QDIM), D_MODEL ** -0.5),
        "peer_k1": nrm(ks[24], (Dp, PEER_HEADS, PEER_KEYS, PEER_HALF), PEER_HALF ** -0.5),
        "peer_k2": nrm(ks[25], (Dp, PEER_HEADS, PEER_KEYS, PEER_HALF), PEER_HALF ** -0.5),
        "peer_u": nrm(ks[26], (Dp, PEER_EXPERTS, D_MODEL), D_MODEL ** -0.5),
        "peer_v": nrm(ks[27], (Dp, PEER_EXPERTS, D_MODEL), PEER_HEADS ** -0.5),
    }


def reference(x, meta_tokens, norm1_g, w_in, q_norm_g, k_norm_g, lambda_q1, lambda_k1, lambda_q2, lambda_k2,
              subln_g, w_attn_branch, ssm_a_re, ssm_a_im, ssm_log_dt, ssm_b_re, ssm_b_im, ssm_c_re, ssm_c_im,
              ssm_d, w_glu, w_out, norm2_g, peer_w_q, peer_k1, peer_k2, peer_u, peer_v):
    B, S = x.shape[0], x.shape[1]
    Lp = -(-(S + N_META) // BLOCK) * BLOCK
    meta = jnp.broadcast_to(meta_tokens.astype(x.dtype)[None], (B, N_META, D_MODEL))
    pad = jnp.zeros((B, Lp - S - N_META, D_MODEL), x.dtype)
    h = jnp.concatenate([meta, x, pad], axis=1)
    pos = jnp.arange(Lp)
    for l in range(DEPTH):
        lam_init = 0.8 - 0.6 * math.exp(-0.3 * l)
        hn = rms_norm(h, norm1_g[l])
        proj = hn @ w_in[l]
        q, k, v, u, gate_a, gate_b = jnp.split(proj, IN_SPLITS, axis=-1)
        q = q.reshape(B, Lp, ATT_HEADS, 2, ATT_SUB_DIM)
        k = k.reshape(B, Lp, ATT_HEADS, 2, ATT_SUB_DIM)
        v = v.reshape(B, Lp, ATT_HEADS, ATT_V_DIM)
        q = rotary(rms_norm(q, q_norm_g[l]), pos)
        k = rotary(rms_norm(k, k_norm_g[l]), pos)
        lam = (jnp.exp(jnp.sum(lambda_q1[l].astype(jnp.float32) * lambda_k1[l].astype(jnp.float32)))
               - jnp.exp(jnp.sum(lambda_q2[l].astype(jnp.float32) * lambda_k2[l].astype(jnp.float32)))
               + lam_init)
        att = diff_attention(q, k, v, lam)
        att = rms_norm(att, subln_g[l]) * (1.0 - lam_init)
        y_a = att.reshape(B, Lp, ATT_WIDTH) @ w_attn_branch[l]
        y_s = s5_ssm(u, ssm_a_re[l], ssm_a_im[l], ssm_log_dt[l], ssm_b_re[l], ssm_b_im[l],
                     ssm_c_re[l], ssm_c_im[l], ssm_d[l])
        glu = jax.nn.gelu(y_s, approximate=False) @ w_glu[l]
        y_b = glu[..., :D_MODEL] * jax.nn.sigmoid(glu[..., D_MODEL:])
        mix = jax.nn.sigmoid(gate_a) * y_a + jax.nn.sigmoid(gate_b) * y_b
        h = h + mix @ w_out[l]
        h = h + peer(rms_norm(h, norm2_g[l]), peer_w_q[l], peer_k1[l], peer_k2[l], peer_u[l], peer_v[l])
    return h[:, N_META:N_META + S]
```

```cpp
#include <hip/hip_runtime.h>
#include <hip/hip_cooperative_groups.h>
#include <cstdio>
#include <cstdint>
namespace cg = cooperative_groups;

#ifndef GEMM_SP2
#define GEMM_SP2 true
#endif
#ifndef MK_SINGLE
#define MK_SINGLE 1
#endif

#define LAS __attribute__((address_space(3)))
typedef unsigned short bf16_t;
typedef short bf16x8 __attribute__((ext_vector_type(8)));
typedef float f32x4 __attribute__((ext_vector_type(4)));
typedef float f32x2 __attribute__((ext_vector_type(2)));
typedef unsigned u32x4 __attribute__((ext_vector_type(4)));
typedef int i32x4 __attribute__((ext_vector_type(4)));
typedef unsigned u32x2 __attribute__((ext_vector_type(2)));
typedef __bf16 bf16x2_t __attribute__((ext_vector_type(2)));

constexpr int DM = 2048, SEQ = 4096, NMETA = 16, MTOK = 2 * SEQ, NPOS = SEQ + NMETA;
constexpr int AW = 1024, SW = 1024, INW = 8192;
constexpr float EPS = 1e-6f;
constexpr float LOG2E = 1.4426950408889634f;
constexpr float QSCALE = 0.125f * LOG2E;
constexpr float LAM_INIT = 0.2f;
constexpr int NEXP = 16384;

constexpr size_t MiB = 1u << 20;
constexpr size_t WS_CTL = 0;
constexpr size_t WS_WTIN = 1 * MiB;
constexpr size_t WS_WTATT = WS_WTIN + 32 * MiB;
constexpr size_t WS_WTGLU = WS_WTATT + 4 * MiB;
constexpr size_t WS_WTOUT = WS_WTGLU + 8 * MiB;
constexpr size_t WS_WTQ = WS_WTOUT + 8 * MiB;
constexpr size_t WS_UE = WS_WTQ + 8 * MiB;
constexpr size_t WS_VE = WS_UE + 64 * MiB;
constexpr size_t WS_XN = WS_VE + 64 * MiB;
constexpr size_t WS_Q = WS_XN + 32 * MiB;
constexpr size_t WS_K = WS_Q + 16 * MiB;
constexpr size_t WS_V = WS_K + 16 * MiB;
constexpr size_t WS_MIX = WS_Q;
constexpr size_t WS_U = WS_V + 16 * MiB;
constexpr size_t WS_QP = WS_U;
constexpr size_t WS_GA = WS_U + 32 * MiB;
constexpr size_t WS_GB = WS_GA + 32 * MiB;
constexpr size_t WS_ATT = WS_GB + 32 * MiB;
constexpr size_t WS_YS = WS_ATT + 16 * MiB;
constexpr size_t WS_YB = WS_YS + 16 * MiB;
constexpr size_t WS_IDX = WS_YB + 32 * MiB;
constexpr size_t WS_GW = WS_IDX + 4 * MiB;
constexpr size_t WS_MISC = WS_GW + 4 * MiB;
constexpr size_t WS_PARTSS = WS_MISC;
constexpr size_t WS_CS = WS_PARTSS + 1 * MiB;
constexpr size_t WS_MPART = WS_CS + 2 * MiB;
constexpr size_t WS_KM = WS_MPART + 2 * MiB;
constexpr size_t WS_VM = WS_KM + 128 * 1024;
constexpr size_t WS_UM = WS_VM + 128 * 1024;
constexpr size_t WS_ABAR = WS_UM + 64 * 1024;
constexpr size_t WS_BBAR = WS_ABAR + 32 * 1024;
constexpr size_t WS_PAR = WS_BBAR + 512 * 1024;
constexpr size_t WS_SU = WS_PAR + 64 * 1024;
constexpr size_t WS_SV = WS_SU + 64 * 1024;
constexpr size_t WS_K12 = WS_SV + 64 * 1024;
constexpr size_t WS_UMB = WS_K12 + 512 * 1024;
constexpr size_t WS_UB = WS_UMB + 64 * 1024;
constexpr size_t WS_HT = WS_UB + 16 * MiB;
constexpr size_t WS_MP32 = WS_HT + 64 * 1024;
constexpr size_t WS_SXA = WS_MP32 + 6 * MiB;
constexpr size_t WS_SWB = WS_SXA + 64 * 1024;
constexpr size_t WS_SWQ = WS_SWB + 64 * 1024;
constexpr size_t WS_SWG = WS_SWQ + 64 * 1024;
constexpr size_t WS_SWA = WS_SWG + 64 * 1024;
constexpr size_t WS_SWO = WS_SWA + 64 * 1024;
constexpr size_t WS_SYS = WS_SWO + 64 * 1024;
constexpr size_t WS_SAT = WS_SYS + 64 * 1024;
constexpr size_t WS_SMX = WS_SAT + 64 * 1024;
constexpr size_t WS_END = WS_SMX + 64 * 1024;
constexpr size_t WS_YS8 = WS_V;
constexpr size_t WS_AT8 = WS_V + 8 * MiB;
constexpr size_t WS_MIX8 = WS_V;
constexpr size_t WS_HQ = WS_ATT;
constexpr size_t WS_APART = WS_Q;
constexpr size_t WS_H2 = WS_GA;

__device__ __forceinline__ unsigned f2bf(float f) { unsigned u = __builtin_bit_cast(unsigned, f); return (u + 0x7fffu + ((u >> 16) & 1u)) >> 16; }
__device__ __forceinline__ unsigned pk2(float lo, float hi) { return f2bf(lo) | (f2bf(hi) << 16); }
__device__ __forceinline__ float bf2f(unsigned short h) { return __builtin_bit_cast(float, (unsigned)h << 16); }
__device__ __forceinline__ float bflo(unsigned w) { return __builtin_bit_cast(float, w << 16); }
__device__ __forceinline__ float bfhi(unsigned w) { return __builtin_bit_cast(float, w & 0xffff0000u); }
__device__ __forceinline__ int otid() { int t = threadIdx.x; asm volatile("" : "+v"(t)); return t; }
template <int CTRL> __device__ __forceinline__ float dpp_f(float v) { return __builtin_bit_cast(float, __builtin_amdgcn_update_dpp(0, __builtin_bit_cast(int, v), CTRL, 0xF, 0xF, true)); }
__device__ __forceinline__ float row_sum16(float v) { v += dpp_f<0x128>(v); v += dpp_f<0x124>(v); v += dpp_f<0x122>(v); v += dpp_f<0x121>(v); return v; }
__device__ __forceinline__ float wave_sum(float v) { v = row_sum16(v); v += __shfl_xor(v, 16); v += __shfl_xor(v, 32); return v; }
__device__ __forceinline__ float wave_max(float v) {
#pragma unroll
    for (int o = 1; o < 64; o <<= 1) v = fmaxf(v, __shfl_xor(v, o));
    return v;
}
__device__ __forceinline__ float sigmoidf_(float x) { return __builtin_amdgcn_rcpf(1.0f + __builtin_amdgcn_exp2f(x * -1.4426950408889634f)); }
__device__ __forceinline__ float gelu_exact(float x) { return 0.5f * x * (1.0f + erff(x * 0.70710678118654752f)); }
__device__ __forceinline__ float dot2bf(unsigned a, unsigned b, float acc) { return __builtin_amdgcn_fdot2_f32_bf16(__builtin_bit_cast(bf16x2_t, a), __builtin_bit_cast(bf16x2_t, b), acc, false); }

namespace pg8 {
#define PG8_LAS __attribute__((address_space(3)))
constexpr int BM = 256, BK = 64, HALF = 128, HTB = HALF * BK * 2, STAGE_BYTES = 8 * HTB, NXCD = 8, WGM = 8;
__host__ __device__ __forceinline__ int lds_byte(int r, int c) { const int st = (r >> 4) * 2 + (c >> 5), rr = r & 15, cc = c & 31, ob = rr * 64 + cc * 2; return st * 1024 + (ob ^ (((ob >> 9) & 1) << 5)); }
__host__ __device__ __forceinline__ void stage_rc(int b, int& R, int& C) { const int st = b / 1024, sb = b % 1024, swz = sb ^ (((sb >> 9) & 1) << 5); R = (st >> 1) * 16 + swz / 64; C = (st & 1) * 32 + (swz % 64) / 2; }
__host__ __device__ __forceinline__ int perm32(int rho) { const int n = rho >> 4, i = rho & 15; return 8 * (i >> 2) + 4 * n + (i & 3); }
struct Unit { int pm, pn, sel; };
struct Gemm { const bf16_t* A; const bf16_t* Bt; int M, N, K; const bf16_t* A2 = nullptr; const bf16_t* Bt2 = nullptr; const float* sa = nullptr; const float* sb = nullptr; const float* sa2 = nullptr; const float* sb2 = nullptr; };
struct StaticOrder {
    int nM, nN, nwg, G, c;
    __host__ __device__ __forceinline__ void init(int M, int N, int G_, int c_) { nM = M / BM; nN = N / BM; nwg = nM * nN; G = G_; c = c_; }
    __host__ __device__ __forceinline__ bool next(int i, Unit& u) const {
        const long L = (long)i * G + c; if (L >= nwg) return false;
        int wgid = (int)L; { const int q = nwg / NXCD, r = nwg % NXCD, xcd = wgid % NXCD, off = wgid / NXCD; wgid = (xcd < r ? xcd * (q + 1) : r * (q + 1) + (xcd - r) * q) + off; }
        const int nig = WGM * nN, gid = wgid / nig, fm = gid * WGM, gsz = (nM - fm) < WGM ? (nM - fm) : WGM;
        u.pm = fm + ((wgid % nig) % gsz); u.pn = (wgid % nig) / gsz; u.sel = 0; return true;
    }
    __device__ __forceinline__ void a_ready(const Unit&) const {}
    __device__ __forceinline__ void done(const Unit&) const {}
};
struct GluOrder {
    StaticOrder base;
    __device__ __forceinline__ bool next(int i, Unit& u) const { Unit b; if (!base.next(i >> 1, b)) return false; u.pm = b.pm; u.pn = 2 * b.pn + (i & 1); u.sel = 0; return true; }
    __device__ __forceinline__ void a_ready(const Unit&) const {}
    __device__ __forceinline__ void done(const Unit&) const {}
};

struct P3Order {
    StaticOrder base;
    __device__ __forceinline__ bool next(int i, Unit& u) const { Unit b; const int r = i / 3, j = i - 3 * r; if (!base.next(r, b)) return false;
        u.pm = b.pm; u.pn = (j < 2) ? 2 * b.pn + j : b.pn; u.sel = (j == 2) ? 1 : 0; return true; }
    __device__ __forceinline__ void a_ready(const Unit&) const {}
    __device__ __forceinline__ void done(const Unit&) const {}
};
template <class Epi, class Sched, bool ALIGN_EPI = false, bool SP2 = false>
__device__ __forceinline__ void gemm_phase(PG8_LAS unsigned char* lds, const Gemm g, const Sched& S, const Epi& E) {
    const int tid = threadIdx.x, wid = __builtin_amdgcn_readfirstlane(tid >> 6), lane = tid & 63, wr = wid >> 2, wc = wid & 3, fr = lane & 15, fq = lane >> 4;
    const int K = g.K, nt = K / BK;
    unsigned voffA[2], voffB[2];
#pragma unroll
    for (int i = 0; i < 2; ++i) { int R, C; stage_rc(tid * 16 + i * 8192, R, C); const int Rb = Epi::PERM ? ((R & ~31) + perm32(R & 31)) : R;
        voffA[i] = (unsigned)(R * K + C) * 2u; voffB[i] = (unsigned)(Rb * K + C) * 2u; }
    const size_t kstep = (size_t)(BK * 2);
    const size_t hstep = (size_t)HALF * K * 2;
    const size_t tstep = 2 * hstep;
    const unsigned ldsw = (unsigned)wid * 1024u;
    const int aoff = lds_byte(wr * 64 + fr, fq * 8), boff = lds_byte(wc * 32 + fr, fq * 8);
#define PG8_SA(b, h) (((b) * 2 + (h)) * HTB)
#define PG8_SB(b, h) ((4 + (b) * 2 + (h)) * HTB)
#define PG8_STAGE(bufoff, gbase, voff) do { _Pragma("unroll") for (int _i = 0; _i < 2; ++_i) \
        __builtin_amdgcn_global_load_lds((const unsigned*)((const char*)(gbase) + (voff)[_i]), (PG8_LAS unsigned*)(lds + (bufoff) + ldsw + _i * 8192), 16, 0, 0); } while (0)
#define PG8_LDA(dst, b, h) do { _Pragma("unroll") for (int m = 0; m < 4; ++m) _Pragma("unroll") for (int k = 0; k < 2; ++k) dst[m][k] = *(const PG8_LAS bf16x8*)(lds + PG8_SA(b, h) + aoff + m * 2048 + k * 1024); } while (0)
#define PG8_LDB(dst, b, h) do { _Pragma("unroll") for (int n = 0; n < 2; ++n) _Pragma("unroll") for (int k = 0; k < 2; ++k) dst[n][k] = *(const PG8_LAS bf16x8*)(lds + PG8_SB(b, h) + boff + n * 2048 + k * 1024); } while (0)
#define PG8_MMA(ai, bj, At, Bt) do { __builtin_amdgcn_s_setprio(1); _Pragma("unroll") for (int m = 0; m < 4; ++m) _Pragma("unroll") for (int n = 0; n < 2; ++n) _Pragma("unroll") for (int k = 0; k < 2; ++k) \
        { if constexpr (Epi::I8) acc[ai][bj][m][n] = __builtin_bit_cast(f32x4, __builtin_amdgcn_mfma_i32_16x16x64_i8(__builtin_bit_cast(i32x4, Bt[n][k]), __builtin_bit_cast(i32x4, At[m][k]), __builtin_bit_cast(i32x4, acc[ai][bj][m][n]), 0, 0, 0)); \
          else acc[ai][bj][m][n] = __builtin_amdgcn_mfma_f32_16x16x32_bf16(Bt[n][k], At[m][k], acc[ai][bj][m][n], 0, 0, 0); } __builtin_amdgcn_s_setprio(0); } while (0)
#define PG8_WAIT_V(n) asm volatile("s_waitcnt vmcnt(" #n ")" ::: "memory")
#define PG8_WAIT_L(n) asm volatile("s_waitcnt lgkmcnt(" #n ")" ::: "memory")
#define PG8_BAR __builtin_amdgcn_s_barrier()
#define PG8_SCHED __builtin_amdgcn_sched_barrier(0)
    Unit cur, nxt; int ui = 0;
    if (!S.next(0, cur)) return;
    f32x4 acc[2][2][4][2];
#pragma unroll
    for (int a = 0; a < 2; ++a)
#pragma unroll
        for (int b = 0; b < 2; ++b)
#pragma unroll
            for (int m = 0; m < 4; ++m)
#pragma unroll
                for (int n = 0; n < 2; ++n) acc[a][b][m][n] = (f32x4){0.f, 0.f, 0.f, 0.f};
    bf16x8 At[4][2], B0[2][2], B1[2][2];
    const char* cA = (const char*)(cur.sel ? g.A2 : g.A) + (size_t)cur.pm * tstep; const char* cB = (const char*)(cur.sel ? g.Bt2 : g.Bt) + (size_t)cur.pn * tstep;
    S.a_ready(cur);
    if constexpr (SP2) {
        PG8_STAGE(PG8_SB(0, 0), cB, voffB); PG8_STAGE(PG8_SB(0, 1), cB + hstep, voffB); PG8_STAGE(PG8_SA(0, 0), cA, voffA); PG8_STAGE(PG8_SA(0, 1), cA + hstep, voffA);
        if (wr == 1) PG8_BAR;
        PG8_WAIT_V(2); PG8_BAR;
        PG8_STAGE(PG8_SB(1, 0), cB + kstep, voffB); PG8_STAGE(PG8_SA(1, 0), cA + kstep, voffA); PG8_STAGE(PG8_SB(1, 1), cB + hstep + kstep, voffB);
        PG8_WAIT_V(6); PG8_BAR;
    } else {
        PG8_STAGE(PG8_SB(0, 0), cB, voffB); PG8_STAGE(PG8_SA(0, 0), cA, voffA); PG8_STAGE(PG8_SB(0, 1), cB + hstep, voffB); PG8_STAGE(PG8_SA(0, 1), cA + hstep, voffA);
        if (wr == 1) PG8_BAR;
        PG8_WAIT_V(4); PG8_BAR;
        PG8_STAGE(PG8_SB(1, 0), cB + kstep, voffB); PG8_STAGE(PG8_SA(1, 0), cA + kstep, voffA); PG8_STAGE(PG8_SB(1, 1), cB + hstep + kstep, voffB);
        PG8_WAIT_V(6); PG8_BAR;
    }
    for (;;) {
        const bool has_next = S.next(ui + 1, nxt);
        const char* nA = has_next ? (const char*)(nxt.sel ? g.A2 : g.A) + (size_t)nxt.pm * tstep : cA; const char* nB = has_next ? (const char*)(nxt.sel ? g.Bt2 : g.Bt) + (size_t)nxt.pn * tstep : cB;
        for (int t = 0; t < nt; t += 2) {
            const bool last = (t == nt - 2);
            const char* a1 = cA + (size_t)(t + 1) * kstep;
            const char* a2 = last ? nA : cA + (size_t)(t + 2) * kstep; const char* b2 = last ? nB : cB + (size_t)(t + 2) * kstep;
            const char* a3 = a2 + kstep; const char* b3 = b2 + kstep;
            if (last && has_next) S.a_ready(nxt);
            if constexpr (SP2) {
            PG8_LDB(B0, 0, 0); PG8_LDB(B1, 0, 1); PG8_SCHED; PG8_LDA(At, 0, 0); PG8_STAGE(PG8_SA(1, 1), a1 + hstep, voffA);
            PG8_WAIT_V(8); PG8_WAIT_L(0); PG8_BAR; PG8_MMA(0, 0, At, B0); PG8_MMA(0, 1, At, B1); PG8_BAR; PG8_SCHED;
            PG8_LDA(At, 0, 1); PG8_STAGE(PG8_SB(0, 0), b2, voffB); PG8_STAGE(PG8_SB(0, 1), b2 + hstep, voffB); PG8_STAGE(PG8_SA(0, 0), a2, voffA);
            PG8_WAIT_V(8); PG8_WAIT_L(0); PG8_BAR; PG8_MMA(1, 0, At, B0); PG8_MMA(1, 1, At, B1); PG8_BAR; PG8_SCHED;
            PG8_LDB(B0, 1, 0); PG8_LDB(B1, 1, 1); PG8_SCHED; PG8_LDA(At, 1, 0); PG8_STAGE(PG8_SA(0, 1), a2 + hstep, voffA);
            PG8_WAIT_V(8); PG8_WAIT_L(0); PG8_BAR; PG8_MMA(0, 0, At, B0); PG8_MMA(0, 1, At, B1); PG8_BAR; PG8_SCHED;
            PG8_LDA(At, 1, 1); PG8_STAGE(PG8_SB(1, 0), b3, voffB); PG8_STAGE(PG8_SB(1, 1), b3 + hstep, voffB); PG8_STAGE(PG8_SA(1, 0), a3, voffA);
            PG8_WAIT_V(8); PG8_WAIT_L(0); PG8_BAR; PG8_MMA(1, 0, At, B0); PG8_MMA(1, 1, At, B1); PG8_BAR; PG8_SCHED;
            } else {
            PG8_LDB(B0, 0, 0); PG8_SCHED; PG8_LDA(At, 0, 0); PG8_STAGE(PG8_SA(1, 1), a1 + hstep, voffA);
            PG8_WAIT_L(8); PG8_BAR; PG8_WAIT_L(0); PG8_MMA(0, 0, At, B0); PG8_BAR; PG8_SCHED;
            PG8_LDB(B1, 0, 1); PG8_STAGE(PG8_SB(0, 0), b2, voffB);
            PG8_BAR; PG8_WAIT_L(0); PG8_MMA(0, 1, At, B1); PG8_BAR;
            PG8_LDA(At, 0, 1); PG8_STAGE(PG8_SA(0, 0), a2, voffA);
            PG8_BAR; PG8_WAIT_L(0); PG8_MMA(1, 0, At, B0); PG8_BAR; PG8_SCHED;
            PG8_STAGE(PG8_SB(0, 1), b2 + hstep, voffB);
            PG8_WAIT_V(6); PG8_BAR; PG8_MMA(1, 1, At, B1); PG8_BAR;
            PG8_LDB(B0, 1, 0); PG8_SCHED; PG8_LDA(At, 1, 0); PG8_STAGE(PG8_SA(0, 1), a2 + hstep, voffA);
            PG8_WAIT_L(8); PG8_BAR; PG8_WAIT_L(0); PG8_MMA(0, 0, At, B0); PG8_BAR; PG8_SCHED;
            PG8_LDB(B1, 1, 1); PG8_STAGE(PG8_SB(1, 0), b3, voffB);
            PG8_BAR; PG8_WAIT_L(0); PG8_MMA(0, 1, At, B1); PG8_BAR;
            PG8_LDA(At, 1, 1); PG8_STAGE(PG8_SA(1, 0), a3, voffA);
            PG8_BAR; PG8_WAIT_L(0); PG8_MMA(1, 0, At, B0); PG8_BAR; PG8_SCHED;
            PG8_STAGE(PG8_SB(1, 1), b3 + hstep, voffB);
            PG8_WAIT_V(6); PG8_BAR; PG8_MMA(1, 1, At, B1); PG8_BAR;
            }
        }
        if constexpr (ALIGN_EPI) { if (wr == 0) PG8_BAR; }
        if constexpr (Epi::I8) {
            int ln_ = (int)__builtin_amdgcn_mbcnt_hi(~0u, __builtin_amdgcn_mbcnt_lo(~0u, 0u)); asm volatile("" : "+v"(ln_));
            const int fr_ = ln_ & 15, fq_ = ln_ >> 4;
            float sxr[2][4];
#pragma unroll
            for (int ai = 0; ai < 2; ++ai)
#pragma unroll
                for (int m = 0; m < 4; ++m) sxr[ai][m] = (cur.sel ? g.sa2 : g.sa)[cur.pm * 256 + ai * 128 + wr * 64 + m * 16 + fr_];
#pragma unroll
            for (int bj = 0; bj < 2; ++bj)
#pragma unroll
                for (int n = 0; n < 2; ++n) { const f32x4 swv = *(const f32x4*)((cur.sel ? g.sb2 : g.sb) + cur.pn * 256 + bj * 128 + wc * 32 + 8 * fq_ + 4 * n);
#pragma unroll
                    for (int ai = 0; ai < 2; ++ai)
#pragma unroll
                        for (int m = 0; m < 4; ++m) { const i32x4 iv = __builtin_bit_cast(i32x4, acc[ai][bj][m][n]);
                            acc[ai][bj][m][n] = (f32x4){(float)iv[0], (float)iv[1], (float)iv[2], (float)iv[3]} * sxr[ai][m] * swv; } }
            if constexpr (Epi::OPQ) E(acc, cur, wr, wc, fr_, fq_);
            else E(acc, cur, wr, wc, fr, fq);
        } else
        E(acc, cur, wr, wc, fr, fq);
        S.done(cur);
        if (!has_next) break;
#pragma unroll
        for (int a = 0; a < 2; ++a)
#pragma unroll
            for (int b = 0; b < 2; ++b)
#pragma unroll
                for (int m = 0; m < 4; ++m)
#pragma unroll
                    for (int n = 0; n < 2; ++n) acc[a][b][m][n] = (f32x4){0.f, 0.f, 0.f, 0.f};
        cur = nxt; cA = nA; cB = nB; ++ui;
        if constexpr (ALIGN_EPI) { if (wr == 1) PG8_BAR; }
    }
    PG8_WAIT_V(0);
    if constexpr (!ALIGN_EPI) { if (wr == 0) PG8_BAR; }
    PG8_BAR;
#undef PG8_SA
#undef PG8_SB
#undef PG8_STAGE
#undef PG8_LDA
#undef PG8_LDB
#undef PG8_MMA
#undef PG8_WAIT_V
#undef PG8_WAIT_L
#undef PG8_BAR
#undef PG8_SCHED
}
}
using pg8::Unit;

__device__ __forceinline__ u32x4 pack8(const f32x4 a, const f32x4 b) { u32x4 w; w.x = pk2(a[0], a[1]); w.y = pk2(a[2], a[3]); w.z = pk2(b[0], b[1]); w.w = pk2(b[2], b[3]); return w; }

struct Epi1 {
    static constexpr bool PERM = true; static constexpr bool I8 = true; static constexpr bool OPQ = true;
    bf16_t *Q, *K, *V, *GA, *GB; float* U; const float* cs; const float *gq, *gk; bf16_t* UB;
    __device__ __forceinline__ void operator()(const f32x4 (&acc)[2][2][4][2], const Unit& u, int wr, int wc, int fr, int fq) const {
        const int type = u.pn >> 2;
        const int row0 = u.pm * 256 + wr * 64 + fr;
        if (type <= 1) {
            const int sh = (u.pn & 3) * 4 + wc;
            bf16_t* dst = type == 0 ? Q : K; const float* g = type == 0 ? gq : gk; const float osc = type == 0 ? QSCALE : 1.0f;
            f32x4 gv[2][2];
#pragma unroll
            for (int bj = 0; bj < 2; ++bj)
#pragma unroll
                for (int n = 0; n < 2; ++n) gv[bj][n] = *(const f32x4*)(g + 32 * bj + 8 * fq + 4 * n);
#pragma unroll
            for (int ai = 0; ai < 2; ++ai) {
                f32x4 cv[4][2], sv[4][2];
#pragma unroll
                for (int m = 0; m < 4; ++m) { const int pos = NMETA + ((row0 + ai * 128 + m * 16) & (SEQ - 1)); const float* csr = cs + (size_t)pos * 64 + 8 * fq;
                    cv[m][0] = *(const f32x4*)(csr); cv[m][1] = *(const f32x4*)(csr + 4); sv[m][0] = *(const f32x4*)(csr + 32); sv[m][1] = *(const f32x4*)(csr + 36); }
                asm volatile("" ::: "memory");
#pragma unroll
                for (int m = 0; m < 4; ++m) {
                    const int r = row0 + ai * 128 + m * 16;
                    float ss = 0.f;
#pragma unroll
                    for (int bj = 0; bj < 2; ++bj)
#pragma unroll
                        for (int n = 0; n < 2; ++n) { const f32x4 x = acc[ai][bj][m][n]; ss += (x[0] * x[0] + x[1] * x[1]) + (x[2] * x[2] + x[3] * x[3]); }
                    ss += __shfl_xor(ss, 16); ss += __shfl_xor(ss, 32);
                    const float rs = rsqrtf(ss * (1.0f / 64.0f) + EPS);
                    f32x4 olo[2], ohi[2];
#pragma unroll
                    for (int n = 0; n < 2; ++n) { const f32x4 lo = acc[ai][0][m][n] * rs * gv[0][n], hi = acc[ai][1][m][n] * rs * gv[1][n];
                        olo[n] = (lo * cv[m][n] - hi * sv[m][n]) * osc; ohi[n] = (hi * cv[m][n] + lo * sv[m][n]) * osc; }
                    bf16_t* p = dst + (size_t)r * AW + sh * 64 + 8 * fq;
                    *(u32x4*)(p) = pack8(olo[0], olo[1]); *(u32x4*)(p + 32) = pack8(ohi[0], ohi[1]);
                }
            }
        } else {
            const int colt = (u.pn & 3) * 256 + wc * 32 + 8 * fq;
#pragma unroll
            for (int ai = 0; ai < 2; ++ai)
#pragma unroll
                for (int m = 0; m < 4; ++m) {
                    const int r = row0 + ai * 128 + m * 16;
#pragma unroll
                    for (int bj = 0; bj < 2; ++bj) {
                        const f32x4 v0 = acc[ai][bj][m][0], v1 = acc[ai][bj][m][1];
                        if (type == 2) *(u32x4*)(V + (size_t)r * AW + colt + bj * 128) = pack8(v0, v1);
                        else if (type == 3) { if (U) { float* p = U + (size_t)r * SW + colt + bj * 128; *(f32x4*)p = v0; *(f32x4*)(p + 4) = v1; } *(u32x4*)(UB + (size_t)r * SW + colt + bj * 128) = pack8(v0, v1); }
                        else {
                            bf16_t* G = (type < 6) ? GA : GB; const int col = ((u.pn - (type < 6 ? 16 : 24)) * 256) + wc * 32 + 8 * fq + bj * 128;
                            f32x4 s0, s1;
#pragma unroll
                            for (int i = 0; i < 4; ++i) { s0[i] = sigmoidf_(v0[i]); s1[i] = sigmoidf_(v1[i]); }
                            *(u32x4*)(G + (size_t)r * DM + col) = pack8(s0, s1);
                        }
                    }
                }
        }
    }
};
struct EpiGlu {
    static constexpr bool PERM = true; static constexpr bool I8 = false; static constexpr bool OPQ = false;
    const bf16_t* GB; bf16_t* YB;
    __device__ __forceinline__ void operator()(const f32x4 (&acc)[2][2][4][2], const Unit& u, int wr, int wc, int fr, int fq) const {
        const int row0 = u.pm * 256 + wr * 64 + fr, col = u.pn * 128 + wc * 32 + 8 * fq;
        u32x4 gbv[2][4];
#pragma unroll
        for (int ai = 0; ai < 2; ++ai)
#pragma unroll
            for (int m = 0; m < 4; ++m) gbv[ai][m] = __builtin_nontemporal_load((const u32x4*)(GB + (size_t)(row0 + ai * 128 + m * 16) * DM + col));
        asm volatile("" ::: "memory");
#pragma unroll
        for (int ai = 0; ai < 2; ++ai)
#pragma unroll
            for (int m = 0; m < 4; ++m) {
                const size_t off = (size_t)(row0 + ai * 128 + m * 16) * DM + col;
                const u32x4 gb = gbv[ai][m];
                f32x4 o0, o1;
#pragma unroll
                for (int i = 0; i < 4; ++i) { o0[i] = acc[ai][0][m][0][i] * sigmoidf_(acc[ai][1][m][0][i]); o1[i] = acc[ai][0][m][1][i] * sigmoidf_(acc[ai][1][m][1][i]); }
                o0[0] *= bflo(gb.x); o0[1] *= bfhi(gb.x); o0[2] *= bflo(gb.y); o0[3] *= bfhi(gb.y);
                o1[0] *= bflo(gb.z); o1[1] *= bfhi(gb.z); o1[2] *= bflo(gb.w); o1[3] *= bfhi(gb.w);
                *(u32x4*)(YB + off) = pack8(o0, o1);
            }
    }
};
struct EpiMix {
    static constexpr bool PERM = true; static constexpr bool I8 = false; static constexpr bool OPQ = false;
    const bf16_t *GA, *YB; bf16_t* MIX;
    __device__ __forceinline__ void operator()(const f32x4 (&acc)[2][2][4][2], const Unit& u, int wr, int wc, int fr, int fq) const {
        const int row0 = u.pm * 256 + wr * 64 + fr, col0 = u.pn * 256 + wc * 32 + 8 * fq;
#pragma unroll
        for (int ai = 0; ai < 2; ++ai)
#pragma unroll
        for (int mh = 0; mh < 2; ++mh) {
            u32x4 gav[2][2], ybv[2][2];
#pragma unroll
            for (int m = 0; m < 2; ++m)
#pragma unroll
                for (int bj = 0; bj < 2; ++bj) { const size_t off = (size_t)(row0 + ai * 128 + (2 * mh + m) * 16) * DM + col0 + bj * 128; gav[m][bj] = __builtin_nontemporal_load((const u32x4*)(GA + off)); ybv[m][bj] = *(const u32x4*)(YB + off); }
            asm volatile("" ::: "memory");
#pragma unroll
            for (int m = 0; m < 2; ++m)
#pragma unroll
                for (int bj = 0; bj < 2; ++bj) {
                    const size_t off = (size_t)(row0 + ai * 128 + (2 * mh + m) * 16) * DM + col0 + bj * 128;
                    const u32x4 ga = gav[m][bj], yb = ybv[m][bj];
                    f32x4 o0 = acc[ai][bj][2 * mh + m][0], o1 = acc[ai][bj][2 * mh + m][1];
                    o0[0] = o0[0] * bflo(ga.x) + bflo(yb.x); o0[1] = o0[1] * bfhi(ga.x) + bfhi(yb.x); o0[2] = o0[2] * bflo(ga.y) + bflo(yb.y); o0[3] = o0[3] * bfhi(ga.y) + bfhi(yb.y);
                    o1[0] = o1[0] * bflo(ga.z) + bflo(yb.z); o1[1] = o1[1] * bfhi(ga.z) + bfhi(yb.z); o1[2] = o1[2] * bflo(ga.w) + bflo(yb.w); o1[3] = o1[3] * bfhi(ga.w) + bfhi(yb.w);
                    *(u32x4*)(MIX + off) = pack8(o0, o1);
                }
        }
    }
};
struct EpiP3 {
    static constexpr bool PERM = true; static constexpr bool I8 = true; static constexpr bool OPQ = false;
    EpiGlu g; EpiMix m;
    __device__ __forceinline__ void operator()(const f32x4 (&acc)[2][2][4][2], const Unit& u, int wr, int wc, int fr, int fq) const { if (u.sel) m(acc, u, wr, wc, fr, fq); else g(acc, u, wr, wc, fr, fq); }
};
struct EpiOut {
    static constexpr bool PERM = true; static constexpr bool I8 = true; static constexpr bool OPQ = false;
    const float* X; bf16_t* H2B; float* PARTSS;
    __device__ __forceinline__ void operator()(const f32x4 (&acc)[2][2][4][2], const Unit& u, int wr, int wc, int fr, int fq) const {
        const int row0 = u.pm * 256 + wr * 64 + fr, col0 = u.pn * 256 + wc * 32 + 8 * fq;
#pragma unroll
        for (int ai = 0; ai < 2; ++ai)
#pragma unroll
        for (int mh = 0; mh < 2; ++mh) {
            f32x4 xv[2][2][2];
#pragma unroll
            for (int m = 0; m < 2; ++m)
#pragma unroll
                for (int bj = 0; bj < 2; ++bj)
#pragma unroll
                    for (int n = 0; n < 2; ++n) xv[m][bj][n] = __builtin_nontemporal_load((const f32x4*)(X + (size_t)(row0 + ai * 128 + (2 * mh + m) * 16) * DM + col0 + bj * 128 + n * 4));
            asm volatile("" ::: "memory");
#pragma unroll
            for (int m = 0; m < 2; ++m) {
                const int r = row0 + ai * 128 + (2 * mh + m) * 16; float ss = 0.f;
#pragma unroll
                for (int bj = 0; bj < 2; ++bj) {
                    const f32x4 h0 = xv[m][bj][0] + acc[ai][bj][2 * mh + m][0], h1 = xv[m][bj][1] + acc[ai][bj][2 * mh + m][1];
                    ss += ((h0[0] * h0[0] + h0[1] * h0[1]) + (h0[2] * h0[2] + h0[3] * h0[3])) + ((h1[0] * h1[0] + h1[1] * h1[1]) + (h1[2] * h1[2] + h1[3] * h1[3]));
                    *(u32x4*)(H2B + (size_t)r * DM + col0 + bj * 128) = pack8(h0, h1);
                }
                ss += __shfl_xor(ss, 16); ss += __shfl_xor(ss, 32);
                if (fq == 0) PARTSS[(size_t)(u.pn * 4 + wc) * MTOK + r] = ss;
            }
        }
    }
};
struct EpiQP {
    static constexpr bool PERM = true; static constexpr bool I8 = true; static constexpr bool OPQ = false;
    bf16_t* QP;
    __device__ __forceinline__ void operator()(const f32x4 (&acc)[2][2][4][2], const Unit& u, int wr, int wc, int fr, int fq) const {
        const int rl0 = wr * 64 + fr, col0 = u.pn * 256 + wc * 32 + 8 * fq;
#pragma unroll
        for (int ai = 0; ai < 2; ++ai)
#pragma unroll
            for (int m = 0; m < 4; ++m) {
                const int rl = rl0 + ai * 128 + m * 16;
#pragma unroll
                for (int bj = 0; bj < 2; ++bj)
                    *(u32x4*)(QP + (size_t)(u.pm * 256 + rl) * DM + col0 + bj * 128) = pack8(acc[ai][bj][m][0], acc[ai][bj][m][1]);
            }
    }
};

struct Args { const float* in[28]; float* out; unsigned char* ws; int ph_lo, ph_hi, probe, pad; };
enum { I_X = 0, I_META, I_N1G, I_WIN, I_QNG, I_KNG, I_LQ1, I_LK1, I_LQ2, I_LK2, I_SUBLN, I_WATT, I_ARE, I_AIM, I_LOGDT, I_BRE, I_BIM, I_CRE, I_CIM, I_SSMD, I_WGLU, I_WOUT, I_N2G, I_WQ, I_K1, I_K2, I_PU, I_PV };

constexpr int NWAVES = 8, NTHREADS = 512;
constexpr int RING_BYTES = 131072, LDS_EXTRA_OFF = RING_BYTES, LDS_BYTES = 147456;

template <class RowMap>
__device__ __forceinline__ void transpose_item(const float* W, int K, int N, bf16_t* WT, LAS float* scr, int item, int lane, RowMap rm, const float* kscale = nullptr) {
    const int nblk = N / 32, kb = item / nblk, nb = item % nblk, k0 = 64 * kb, n0 = 32 * nb;
    float tv[32];
#pragma unroll
    for (int i = 0; i < 32; ++i) { tv[i] = __builtin_nontemporal_load(W + (size_t)(k0 + 2 * i + (lane >> 5)) * N + n0 + (lane & 31)); if (kscale) tv[i] *= kscale[k0 + 2 * i + (lane >> 5)]; }
#pragma unroll
    for (int i = 0; i < 32; ++i) scr[(2 * i + (lane >> 5)) * 33 + (lane & 31)] = tv[i];
    asm volatile("s_waitcnt lgkmcnt(0)" ::: "memory");
    const int c = lane & 7;
#pragma unroll
    for (int j = 0; j < 4; ++j) { const int n = (lane >> 3) + 8 * j; const LAS float* s = scr + (8 * c) * 33 + n;
        u32x4 o; o.x = pk2(s[0 * 33], s[1 * 33]); o.y = pk2(s[2 * 33], s[3 * 33]); o.z = pk2(s[4 * 33], s[5 * 33]); o.w = pk2(s[6 * 33], s[7 * 33]);
        *(u32x4*)(WT + (size_t)rm(n0 + n) * K + k0 + 8 * c) = o; }
    asm volatile("s_waitcnt lgkmcnt(0)" ::: "memory");
}
struct MapId { __device__ __forceinline__ int operator()(int n) const { return n; } };
struct MapWin { __device__ __forceinline__ int operator()(int n) const { if (n >= 2048) return n; const int w = n & 255; return (n & ~255) + 128 * ((w >> 5) & 1) + 32 * (w >> 6) + (w & 31); } };
struct MapGlu { __device__ __forceinline__ int operator()(int n) const { const int hi = n >= 2048, j = n & 2047; return (j >> 7) * 256 + 128 * hi + (j & 127); } };

__device__ __forceinline__ void rms_row_to_bf16(const float* xrow, const float* g, bf16_t* orow, int lane) {
    const f32x4* xr = (const f32x4*)xrow + lane; const f32x4* gr = (const f32x4*)g + lane;
    f32x4 v[8]; float s = 0.f;
#pragma unroll
    for (int j = 0; j < 8; ++j) { v[j] = __builtin_nontemporal_load(xr + 64 * j); s += (v[j][0] * v[j][0] + v[j][1] * v[j][1]) + (v[j][2] * v[j][2] + v[j][3] * v[j][3]); }
    const float rs = rsqrtf(wave_sum(s) * (1.0f / DM) + EPS);
    u32x2* o = (u32x2*)orow + lane;
#pragma unroll
    for (int j = 0; j < 8; ++j) { const f32x4 y = v[j] * rs * gr[64 * j]; u32x2 w; w.x = pk2(y[0], y[1]); w.y = pk2(y[2], y[3]); o[64 * j] = w; }
}

__device__ __forceinline__ void rms_row_to_i8(const float* xrow, const float* g, unsigned char* qrow, float* sx, int lane) {
    const f32x4* xr = (const f32x4*)xrow + lane; const f32x4* gr = (const f32x4*)g + lane;
    f32x4 v[8]; float s = 0.f, mx = 0.f;
#pragma unroll
    for (int j = 0; j < 8; ++j) { v[j] = __builtin_nontemporal_load(xr + 64 * j); s += (v[j][0] * v[j][0] + v[j][1] * v[j][1]) + (v[j][2] * v[j][2] + v[j][3] * v[j][3]);
        v[j] = v[j] * gr[64 * j]; mx = fmaxf(mx, fmaxf(fmaxf(fabsf(v[j][0]), fabsf(v[j][1])), fmaxf(fabsf(v[j][2]), fabsf(v[j][3])))); }
    const float rs = rsqrtf(wave_sum(s) * (1.0f / DM) + EPS);
    mx = wave_max(mx);
    const float inv = mx > 0.f ? 127.0f / mx : 0.f;
    unsigned* o = (unsigned*)qrow + lane;
#pragma unroll
    for (int j = 0; j < 8; ++j) { const int q0 = (int)rintf(v[j][0] * inv), q1 = (int)rintf(v[j][1] * inv), q2 = (int)rintf(v[j][2] * inv), q3 = (int)rintf(v[j][3] * inv);
        o[64 * j] = (unsigned)(q0 & 255) | ((unsigned)(q1 & 255) << 8) | ((unsigned)(q2 & 255) << 16) | ((unsigned)q3 << 24); }
    if (lane == 0) *sx = mx * rs * (1.0f / 127.0f);
}
template <int K, class RowMap>
__device__ __forceinline__ void strip_item(const float* Wm, int N, const float* kscale, RowMap rm, unsigned char* WT8, float* sw, LAS unsigned char* lds, int strip) {
    const int tid = otid(), col = tid & 31, rp = tid >> 5;
    constexpr int CP = 2 * K + 16;
    const float* W = Wm + 32 * strip + col;
    float mx = 0.f;
#pragma unroll 1
    for (int i0 = 0; i0 < K / 32; i0 += 16) {
        float v[32];
#pragma unroll
        for (int i = 0; i < 16; ++i) { const int k = 2 * (rp + 16 * (i0 + i)); v[2 * i] = __builtin_nontemporal_load(W + (size_t)k * N); v[2 * i + 1] = __builtin_nontemporal_load(W + (size_t)(k + 1) * N); }
        asm volatile("" ::: "memory");
#pragma unroll
        for (int i = 0; i < 16; ++i) { const int k = 2 * (rp + 16 * (i0 + i)); if (kscale) { v[2 * i] *= kscale[k]; v[2 * i + 1] *= kscale[k + 1]; }
            mx = fmaxf(mx, fmaxf(fabsf(v[2 * i]), fabsf(v[2 * i + 1])));
            *(LAS unsigned*)(lds + col * CP + k * 2) = pk2(v[2 * i], v[2 * i + 1]); }
    }
    LAS float* smax = (LAS float*)(lds + 32 * CP);
    smax[rp * 32 + col] = mx;
    __syncthreads();
    constexpr int TPC = K / 16, CPP = 512 / TPC;
#pragma unroll 1
    for (int p = 0; p < 32 / CPP; ++p) {
        const int c = CPP * p + tid / TPC, kc = (tid % TPC) * 16;
        float cm = 0.f;
#pragma unroll
        for (int j = 0; j < 16; ++j) cm = fmaxf(cm, smax[j * 32 + c]);
        const float inv = cm > 0.f ? 127.0f / cm : 0.f;
        const u32x4 lo = *(const LAS u32x4*)(lds + c * CP + kc * 2), hi = *(const LAS u32x4*)(lds + c * CP + kc * 2 + 16);
        const unsigned wd[8] = {lo.x, lo.y, lo.z, lo.w, hi.x, hi.y, hi.z, hi.w}; u32x4 o;
#pragma unroll
        for (int q = 0; q < 4; ++q) { const int q0 = (int)rintf(bflo(wd[2 * q]) * inv), q1 = (int)rintf(bfhi(wd[2 * q]) * inv), q2 = (int)rintf(bflo(wd[2 * q + 1]) * inv), q3 = (int)rintf(bfhi(wd[2 * q + 1]) * inv);
            const unsigned pk = (unsigned)(q0 & 255) | ((unsigned)(q1 & 255) << 8) | ((unsigned)(q2 & 255) << 16) | ((unsigned)q3 << 24);
            if (q == 0) o.x = pk; else if (q == 1) o.y = pk; else if (q == 2) o.z = pk; else o.w = pk; }
        const int n = rm(32 * strip + c);
        *(u32x4*)(WT8 + (size_t)n * K + kc) = o;
        if ((tid % TPC) == 0) sw[n] = cm * (1.0f / 127.0f);
    }
    __syncthreads();
}

constexpr int XROWS = 2 * NEXP;
template <int MODE>
__device__ __forceinline__ void p0_prologue(const Args& A, LAS unsigned char* lds, int G, int probe = 0) {
    const int tid = otid(), lane = tid & 63, wave = __builtin_amdgcn_readfirstlane(tid >> 6);
    const int gw = MODE ? (blockIdx.x - 128) * NWAVES + wave : blockIdx.x * NWAVES + wave, NGW = MODE ? (G - 128) * NWAVES : G * NWAVES;
    unsigned char* ws = A.ws;
#pragma unroll 1
    for (int step = 0; step < 3; ++step) {
    const int part = (MODE == 0 && (blockIdx.x & 1)) ? (step + 2) % 3 : step;
    if (part == 0 && (probe == 0 || probe == 1)) {
        LAS float* scr = (LAS float*)(lds + wave * 16384);
        constexpr int I_IN = (DM / 64) * (INW / 32), I_AT = (AW / 64) * (DM / 32), I_GL = (SW / 64) * (2 * DM / 32), I_OU = (DM / 64) * (DM / 32), I_Q = I_OU;
        constexpr int NIT = I_IN + I_AT + I_GL + I_OU + I_Q;
        if (MODE == 0) { for (int st = blockIdx.x; st < INW / 32; st += G) strip_item<DM>(A.in[I_WIN], INW, nullptr, MapWin(), ws + WS_WTIN, (float*)(ws + WS_SWB), lds, st); }
        else {
            for (int it = (int)blockIdx.x - 128; it < 320; it += G - 128) {
                if (it < 64) strip_item<DM>(A.in[I_WQ], DM, A.in[I_N2G], MapId(), ws + WS_WTQ, (float*)(ws + WS_SWQ), lds, it);
                else if (it < 128) strip_item<DM>(A.in[I_WOUT], DM, nullptr, MapId(), ws + WS_WTOUT, (float*)(ws + WS_SWO), lds, it - 64);
                else if (it < 256) strip_item<SW>(A.in[I_WGLU], 2 * DM, nullptr, MapGlu(), ws + WS_WTGLU, (float*)(ws + WS_SWG), lds, it - 128);
                else strip_item<AW>(A.in[I_WATT], DM, nullptr, MapId(), ws + WS_WTATT, (float*)(ws + WS_SWA), lds, it - 256);
            }
        }
    }
    if (part == 1 && MODE == 0 && (probe == 0 || probe == 2)) for (int m = gw; m < MTOK; m += NGW) rms_row_to_i8(A.in[I_X] + (size_t)m * DM, A.in[I_N1G], ws + WS_XN + (size_t)m * DM, (float*)(ws + WS_SXA) + m, lane);
    if (part == 2 && (probe == 0 || probe == 3)) {
        float* su = (float*)(ws + WS_SU); float* sv = (float*)(ws + WS_SV);
        const int it_end = MODE ? 2 * NEXP : XROWS;
        f32x4 nv[8];
        { const int it = MODE ? gw + XROWS : gw;
          if (it < it_end) { const int tb = it >= NEXP, e = it - tb * NEXP; const f32x4* src = (const f32x4*)(A.in[tb ? I_PV : I_PU] + (size_t)e * DM) + lane;
#pragma unroll
            for (int j = 0; j < 8; ++j) nv[j] = __builtin_nontemporal_load(src + 64 * j); } }
#pragma unroll 1
        for (int it = MODE ? gw + XROWS : gw; it < it_end; it += NGW) {
            const int tb = it >= NEXP, e = it - tb * NEXP;
            f32x4 v[8]; float mx = 0.f;
#pragma unroll
            for (int j = 0; j < 8; ++j) v[j] = nv[j];
            { const int nit = it + NGW;
              if (nit < it_end) { const int ntb = nit >= NEXP, ne = nit - ntb * NEXP; const f32x4* src = (const f32x4*)(A.in[ntb ? I_PV : I_PU] + (size_t)ne * DM) + lane;
#pragma unroll
                for (int j = 0; j < 8; ++j) nv[j] = __builtin_nontemporal_load(src + 64 * j); } }
            asm volatile("" ::: "memory");
#pragma unroll
            for (int j = 0; j < 8; ++j) { if (!tb) v[j] = v[j] * *((const f32x4*)A.in[I_N2G] + lane + 64 * j);
                mx = fmaxf(mx, fmaxf(fmaxf(fabsf(v[j][0]), fabsf(v[j][1])), fmaxf(fabsf(v[j][2]), fabsf(v[j][3])))); }
            mx = wave_max(mx);
            unsigned* dst = (unsigned*)(ws + (tb ? WS_VE : WS_UE) + (size_t)e * DM) + lane;
            if (!tb) {
                const float inv = mx > 0.f ? 127.0f / mx : 0.f;
#pragma unroll
                for (int j = 0; j < 8; ++j) { const int q0 = (int)rintf(v[j][0] * inv), q1 = (int)rintf(v[j][1] * inv), q2 = (int)rintf(v[j][2] * inv), q3 = (int)rintf(v[j][3] * inv);
                    dst[64 * j] = (unsigned)(q0 & 255) | ((unsigned)(q1 & 255) << 8) | ((unsigned)(q2 & 255) << 16) | ((unsigned)(q3 & 255) << 24); }
                if (lane == 0) su[e] = mx * (1.0f / 127.0f);
            } else {
                const float inv = mx > 0.f ? 448.0f / mx : 0.f;
#pragma unroll
                for (int j = 0; j < 8; ++j) { int p = __builtin_amdgcn_cvt_pk_fp8_f32(v[j][0] * inv, v[j][1] * inv, 0, false); p = __builtin_amdgcn_cvt_pk_fp8_f32(v[j][2] * inv, v[j][3] * inv, p, true); dst[64 * j] = (unsigned)p; }
                if (lane == 0) sv[e] = mx * (1.0f / 448.0f);
            }
        }
    }
    }
    if (MODE == 0 && (probe == 0 || probe == 4)) {
        { bf16_t* k12 = (bf16_t*)(ws + WS_K12);
          for (int i = blockIdx.x * NTHREADS + tid; i < 2 * 8 * 128 * 128; i += G * NTHREADS) k12[i] = (bf16_t)f2bf(i < 131072 ? A.in[I_K1][i] : A.in[I_K2][i - 131072]); }
        float* cs = (float*)(ws + WS_CS);
        for (int i = blockIdx.x * NTHREADS + tid; i < NPOS * 32; i += G * NTHREADS) {
            const int pos = i >> 5, j = i & 31; const float invf = exp2f(-(float)j * (13.287712379549449f / 32.0f));
            const float ang = (float)pos * invf; float sn, cn; sincosf(ang, &sn, &cn); cs[pos * 64 + j] = cn; cs[pos * 64 + 32 + j] = sn;
        }
        float* abar = (float*)(ws + WS_ABAR); float* bbar = (float*)(ws + WS_BBAR);
        for (int i = blockIdx.x * NTHREADS + tid; i < 64 * 64; i += G * NTHREADS) {
            const int g = i >> 6; const float are = A.in[I_ARE][i], aim = A.in[I_AIM][i], dt = expf(A.in[I_LOGDT][g]);
            const float mag = expf(are * dt); float sn, cn; sincosf(aim * dt, &sn, &cn); const float br = mag * cn, bi = mag * sn;
            abar[2 * i] = br; abar[2 * i + 1] = bi;
            const float nr = br - 1.0f, ni = bi, den = 1.0f / (are * are + aim * aim);
            const float fr_ = (nr * are + ni * aim) * den, fi_ = (ni * are - nr * aim) * den;
            for (int c = 0; c < 16; ++c) { const float b_r = A.in[I_BRE][i * 16 + c], b_i = A.in[I_BIM][i * 16 + c];
                bbar[(i * 16 + c) * 2] = fr_ * b_r - fi_ * b_i; bbar[(i * 16 + c) * 2 + 1] = fr_ * b_i + fi_ * b_r; }
        }
        if (blockIdx.x == 0 && wave == 0) {
            const float s1 = wave_sum(A.in[I_LQ1][lane] * A.in[I_LK1][lane]), s2 = wave_sum(A.in[I_LQ2][lane] * A.in[I_LK2][lane]);
            const float gqm = wave_max(fabsf(A.in[I_QNG][lane])), gkm = wave_max(fabsf(A.in[I_KNG][lane]));
            if (lane == 0) { float* par = (float*)(ws + WS_PAR); par[0] = expf(s1) - expf(s2) + LAM_INIT; par[1] = 8.0f * gqm * gkm * LOG2E * 1.01f; }
        }
    }
    if (MODE == 0 && (probe == 0 || probe == 5)) {
        __syncthreads();
        LAS float* hm = (LAS float*)(lds + wave * 16384);
        float* macc = (float*)(ws + WS_MP32);
        for (int it = gw; it < 48 * 32; it += NGW) {
            const int cb = it % 48, ks = it / 48, k0 = ks * 64;
            float w[64];
            const float* wp = A.in[I_WIN] + (size_t)k0 * INW + 1024 + cb * 64 + lane;
#pragma unroll
            for (int q = 0; q < 64; ++q) w[q] = wp[(size_t)q * INW];
            const float gk = A.in[I_N1G][k0 + lane];
#pragma unroll
            for (int r = 0; r < 16; ++r) hm[r * 64 + lane] = A.in[I_META][(size_t)r * DM + k0 + lane] * gk;
            asm volatile("s_waitcnt lgkmcnt(0)" ::: "memory");
            float acc[16];
#pragma unroll
            for (int r = 0; r < 16; ++r) acc[r] = 0.f;
#pragma unroll
            for (int q4 = 0; q4 < 16; ++q4) {
#pragma unroll
                for (int r = 0; r < 16; ++r) { const f32x4 h = *(const LAS f32x4*)(hm + r * 64 + 4 * q4); acc[r] += (h[0] * w[4 * q4] + h[1] * w[4 * q4 + 1]) + (h[2] * w[4 * q4 + 2] + h[3] * w[4 * q4 + 3]); }
                if ((q4 & 3) == 3) __builtin_amdgcn_sched_barrier(0);
            }
#pragma unroll
            for (int r = 0; r < 16; ++r) macc[((size_t)ks * 16 + r) * 3072 + cb * 64 + lane] = acc[r];
            asm volatile("s_waitcnt lgkmcnt(0)" ::: "memory");
        }
    }
}
__device__ __forceinline__ void p1_meta_finish(const Args& A, LAS unsigned char* lds, int G) {
    const int tid = otid(), lane = tid & 63, wave = __builtin_amdgcn_readfirstlane(tid >> 6); unsigned char* ws = A.ws;
    const float* mp = (const float*)(ws + WS_MP32); const float* cs = (const float*)(ws + WS_CS);
    bf16_t* KM = (bf16_t*)(ws + WS_KM); bf16_t* VM = (bf16_t*)(ws + WS_VM); float* UM = (float*)(ws + WS_UM); bf16_t* UMB = (bf16_t*)(ws + WS_UMB);
    LAS float* rsm = (LAS float*)(lds + LDS_EXTRA_OFF + 12288);
    for (int r = wave; r < 16; r += NWAVES) { const f32x4* mr = (const f32x4*)(A.in[I_META] + (size_t)r * DM) + lane; float sq = 0.f;
#pragma unroll
        for (int j = 0; j < 8; ++j) { const f32x4 v = mr[64 * j]; sq += (v[0] * v[0] + v[1] * v[1]) + (v[2] * v[2] + v[3] * v[3]); }
        sq = wave_sum(sq); if (lane == 0) rsm[r] = rsqrtf(sq * (1.0f / DM) + EPS); }
    __syncthreads();
    for (int t = blockIdx.x * NWAVES + wave; t < 16 * 16; t += G * NWAVES) {
        const int r = t >> 4, sh = t & 15, d = lane; float kv = 0.f;
        for (int ks = 0; ks < 32; ++ks) kv += mp[((size_t)ks * 16 + r) * 3072 + sh * 64 + d];
        kv *= rsm[r];
        const float rs = rsqrtf(wave_sum(kv * kv) * (1.0f / 64.0f) + EPS);
        const float a = kv * rs * A.in[I_KNG][d], bq = __shfl_xor(a, 32);
        const int j = d & 31; const float cn = cs[r * 64 + j], sn = cs[r * 64 + 32 + j];
        KM[r * 1024 + sh * 64 + d] = (bf16_t)f2bf((d < 32) ? (a * cn - bq * sn) : (a * cn + bq * sn));
    }
    for (int i = blockIdx.x * NTHREADS + tid; i < 16 * 2048; i += G * NTHREADS) {
        const int r = i >> 11, c = i & 2047; float v = 0.f;
        for (int ks = 0; ks < 32; ++ks) v += mp[((size_t)ks * 16 + r) * 3072 + 1024 + c];
        v *= rsm[r];
        if (c < 1024) VM[r * 1024 + c] = (bf16_t)f2bf(v); else { UM[r * 1024 + c - 1024] = v; UMB[r * 1024 + c - 1024] = (bf16_t)f2bf(v); }
    }
    for (int i = blockIdx.x * NTHREADS + tid; i < 48 * 1024; i += G * NTHREADS) { KM[16 * 1024 + i] = 0; VM[16 * 1024 + i] = 0; }
}

namespace att {
typedef float f32x16 __attribute__((ext_vector_type(16)));
typedef short s16x4 __attribute__((ext_vector_type(4)));
typedef short v4i16_t __attribute__((ext_vector_type(4)));
constexpr int KP = 272, VP = 320, KBUF = 64 * KP, VBUF = 64 * VP, STG = KBUF + VBUF;
constexpr int X_OFF = 0, OST_OFF = 65536, QF_OFF = 2 * STG, WSL_OFF = QF_OFF + 32768;
__device__ __forceinline__ int crow(int r, int hi) { return (r & 3) + 8 * (r >> 2) + 4 * hi; }
__device__ __forceinline__ s16x4 vtr(const LAS unsigned char* p) { return __builtin_bit_cast(s16x4, __builtin_amdgcn_ds_read_tr16_b64_v4i16((LAS v4i16_t*)p)); }
__device__ __forceinline__ unsigned cvtpk(float lo, float hi) { f32x2 v = {lo, hi}; bf16x2_t b = __builtin_convertvector(v, bf16x2_t); return __builtin_bit_cast(unsigned, b); }

__device__ __forceinline__ void attn_unit(const Args& A, int b, int h, int qb, LAS unsigned char* lds, float lam, float Mb) {
    const int tid = otid(), lane = tid & 63, wave = __builtin_amdgcn_readfirstlane(tid >> 6);
    const int c = wave >> 2, w4 = wave & 3, r32 = lane & 31, hh = lane >> 5;
    unsigned char* ws = A.ws;
    const bf16_t* Q = (const bf16_t*)(ws + WS_Q); const bf16_t* K = (const bf16_t*)(ws + WS_K); const bf16_t* V = (const bf16_t*)(ws + WS_V);
    const bf16_t* KM = (const bf16_t*)(ws + WS_KM); const bf16_t* VM = (const bf16_t*)(ws + WS_VM); bf16_t* ATT = (bf16_t*)(ws + WS_ATT);
    const int tq = qb * 128 + 32 * w4 + r32;
    LAS unsigned char* qfl = lds + QF_OFF + wave * 4096 + lane * 16;
    { const bf16_t* qp = Q + (size_t)(b * SEQ + tq) * AW + h * 128 + c * 64 + 8 * hh;
#pragma unroll
      for (int ds = 0; ds < 4; ++ds) *(LAS bf16x8*)(qfl + ds * 1024) = *(const bf16x8*)(qp + 16 * ds); }
    f32x16 o[4];
#pragma unroll
    for (int d = 0; d < 4; ++d)
#pragma unroll
        for (int r = 0; r < 16; ++r) o[d][r] = 0.f;
    float l = 0.f;
    const int ntile = 2 * qb + 3;
    const int srow = tid >> 3, sch = tid & 7;
    u32x4 st[4];
#define ATT_LOAD(kt) do { const bf16_t* kr; const bf16_t* vr; if ((kt) == 0) { kr = KM + (size_t)srow * AW; vr = VM + (size_t)srow * AW; } \
        else { const size_t row = (size_t)(b * SEQ + ((kt) - 1) * 64 + srow) * AW; kr = K + row; vr = V + row; } \
        kr += h * 128 + sch * 8; vr += h * 128 + sch * 8; st[0] = *(const u32x4*)kr; st[1] = *(const u32x4*)(kr + 64); st[2] = *(const u32x4*)vr; st[3] = *(const u32x4*)(vr + 64); } while (0)
#define ATT_STORE(buf) do { LAS unsigned char* kb_ = lds + (buf) * STG + srow * KP + sch * 16; LAS unsigned char* vb_ = lds + (buf) * STG + KBUF + srow * VP + sch * 16; \
        *(LAS u32x4*)kb_ = st[0]; *(LAS u32x4*)(kb_ + 128) = st[1]; *(LAS u32x4*)vb_ = st[2]; *(LAS u32x4*)(vb_ + 128) = st[3]; } while (0)
    ATT_LOAD(0); ATT_STORE(0);
    __syncthreads();
    const int koff = r32 * KP + (c * 64 + 8 * hh) * 2;
    const int voff = (4 * hh + ((lane & 15) >> 2)) * VP + (16 * ((lane >> 4) & 1) + 4 * (lane & 3)) * 2;
    const float NEG = -INFINITY;
#pragma unroll 1
    for (int kt = 0; kt < ntile; ++kt) {
        const int cur = kt & 1;
        if (kt + 1 < ntile) ATT_LOAD(kt + 1);
        const LAS unsigned char* Kb = lds + cur * STG + koff; const LAS unsigned char* Vb = lds + cur * STG + KBUF + voff;
        f32x16 p0, p1;
#pragma unroll
        for (int r = 0; r < 16; ++r) { p0[r] = -Mb; p1[r] = -Mb; }
#pragma unroll
        for (int ds = 0; ds < 4; ++ds) {
            const bf16x8 a0 = *(const LAS bf16x8*)(Kb + ds * 32), a1 = *(const LAS bf16x8*)(Kb + 32 * KP + ds * 32);
            const bf16x8 qv = *(const LAS bf16x8*)(qfl + ds * 1024);
            p0 = __builtin_amdgcn_mfma_f32_32x32x16_bf16(a0, qv, p0, 0, 0, 0);
            p1 = __builtin_amdgcn_mfma_f32_32x32x16_bf16(a1, qv, p1, 0, 0, 0);
        }
        if (kt == 0) {
#pragma unroll
            for (int r = 0; r < 16; ++r) { if (r >= 8) p0[r] = NEG; p1[r] = NEG; }
        } else if (kt - 1 >= 2 * qb) {
            const int lim = tq - (kt - 1) * 64 - 4 * hh;
#pragma unroll
            for (int r = 0; r < 16; ++r) { const int kc = (r & 3) + 8 * (r >> 2); if (kc > lim) p0[r] = NEG; if (kc + 32 > lim) p1[r] = NEG; }
        }
        float sacc = 0.f;
#pragma unroll
        for (int r = 0; r < 16; ++r) { p0[r] = __builtin_amdgcn_exp2f(p0[r]); p1[r] = __builtin_amdgcn_exp2f(p1[r]); sacc += p0[r] + p1[r]; }
        l += sacc;
        bf16x8 pa[4];
        { u32x4 w;
          w.x = cvtpk(p0[0], p0[1]); w.y = cvtpk(p0[2], p0[3]); w.z = cvtpk(p0[4], p0[5]); w.w = cvtpk(p0[6], p0[7]); pa[0] = __builtin_bit_cast(bf16x8, w);
          w.x = cvtpk(p0[8], p0[9]); w.y = cvtpk(p0[10], p0[11]); w.z = cvtpk(p0[12], p0[13]); w.w = cvtpk(p0[14], p0[15]); pa[1] = __builtin_bit_cast(bf16x8, w);
          w.x = cvtpk(p1[0], p1[1]); w.y = cvtpk(p1[2], p1[3]); w.z = cvtpk(p1[4], p1[5]); w.w = cvtpk(p1[6], p1[7]); pa[2] = __builtin_bit_cast(bf16x8, w);
          w.x = cvtpk(p1[8], p1[9]); w.y = cvtpk(p1[10], p1[11]); w.z = cvtpk(p1[12], p1[13]); w.w = cvtpk(p1[14], p1[15]); pa[3] = __builtin_bit_cast(bf16x8, w); }
        __builtin_amdgcn_sched_barrier(0);
        __builtin_amdgcn_s_setprio(1);
#pragma unroll
        for (int db = 0; db < 4; ++db) {
            s16x4 lo[4], hi[4];
#pragma unroll
            for (int ks = 0; ks < 4; ++ks) { lo[ks] = vtr(Vb + (16 * ks) * VP + db * 64); hi[ks] = vtr(Vb + (16 * ks + 8) * VP + db * 64); }
#pragma unroll
            for (int ks = 0; ks < 4; ++ks) {
                const bf16x8 vf = (bf16x8){lo[ks][0], lo[ks][1], lo[ks][2], lo[ks][3], hi[ks][0], hi[ks][1], hi[ks][2], hi[ks][3]};
                o[db] = __builtin_amdgcn_mfma_f32_32x32x16_bf16(pa[ks], vf, o[db], 0, 0, 0);
            }
        }
        __builtin_amdgcn_s_setprio(0);
        if (kt + 1 < ntile) ATT_STORE(cur ^ 1);
        __syncthreads();
    }
#undef ATT_LOAD
#undef ATT_STORE
    l += __shfl_xor(l, 32);
    LAS float* wsl = (LAS float*)(lds + WSL_OFF);
    LAS float* X = (LAS float*)(lds + X_OFF);
    if (hh == 0) wsl[c * 128 + 32 * w4 + r32] = (c == 0 ? 1.0f : lam) / l;
    __syncthreads();
    if (c == 1) {
#pragma unroll
        for (int r = 0; r < 16; ++r) { const int ql = 32 * w4 + crow(r, hh); const float sc = wsl[128 + ql];
#pragma unroll
            for (int db = 0; db < 4; ++db) X[ql * 128 + 32 * db + r32] = o[db][r] * sc;
            if ((r & 3) == 3) __builtin_amdgcn_sched_barrier(0); }
    }
    __syncthreads();
    if (c == 0) {
        LAS bf16_t* ost = (LAS bf16_t*)(lds + OST_OFF + w4 * 8192);
        float gsub[4];
#pragma unroll
        for (int db = 0; db < 4; ++db) gsub[db] = A.in[I_SUBLN][32 * db + r32] * (1.0f - LAM_INIT);
#pragma unroll
        for (int r = 0; r < 16; ++r) {
            const int qw = crow(r, hh), ql = 32 * w4 + qw; const float sc = wsl[ql];
            float d[4], ss = 0.f;
#pragma unroll
            for (int db = 0; db < 4; ++db) { d[db] = o[db][r] * sc - X[ql * 128 + 32 * db + r32]; ss += d[db] * d[db]; }
            ss = row_sum16(ss); ss += __shfl_xor(ss, 16);
            const float rs = rsqrtf(ss * (1.0f / 128.0f) + EPS);
#pragma unroll
            for (int db = 0; db < 4; ++db) ost[qw * 128 + 32 * db + r32] = (bf16_t)f2bf(d[db] * rs * gsub[db]);
            if ((r & 3) == 3) __builtin_amdgcn_sched_barrier(0);
        }
        asm volatile("s_waitcnt lgkmcnt(0)" ::: "memory");
#pragma unroll
        for (int it = 0; it < 8; ++it) { const int row = it * 4 + (lane >> 4), ch = lane & 15;
            const u32x4 v = *(const LAS u32x4*)(ost + row * 128 + ch * 8);
            *(u32x4*)(ATT + (size_t)(b * SEQ + qb * 128 + 32 * w4 + row) * AW + h * 128 + ch * 8) = v; }
    }
    __syncthreads();
}
__device__ __forceinline__ void attn_phase(const Args& A, LAS unsigned char* lds, int G) {
    const float* par = (const float*)(A.ws + WS_PAR); const float lam = par[0], Mb = par[1];
    const int bx = blockIdx.x, vcu = (G % 8 == 0) ? (bx % 8) * (G / 8) + bx / 8 : bx;
    for (int item = vcu; item < 256; item += G) {
        const int bh = item >> 4, pr = item & 15;
#pragma unroll 1
        for (int u2 = 0; u2 < 2; ++u2) attn_unit(A, bh >> 3, bh & 7, u2 ? pr : 31 - pr, lds, lam, Mb);
    }
}
}

__device__ __forceinline__ float gelu_as(float v) {
    const float av = fabsf(v), t = __builtin_amdgcn_rcpf(av * 0.2316418882f + 1.0f);
    float q = t * 0.5307027145f + (-0.7265760135f); q = q * t + 0.7107068705f; q = q * t + (-0.142248368f); q = q * t + 0.127414796f; q = q * t;
    const float e = __builtin_amdgcn_exp2f((v * v) * (-0.72134752044f)), m = v * (q * e);
    return v < 0.f ? m : v - m;
}

namespace ssm {
typedef float f32x16 __attribute__((ext_vector_type(16)));
constexpr int L_APOW = 0, L_BB = 8704, L_CC = L_BB + 8192, L_KT = L_CC + 8192, L_DS = L_KT + 16384, L_XIN = L_DS + 64, XPITCH = 272, XBLK = 32 * XPITCH;
static_assert(L_XIN + 8 * XBLK <= RING_BYTES, "ssm LDS map");
__device__ __forceinline__ unsigned cvtpk(float lo, float hi) { f32x2 v = {lo, hi}; bf16x2_t b = __builtin_convertvector(v, bf16x2_t); return __builtin_bit_cast(unsigned, b); }
__device__ __forceinline__ void ssm_mm_phase(const Args& A, LAS unsigned char* lds, int G, int probe = 0) {
    const int tid = otid(), lane = tid & 63, wave = __builtin_amdgcn_readfirstlane(tid >> 6), r32 = lane & 31, hh = lane >> 5;
    unsigned char* ws = A.ws;
    const bf16_t* UB = (const bf16_t*)(ws + WS_UB); const bf16_t* UMB = (const bf16_t*)(ws + WS_UMB); bf16_t* YS = (bf16_t*)(ws + WS_YS);
    const float* abar = (const float*)(ws + WS_ABAR); const float* bbar = (const float*)(ws + WS_BBAR);
    LAS float* apow = (LAS float*)(lds + L_APOW); LAS float* Bb = (LAS float*)(lds + L_BB); LAS float* Cc = (LAS float*)(lds + L_CC); LAS float* Kt = (LAS float*)(lds + L_KT);
    if (blockIdx.x < 128) {
        const int item = blockIdx.x, b = item >> 6, g = item & 63;
        __syncthreads();
        if (tid < 64) { const float ar = abar[(g * 64 + tid) * 2], ai = abar[(g * 64 + tid) * 2 + 1]; float pr = 1.f, pi = 0.f;
            for (int t = 0; t <= 16; ++t) { apow[(t * 64 + tid) * 2] = pr; apow[(t * 64 + tid) * 2 + 1] = pi; const float nr = pr * ar - pi * ai, ni = pr * ai + pi * ar; pr = nr; pi = ni; } }
        *(LAS f32x4*)(Bb + 4 * tid) = *(const f32x4*)(bbar + (size_t)g * 2048 + 4 * tid);
        if (tid < 16) ((LAS float*)(lds + L_DS))[tid] = A.in[I_SSMD][g * 16 + tid];
#pragma unroll
        for (int q = 0; q < 2; ++q) { const int idx = 2 * tid + q, cc_ = idx >> 6, pp_ = idx & 63;
            Cc[(pp_ * 16 + cc_) * 2] = A.in[I_CRE][g * 1024 + idx]; Cc[(pp_ * 16 + cc_) * 2 + 1] = A.in[I_CIM][g * 1024 + idx]; }
        __syncthreads();
        { const int tau = tid >> 5, c = (tid >> 1) & 15, ch = tid & 1; float acc[8];
#pragma unroll
          for (int i = 0; i < 8; ++i) acc[i] = 0.f;
          for (int p = 0; p < 64; ++p) {
              const float cr = Cc[(p * 16 + c) * 2], ci = Cc[(p * 16 + c) * 2 + 1], ar = apow[(tau * 64 + p) * 2], ai = apow[(tau * 64 + p) * 2 + 1];
              const float wr = cr * ar - ci * ai, wi = cr * ai + ci * ar;
              const LAS f32x4* bp = (const LAS f32x4*)(Bb + (p * 16 + 8 * ch) * 2);
#pragma unroll
              for (int q = 0; q < 4; ++q) { const f32x4 bv = bp[q]; acc[2 * q] += wr * bv[0] - wi * bv[1]; acc[2 * q + 1] += wr * bv[2] - wi * bv[3]; }
          }
#pragma unroll
          for (int i = 0; i < 8; ++i) Kt[(tau * 16 + c) * 16 + 8 * ch + i] = acc[i]; }
        __syncthreads();
        if (probe == 3) return;
        if (wave < 4) {
            const int mb = wave;
            bf16x8 pf[16];
            { const int p = 16 * mb + (r32 >> 1), ri = r32 & 1;
#pragma unroll
              for (int sstep = 0; sstep < 16; ++sstep) {
                  const float ar = apow[((15 - sstep) * 64 + p) * 2], ai = apow[((15 - sstep) * 64 + p) * 2 + 1];
                  const float ca = ri ? ai : ar, cb_ = ri ? ar : -ai;
                  const LAS f32x4* bp = (const LAS f32x4*)(Bb + (p * 16 + 8 * hh) * 2); float v[8];
#pragma unroll
                  for (int q = 0; q < 4; ++q) { const f32x4 bv = bp[q]; v[2 * q] = ca * bv[0] + cb_ * bv[1]; v[2 * q + 1] = ca * bv[2] + cb_ * bv[3]; }
                  u32x4 w; w.x = cvtpk(v[0], v[1]); w.y = cvtpk(v[2], v[3]); w.z = cvtpk(v[4], v[5]); w.w = cvtpk(v[6], v[7]); pf[sstep] = __builtin_bit_cast(bf16x8, w);
                  if ((sstep & 3) == 3) __builtin_amdgcn_sched_barrier(0); } }
            const int pst = 16 * mb + (r32 >> 1);
            const float sca = apow[(16 * 64 + pst) * 2], scb = (r32 & 1) ? apow[(16 * 64 + pst) * 2 + 1] : -apow[(16 * 64 + pst) * 2 + 1];
            const int sig = (r32 & 3) + 4 * (r32 >> 3) + 16 * ((r32 >> 2) & 1);
            float xc;
            { f32x16 acc;
#pragma unroll
              for (int r = 0; r < 16; ++r) acc[r] = 0.f;
#pragma unroll
              for (int sstep = 0; sstep < 16; ++sstep) { const bf16x8 bf = *(const bf16x8*)(UMB + (size_t)sstep * SW + g * 16 + 8 * hh); acc = __builtin_amdgcn_mfma_f32_32x32x16_bf16(bf, pf[sstep], acc, 0, 0, 0); }
              xc = acc[0]; }
            bf16x8 ufr[16];
            { const bf16_t* up = UB + (size_t)(b * SEQ + 16 * sig) * SW + g * 16 + 8 * hh;
#pragma unroll
              for (int sstep = 0; sstep < 16; ++sstep) ufr[sstep] = *(const bf16x8*)(up + (size_t)sstep * SW); }
#pragma unroll 1
            for (int cb = 0; cb < 8; ++cb) {
                f32x16 acc;
#pragma unroll
                for (int r = 0; r < 16; ++r) acc[r] = 0.f;
#pragma unroll
                for (int sstep = 0; sstep < 16; ++sstep) acc = __builtin_amdgcn_mfma_f32_32x32x16_bf16(ufr[sstep], pf[sstep], acc, 0, 0, 0);
                if (cb + 1 < 8) {
                    const bf16_t* up = UB + (size_t)(b * SEQ + 16 * (32 * (cb + 1) + sig)) * SW + g * 16 + 8 * hh;
#pragma unroll
                    for (int sstep = 0; sstep < 16; ++sstep) ufr[sstep] = *(const bf16x8*)(up + (size_t)sstep * SW);
                }
                float xin[16]; float xs_ = hh ? 0.f : xc;
#pragma unroll
                for (int r = 0; r < 16; ++r) { xin[r] = xs_; const float pv = dpp_f<0xB1>(xs_); xs_ = sca * xs_ + scb * pv + acc[r]; }
                float f = __shfl_xor(xs_, 32); if (!hh) f = 0.f;
#pragma unroll
                for (int r = 0; r < 16; ++r) { xin[r] += f; const float pv = dpp_f<0xB1>(f); f = sca * f + scb * pv; }
                xs_ += f;
                xc = __shfl_xor(xs_, 32);
                LAS bf16_t* xo = (LAS bf16_t*)(lds + L_XIN + cb * XBLK + (16 * hh) * XPITCH) + 32 * mb + r32;
#pragma unroll
                for (int r = 0; r < 16; ++r) xo[r * (XPITCH / 2)] = (bf16_t)f2bf(xin[r]);
            }
        }
        __syncthreads();
        if (probe == 4) return;
        {
            const int cb = wave, tl = r32 >> 4, c = r32 & 15;
            const size_t row0 = (size_t)(b * SEQ + 16 * (32 * cb + r32));
            bf16x8 ufr[16];
            { const bf16_t* up = UB + row0 * SW + g * 16 + 8 * hh;
#pragma unroll
              for (int ks = 0; ks < 16; ++ks) ufr[ks] = *(const bf16x8*)(up + (size_t)ks * SW); }
            bf16x8 kl[16];
#pragma unroll
            for (int d1 = 0; d1 < 16; ++d1) {
                const int tau = d1 - 1 + tl; float v[8];
                if (tau >= 0) { const LAS f32x4* kp = (const LAS f32x4*)(Kt + (tau * 16 + c) * 16 + 8 * hh); const f32x4 k0 = kp[0], k1 = kp[1];
                    v[0] = k0[0]; v[1] = k0[1]; v[2] = k0[2]; v[3] = k0[3]; v[4] = k1[0]; v[5] = k1[1]; v[6] = k1[2]; v[7] = k1[3]; }
                else {
#pragma unroll
                    for (int i = 0; i < 8; ++i) v[i] = 0.f; }
                u32x4 wv; wv.x = cvtpk(v[0], v[1]); wv.y = cvtpk(v[2], v[3]); wv.z = cvtpk(v[4], v[5]); wv.w = cvtpk(v[6], v[7]); kl[d1] = __builtin_bit_cast(bf16x8, wv);
                if ((d1 & 3) == 3) __builtin_amdgcn_sched_barrier(0);
            }
            const LAS unsigned char* xi_ = lds + L_XIN + cb * XBLK + r32 * XPITCH + 16 * hh;
#pragma unroll
            for (int mb = 0; mb < 8; ++mb) {
                int dq = 4 * hh; asm volatile("" : "+v"(dq));
                const f32x4 d0 = *(const LAS f32x4*)((LAS float*)(lds + L_DS) + dq), d1 = *(const LAS f32x4*)((LAS float*)(lds + L_DS) + dq + 8);
                const float dsk[8] = {d0[0], d0[1], d0[2], d0[3], d1[0], d1[1], d1[2], d1[3]};
                f32x16 acc;
#pragma unroll
                for (int r = 0; r < 16; ++r) acc[r] = 0.f;
#pragma unroll
                for (int ks = 0; ks < 16; ++ks) if (ks <= 2 * mb + 1) acc = __builtin_amdgcn_mfma_f32_32x32x16_bf16(kl[2 * mb - ks + 1], ufr[ks], acc, 0, 0, 0);
                int cq = c + 64 * hh; asm volatile("" : "+v"(cq));
#pragma unroll
                for (int ks = 0; ks < 8; ++ks) {
                    float v[8];
#pragma unroll
                    for (int i2 = 0; i2 < 4; ++i2) { const int p = 8 * ks + 4 * hh + i2;
                        const float c_r = Cc[(cq + 128 * ks + 16 * i2) * 2], c_i = Cc[(cq + 128 * ks + 16 * i2) * 2 + 1], ar = apow[((2 * mb + tl + 1) * 64 + p) * 2], ai = apow[((2 * mb + tl + 1) * 64 + p) * 2 + 1];
                        v[2 * i2] = c_r * ar - c_i * ai; v[2 * i2 + 1] = -(c_r * ai + c_i * ar); }
                    u32x4 wv; wv.x = cvtpk(v[0], v[1]); wv.y = cvtpk(v[2], v[3]); wv.z = cvtpk(v[4], v[5]); wv.w = cvtpk(v[6], v[7]);
                    acc = __builtin_amdgcn_mfma_f32_32x32x16_bf16(__builtin_bit_cast(bf16x8, wv), *(const LAS bf16x8*)(xi_ + 32 * ks), acc, 0, 0, 0);
                }
#pragma unroll
                for (int t2 = 0; t2 < 2; ++t2) {
                    const u32x4 uf = __builtin_bit_cast(u32x4, ufr[2 * mb + t2]);
                    const unsigned s0 = hh ? uf.x : uf.z, s1 = hh ? uf.y : uf.w;
                    const unsigned r0 = (unsigned)__shfl_xor((int)s0, 32), r1 = (unsigned)__shfl_xor((int)s1, 32);
                    const unsigned own0 = hh ? uf.z : uf.x, own1 = hh ? uf.w : uf.y;
                    const unsigned c0a = hh ? r0 : own0, c0b = hh ? r1 : own1, c1a = hh ? own0 : r0, c1b = hh ? own1 : r1;
                    const unsigned ua[2] = {c0a, c1a}, ub[2] = {c0b, c1b};
#pragma unroll
                    for (int ch = 0; ch < 2; ++ch) {
                        const size_t off = (row0 + 2 * mb + t2) * SW + g * 16 + 4 * hh + 8 * ch;
                        const float y0 = gelu_as(acc[8 * t2 + 4 * ch + 0] + dsk[4 * ch + 0] * bflo(ua[ch])), y1 = gelu_as(acc[8 * t2 + 4 * ch + 1] + dsk[4 * ch + 1] * bfhi(ua[ch]));
                        const float y2 = gelu_as(acc[8 * t2 + 4 * ch + 2] + dsk[4 * ch + 2] * bflo(ub[ch])), y3 = gelu_as(acc[8 * t2 + 4 * ch + 3] + dsk[4 * ch + 3] * bfhi(ub[ch]));
                        u32x2 o; o.x = cvtpk(y0, y1); o.y = cvtpk(y2, y3); *(u32x2*)(YS + off) = o;
                    }
                }
                __builtin_amdgcn_sched_barrier(0);
            }
        }
    }
}
}

namespace tk {
typedef float f32x16 __attribute__((ext_vector_type(16)));
__device__ __forceinline__ unsigned fkey(float f) { const unsigned u = __builtin_bit_cast(unsigned, f); return (u & 0x80000000u) ? ~u : (u | 0x80000000u); }
__device__ __forceinline__ float kval(unsigned k) { const unsigned u = (k & 0x80000000u) ? (k & 0x7fffffffu) : ~k; return __builtin_bit_cast(float, u); }
__device__ __forceinline__ void ce(unsigned& a, unsigned& b) { const unsigned hi = a > b ? a : b, lo = a > b ? b : a; a = hi; b = lo; }
template <int N> __device__ __forceinline__ void sort_desc(unsigned (&a)[N]) {
#pragma unroll
    for (int k = 2; k <= N; k <<= 1)
#pragma unroll
        for (int j = k >> 1; j > 0; j >>= 1)
#pragma unroll
            for (int i = 0; i < N; ++i) { const int l = i ^ j; if (l > i) { if ((i & k) == 0) ce(a[i], a[l]); else ce(a[l], a[i]); } }
}
__device__ __forceinline__ void merge_top16(unsigned (&a)[16], const unsigned (&b)[16]) {
#pragma unroll
    for (int i = 0; i < 16; ++i) a[i] = a[i] > b[15 - i] ? a[i] : b[15 - i];
#pragma unroll
    for (int j = 8; j > 0; j >>= 1)
#pragma unroll
        for (int i = 0; i < 16; ++i) { const int l = i ^ j; if (l > i) ce(a[i], a[l]); }
}
__device__ __forceinline__ void peer_topk_phase(const Args& A, LAS unsigned char* lds, int G) {
    const int tid = otid(), lane = tid & 63, wave = __builtin_amdgcn_readfirstlane(tid >> 6), r32 = lane & 31, hh = lane >> 5;
    unsigned char* ws = A.ws;
    const bf16_t* QP = (const bf16_t*)(ws + WS_QP); const bf16_t* K12 = (const bf16_t*)(ws + WS_K12); int* IDX = (int*)(ws + WS_IDX); float* GW = (float*)(ws + WS_GW);
    LAS unsigned* tl = (LAS unsigned*)(lds + wave * 8192);
    pg8::StaticOrder S5; S5.init(MTOK, DM, G, (int)blockIdx.x);
    pg8::Unit u5;
    for (int ui = 0; S5.next(ui, u5); ++ui) {
        const int h = u5.pn, tb = u5.pm * 8 + wave, tok = tb * 32 + r32;
        unsigned lst[2][16];
#pragma unroll
        for (int half = 0; half < 2; ++half) {
            const bf16_t* qp = QP + (size_t)tok * DM + h * 256 + half * 128 + 8 * hh;
            const bf16_t* kp = K12 + ((size_t)(half * 8 + h) * 128 + r32) * 128 + 8 * hh;
            bf16x8 qf[8];
#pragma unroll
            for (int ds = 0; ds < 8; ++ds) qf[ds] = *(const bf16x8*)(qp + 16 * ds);
            f32x16 sc[4];
#pragma unroll
            for (int kb = 0; kb < 4; ++kb) {
#pragma unroll
                for (int r = 0; r < 16; ++r) sc[kb][r] = 0.f;
#pragma unroll
                for (int ds = 0; ds < 8; ++ds) { const bf16x8 kf = *(const bf16x8*)(kp + (size_t)kb * 32 * 128 + 16 * ds); sc[kb] = __builtin_amdgcn_mfma_f32_32x32x16_bf16(kf, qf[ds], sc[kb], 0, 0, 0); }
            }
            unsigned g0[16], g1[16];
#pragma unroll
            for (int r = 0; r < 16; ++r) { const int kc = (r & 3) + 8 * (r >> 2) + 4 * hh; g0[r] = (fkey(sc[0][r]) & ~127u) | (unsigned)(127 - kc); g1[r] = (fkey(sc[1][r]) & ~127u) | (unsigned)(127 - 32 - kc); }
            sort_desc<16>(g0); sort_desc<16>(g1); merge_top16(g0, g1);
#pragma unroll
            for (int r = 0; r < 16; ++r) { const int kc = (r & 3) + 8 * (r >> 2) + 4 * hh; lst[half][r] = (fkey(sc[2][r]) & ~127u) | (unsigned)(127 - 64 - kc); g1[r] = (fkey(sc[3][r]) & ~127u) | (unsigned)(127 - 96 - kc); }
            sort_desc<16>(lst[half]); sort_desc<16>(g1); merge_top16(lst[half], g1); merge_top16(lst[half], g0);
        }
        unsigned mine[16], oth[16];
#pragma unroll
        for (int i = 0; i < 16; ++i) { const unsigned send = hh ? lst[0][i] : lst[1][i]; mine[i] = hh ? lst[1][i] : lst[0][i]; oth[i] = (unsigned)__shfl_xor((int)send, 32); }
        merge_top16(mine, oth);
#pragma unroll
        for (int i = 0; i < 16; ++i) tl[(16 * hh + i) * 64 + r32] = mine[i];
        asm volatile("s_waitcnt lgkmcnt(0)" ::: "memory");
        float v1[16], v2[16];
#pragma unroll
        for (int i = 0; i < 16; ++i) { v1[i] = kval(tl[i * 64 + r32] & ~127u); v2[i] = kval(tl[(16 + i) * 64 + r32] & ~127u); }
#define CKEY(i, j) ((fkey(v1[i] + v2[j]) & ~255u) | (unsigned)(255 - (16 * (i) + (j))))
        unsigned c0[16], c1[16];
#pragma unroll
        for (int j = 0; j < 16; ++j) c0[j] = CKEY(0, j);
#pragma unroll
        for (int j = 0; j < 8; ++j) c1[j] = CKEY(1, j);
#pragma unroll
        for (int j = 0; j < 5; ++j) c1[8 + j] = CKEY(2, j);
        c1[13] = CKEY(3, 0); c1[14] = CKEY(3, 1); c1[15] = CKEY(3, 2);
        sort_desc<16>(c1); merge_top16(c0, c1);
        c1[0] = CKEY(3, 3); c1[1] = CKEY(4, 0); c1[2] = CKEY(4, 1); c1[3] = CKEY(4, 2); c1[4] = CKEY(5, 0); c1[5] = CKEY(5, 1); c1[6] = CKEY(6, 0); c1[7] = CKEY(6, 1);
        c1[8] = CKEY(7, 0); c1[9] = CKEY(7, 1); c1[10] = CKEY(8, 0); c1[11] = CKEY(9, 0); c1[12] = CKEY(10, 0); c1[13] = CKEY(11, 0); c1[14] = CKEY(12, 0); c1[15] = CKEY(13, 0);
        sort_desc<16>(c1); merge_top16(c0, c1);
        c1[0] = CKEY(14, 0); c1[1] = CKEY(15, 0);
#pragma unroll
        for (int i = 2; i < 16; ++i) c1[i] = 0u;
        sort_desc<16>(c1); merge_top16(c0, c1);
#undef CKEY
        float ev[16], se = 0.f; const float mx = kval(c0[0] & ~255u);
#pragma unroll
        for (int k = 0; k < 16; ++k) { ev[k] = __expf(kval(c0[k] & ~255u) - mx); se += ev[k]; }
        const float inv = 1.0f / se;
        if (hh == 0) {
            int ex[16];
#pragma unroll
            for (int k = 0; k < 16; ++k) { const int cid = 255 - (int)(c0[k] & 255u), i = cid >> 4, j = cid & 15;
                const int e1 = 127 - (int)(tl[i * 64 + r32] & 127u), e2 = 127 - (int)(tl[(16 + j) * 64 + r32] & 127u); ex[k] = e1 * 128 + e2; }
            int* ip = IDX + (size_t)tok * 128 + h * 16;
#pragma unroll
            for (int k = 0; k < 16; k += 4) *(u32x4*)(ip + k) = (u32x4){(unsigned)ex[k], (unsigned)ex[k + 1], (unsigned)ex[k + 2], (unsigned)ex[k + 3]};
        } else {
            float* gp = GW + (size_t)tok * 128 + h * 16;
#pragma unroll
            for (int k = 0; k < 16; k += 4) *(f32x4*)(gp + k) = (f32x4){ev[k] * inv, ev[k + 1] * inv, ev[k + 2] * inv, ev[k + 3] * inv};
        }
        asm volatile("s_waitcnt lgkmcnt(0)" ::: "memory");
    }
}
}

#define XB_TMO      128
#define XB_XCNT(j)  (256  + 64 * (j))
#define XB_XSUB(j)  (1280 + 64 * (j))
#define XB_XGEN(j)  (2304 + 64 * (j))
#define XB_TOP      3328
#define XB_TOPGEN   3392
#define XCD_BAR_WORDS 3456
#define XB_SPIN_CAP (1u << 18)
__device__ __forceinline__ unsigned xb_ld(unsigned* p)              { return __hip_atomic_load(p, __ATOMIC_RELAXED, __HIP_MEMORY_SCOPE_AGENT); }
__device__ __forceinline__ unsigned xb_add(unsigned* p, unsigned v) { return __hip_atomic_fetch_add(p, v, __ATOMIC_RELAXED, __HIP_MEMORY_SCOPE_AGENT); }
__device__ __forceinline__ unsigned xb_xcc_id() { return (unsigned)__builtin_amdgcn_s_getreg((3 << 11) | 20) & 0xFu; }
#define XB_SPIN(cond, bar) do { unsigned _sp = 0; while (cond) { __builtin_amdgcn_s_sleep(1); \
    if ((++_sp & 255u) == 0u) { if (xb_ld(&(bar)[XB_TMO])) break; if (_sp > XB_SPIN_CAP) { atomicAdd(&(bar)[XB_TMO], 1u); break; } } } } while (0)
struct XcdBarrier { unsigned* bar; unsigned x; volatile LAS unsigned* st; };
__device__ __forceinline__ XcdBarrier xcd_barrier_post(unsigned* bar, volatile LAS unsigned* st) {
    XcdBarrier b; b.bar = bar; b.x = xb_xcc_id(); b.st = st;
    if (threadIdx.x == 0) (void)xb_add(&bar[XB_XCNT(b.x)], 1u);
    return b;
}
__device__ __forceinline__ void xcd_barrier_complete(unsigned* bar, unsigned x, unsigned& nloc, unsigned& nx) {
    const unsigned G = gridDim.x * gridDim.y * gridDim.z;
    unsigned sum, cnt, mine, sp = 0u;
    for (;;) {
        sum = 0u; cnt = 0u; mine = 0u;
#pragma unroll
        for (unsigned j = 0; j < 16; ++j) { const unsigned c = xb_ld(&bar[XB_XCNT(j)]); sum += c; cnt += (c > 0u) ? 1u : 0u; mine = (j == x) ? c : mine; }
        if (sum == G) break;
        __builtin_amdgcn_s_sleep(1);
        if ((++sp & 255u) == 0u) { if (xb_ld(&bar[XB_TMO])) break; if (sp > XB_SPIN_CAP) { atomicAdd(&bar[XB_TMO], 1u); break; } }
    }
    nloc = mine > 0u ? mine : 1u; nx = cnt > 0u ? cnt : 1u;
}
__device__ __forceinline__ void xcd_barrier(const XcdBarrier& b) {
    asm volatile("s_waitcnt vmcnt(0)" ::: "memory");
    __syncthreads();
    if (threadIdx.x == 0) {
        unsigned* bar = b.bar;
        __builtin_amdgcn_s_waitcnt(0);
        unsigned nloc = b.st[0], nx = b.st[1];
        if (nloc == 0u) { xcd_barrier_complete(bar, b.x, nloc, nx); b.st[0] = nloc; b.st[1] = nx; }
        const unsigned old = xb_add(&bar[XB_XSUB(b.x)], 1u);
        const unsigned gen = old / nloc;
        if (old + 1u == (gen + 1u) * nloc) {
            __builtin_amdgcn_fence(__ATOMIC_RELEASE, "agent");
            asm volatile("s_waitcnt vmcnt(0)" ::: "memory");
            const unsigned og = xb_add(&bar[XB_TOP], 1u);
            const unsigned tg = og / nx;
            if (og + 1u == (tg + 1u) * nx) xb_add(&bar[XB_TOPGEN], 1u);
            else XB_SPIN(xb_ld(&bar[XB_TOPGEN]) == tg, bar);
            __builtin_amdgcn_fence(__ATOMIC_ACQUIRE, "agent");
            xb_add(&bar[XB_XGEN(b.x)], 1u);
            asm volatile("s_waitcnt vmcnt(0)" ::: "memory");
        } else {
            XB_SPIN(xb_ld(&bar[XB_XGEN(b.x)]) == gen, bar);
            __builtin_amdgcn_fence(__ATOMIC_ACQUIRE, "agent");
            asm volatile("s_waitcnt vmcnt(0)" ::: "memory");
        }
    }
    __syncthreads();
}

namespace sg {
constexpr int NSL = 16, SLW = 128, TBK = 32, NTB = MTOK / TBK;
constexpr int CW_U = 8192, CW_V = 8192 + 64 * NSL;
template <int D> __device__ __forceinline__ float xsl(float a, float b, bool bit, int ln) { const float send = bit ? a : b, keep = bit ? b : a;
    return keep + __builtin_bit_cast(float, __builtin_amdgcn_ds_bpermute((ln ^ D) << 2, __builtin_bit_cast(int, send))); }
template <int D> __device__ __forceinline__ float xs(float a, float b, bool bit) { const float send = bit ? a : b, keep = bit ? b : a; return keep + __shfl_xor(send, D); }
__device__ __forceinline__ void quant_rows(const Args& A, int G) {
    const int tid = otid(), lane = tid & 63, wave = __builtin_amdgcn_readfirstlane(tid >> 6);
    unsigned char* ws = A.ws; const bf16_t* H2G = (const bf16_t*)(ws + WS_XN); const float* PARTSS = (const float*)(ws + WS_PARTSS);
    const int NW = G * NWAVES;
    for (int r0 = blockIdx.x * NWAVES + wave; r0 < MTOK; r0 += 4 * NW) {
        u32x4 hb[4][4]; float ssq[4];
#pragma unroll
        for (int q = 0; q < 4; ++q) { const int r = r0 + q * NW; const bool ok = r < MTOK; const u32x4* hp = (const u32x4*)(H2G + (size_t)(ok ? r : r0) * DM) + lane;
#pragma unroll
            for (int j = 0; j < 4; ++j) hb[q][j] = hp[64 * j];
            ssq[q] = (lane < 32) ? PARTSS[(size_t)lane * MTOK + (ok ? r : r0)] : 0.f; }
        asm volatile("" ::: "memory");
#pragma unroll
        for (int q = 0; q < 4; ++q) {
            const int r = r0 + q * NW; if (r >= MTOK) break;
            const float rs = rsqrtf(wave_sum(ssq[q]) * (1.0f / DM) + EPS);
            float hm = 0.f;
#pragma unroll
            for (int j = 0; j < 4; ++j) { hm = fmaxf(hm, fmaxf(fmaxf(fabsf(bflo(hb[q][j].x)), fabsf(bfhi(hb[q][j].x))), fmaxf(fabsf(bflo(hb[q][j].y)), fabsf(bfhi(hb[q][j].y)))));
                hm = fmaxf(hm, fmaxf(fmaxf(fabsf(bflo(hb[q][j].z)), fabsf(bfhi(hb[q][j].z))), fmaxf(fabsf(bflo(hb[q][j].w)), fabsf(bfhi(hb[q][j].w))))); }
            hm = wave_max(hm);
            const float hinv = hm > 0.f ? 127.0f / hm : 0.f;
            u32x2* dst = (u32x2*)(ws + WS_HQ + (size_t)r * DM) + lane;
#pragma unroll
            for (int j = 0; j < 4; ++j) { const unsigned wd[4] = {hb[q][j].x, hb[q][j].y, hb[q][j].z, hb[q][j].w}; u32x2 o;
#pragma unroll
                for (int h2 = 0; h2 < 2; ++h2) { const int q0 = (int)rintf(bflo(wd[2 * h2]) * hinv), q1 = (int)rintf(bfhi(wd[2 * h2]) * hinv), q2 = (int)rintf(bflo(wd[2 * h2 + 1]) * hinv), q3 = (int)rintf(bfhi(wd[2 * h2 + 1]) * hinv);
                    const unsigned pk = (unsigned)(q0 & 255) | ((unsigned)(q1 & 255) << 8) | ((unsigned)(q2 & 255) << 16) | ((unsigned)(q3 & 255) << 24); if (h2 == 0) o.x = pk; else o.y = pk; }
                dst[64 * j] = o; }
            if (lane == 0) ((float*)(ws + WS_HT))[r] = hm * (1.0f / 127.0f) * rs;
        }
    }
}
template <int NCOL>
__device__ __forceinline__ void quant_pass(const bf16_t* src, unsigned char* dst, float* sc, int G) {
    const int tid = otid(), lane = tid & 63, wave = __builtin_amdgcn_readfirstlane(tid >> 6);
    constexpr int NL = NCOL / 512;
    const int NW = G * NWAVES;
    for (int r0 = blockIdx.x * NWAVES + wave; r0 < MTOK; r0 += 4 * NW) {
        u32x4 hb[4][NL];
#pragma unroll
        for (int q = 0; q < 4; ++q) { const int r = r0 + q * NW; const bool ok = r < MTOK; const u32x4* hp = (const u32x4*)(src + (size_t)(ok ? r : r0) * NCOL) + lane;
#pragma unroll
            for (int j = 0; j < NL; ++j) hb[q][j] = hp[64 * j]; }
        asm volatile("" ::: "memory");
#pragma unroll
        for (int q = 0; q < 4; ++q) {
            const int r = r0 + q * NW; if (r >= MTOK) break;
            float hm = 0.f;
#pragma unroll
            for (int j = 0; j < NL; ++j) { hm = fmaxf(hm, fmaxf(fmaxf(fabsf(bflo(hb[q][j].x)), fabsf(bfhi(hb[q][j].x))), fmaxf(fabsf(bflo(hb[q][j].y)), fabsf(bfhi(hb[q][j].y)))));
                hm = fmaxf(hm, fmaxf(fmaxf(fabsf(bflo(hb[q][j].z)), fabsf(bfhi(hb[q][j].z))), fmaxf(fabsf(bflo(hb[q][j].w)), fabsf(bfhi(hb[q][j].w))))); }
            hm = wave_max(hm);
            const float hinv = hm > 0.f ? 127.0f / hm : 0.f;
            u32x2* d = (u32x2*)(dst + (size_t)r * NCOL) + lane;
#pragma unroll
            for (int j = 0; j < NL; ++j) { const unsigned wd[4] = {hb[q][j].x, hb[q][j].y, hb[q][j].z, hb[q][j].w}; u32x2 o;
#pragma unroll
                for (int h2 = 0; h2 < 2; ++h2) { const int q0 = (int)rintf(bflo(wd[2 * h2]) * hinv), q1 = (int)rintf(bfhi(wd[2 * h2]) * hinv), q2 = (int)rintf(bflo(wd[2 * h2 + 1]) * hinv), q3 = (int)rintf(bfhi(wd[2 * h2 + 1]) * hinv);
                    const unsigned pk = (unsigned)(q0 & 255) | ((unsigned)(q1 & 255) << 8) | ((unsigned)(q2 & 255) << 16) | ((unsigned)q3 << 24); if (h2 == 0) o.x = pk; else o.y = pk; }
                d[64 * j] = o; }
            if (lane == 0) sc[r] = hm * (1.0f / 127.0f);
        }
    }
}
__device__ __forceinline__ bool pop_item(unsigned* ctr, int xcd, int& si, int& slice, int& tb, volatile LAS int* bc) {
    for (;;) {
        if (si >= NSL) return false;
        const int s = (2 * xcd + si) & (NSL - 1);
        __syncthreads();
        if (threadIdx.x == 0) { const int pre = bc[1]; bc[0] = pre >= 0 ? pre : (int)__hip_atomic_fetch_add(ctr + 64 * s, 1u, __ATOMIC_RELAXED, __HIP_MEMORY_SCOPE_AGENT); bc[1] = -1; }
        __syncthreads();
        const int t = bc[0];
        if (t < NTB) { slice = s; tb = t;
            if (threadIdx.x == 0) bc[1] = (int)__hip_atomic_fetch_add(ctr + 64 * s, 1u, __ATOMIC_RELAXED, __HIP_MEMORY_SCOPE_AGENT);
            return true; }
        ++si;
    }
}
__device__ __forceinline__ void upass_phase(const Args& A, LAS unsigned char* lds, int G) {
    const int tid = otid(), lane = tid & 63, wave = __builtin_amdgcn_readfirstlane(tid >> 6), sub = lane >> 3, piece = lane & 7;
    unsigned char* ws = A.ws; const unsigned char* UQ = ws + WS_UE; const unsigned char* HQ = ws + WS_HQ; const int* IDX = (const int*)(ws + WS_IDX); float* AP = (float*)(ws + WS_APART);
    const bool b0 = (lane & 1) != 0, b1 = (lane & 2) != 0, b2 = (lane & 4) != 0;
    const int j0 = (b2 ? 2 : 0) + (b1 ? 4 : 0) + (b0 ? 8 : 0);
    const int xcd = (int)(xb_xcc_id() & 7u); int si = 0, slice, tb;
    volatile LAS int* bc = (volatile LAS int*)(lds + LDS_BYTES - 128);
    if (threadIdx.x == 0) bc[1] = -1;
    LAS unsigned* sidx = (LAS unsigned*)(lds + 16384 + wave * 4096);
    LAS u32x4* shq = (LAS u32x4*)(lds + 16384 + wave * 4096 + 2048);
    while (pop_item((unsigned*)(ws + WS_CTL) + CW_U, xcd, si, slice, tb, bc)) {
        { const int t0 = tb * TBK + wave;
#pragma unroll
          for (int i = 0; i < 4; ++i) { const u32x2 v = *((const u32x2*)(IDX + (size_t)(t0 + NWAVES * i) * 128) + lane); *(LAS u32x2*)(sidx + i * 128 + 2 * lane) = v; }
          if (lane < 32) { const int i = lane >> 3, pc = lane & 7; shq[lane] = *(const u32x4*)(HQ + (size_t)(t0 + NWAVES * i) * DM + slice * SLW + 16 * pc); }
          asm volatile("s_waitcnt vmcnt(0) lgkmcnt(0)" ::: "memory"); }
#define UP_G(buf, I, H) do { const u32x4 i0_ = *(const LAS u32x4*)(sidx + (I) * 128 + 16 * sub + 8 * (H)), i1_ = *(const LAS u32x4*)(sidx + (I) * 128 + 16 * sub + 8 * (H) + 4); \
            const unsigned ex_[8] = {i0_.x, i0_.y, i0_.z, i0_.w, i1_.x, i1_.y, i1_.z, i1_.w}; \
            _Pragma("unroll") for (int j_ = 0; j_ < 8; ++j_) buf[j_] = *(const u32x4*)(UQ + (size_t)ex_[j_] * DM + slice * SLW + 16 * piece); \
            asm volatile("" ::: "memory"); } while (0)
#define UP_C(vv, buf, I) do { const u32x4 hq_ = shq[(I) * 8 + piece]; _Pragma("unroll") for (int j_ = 0; j_ < 8; ++j_) { \
            int sd_ = __builtin_amdgcn_sdot4((int)buf[j_].x, (int)hq_.x, 0, false); sd_ = __builtin_amdgcn_sdot4((int)buf[j_].y, (int)hq_.y, sd_, false); \
            sd_ = __builtin_amdgcn_sdot4((int)buf[j_].z, (int)hq_.z, sd_, false); sd_ = __builtin_amdgcn_sdot4((int)buf[j_].w, (int)hq_.w, sd_, false); vv[j_] = (float)sd_; } } while (0)
#define UP_F(I) do { float w8_[8], w4_[4], w2_[2]; \
            _Pragma("unroll") for (int q_ = 0; q_ < 8; ++q_) w8_[q_] = xs<1>(vlo[q_], vhi[q_], b0); \
            _Pragma("unroll") for (int q_ = 0; q_ < 4; ++q_) w4_[q_] = xs<2>(w8_[q_], w8_[q_ + 4], b1); \
            _Pragma("unroll") for (int q_ = 0; q_ < 2; ++q_) w2_[q_] = xs<4>(w4_[q_], w4_[q_ + 2], b2); \
            *(f32x2*)(AP + ((size_t)slice * MTOK + tb * TBK + wave + NWAVES * (I)) * 128 + 16 * sub + j0) = (f32x2){w2_[0], w2_[1]}; } while (0)
        { u32x4 bufA[8], bufB[8]; float vlo[8], vhi[8];
          UP_G(bufA, 0, 0); UP_G(bufB, 0, 1);
          UP_C(vlo, bufA, 0); UP_G(bufA, 1, 0);
          UP_C(vhi, bufB, 0); UP_G(bufB, 1, 1); UP_F(0);
          UP_C(vlo, bufA, 1); UP_G(bufA, 2, 0);
          UP_C(vhi, bufB, 1); UP_G(bufB, 2, 1); UP_F(1);
          UP_C(vlo, bufA, 2); UP_G(bufA, 3, 0);
          UP_C(vhi, bufB, 2); UP_G(bufB, 3, 1); UP_F(2);
          UP_C(vlo, bufA, 3);
          UP_C(vhi, bufB, 3); UP_F(3); }
#undef UP_G
#undef UP_C
#undef UP_F
    }
}
__device__ __forceinline__ void combine_phase(const Args& A, int G) {
    const int tid = otid(), lane = tid & 63, wave = __builtin_amdgcn_readfirstlane(tid >> 6);
    unsigned char* ws = A.ws; const float* AP = (const float*)(ws + WS_APART); const int* IDX = (const int*)(ws + WS_IDX); float* GW = (float*)(ws + WS_GW);
    const float* SU = (const float*)(ws + WS_SU); const float* SV = (const float*)(ws + WS_SV); const float* HT = (const float*)(ws + WS_HT);
    for (int tok = blockIdx.x * NWAVES + wave; tok < MTOK; tok += G * NWAVES) {
        const float tsc = HT[tok];
#pragma unroll
        for (int hf = 0; hf < 2; ++hf) { const int k = lane + 64 * hf; float a = 0.f;
#pragma unroll
            for (int sl = 0; sl < NSL; ++sl) a += __builtin_nontemporal_load(AP + ((size_t)sl * MTOK + tok) * 128 + k);
            const int e = IDX[(size_t)tok * 128 + k];
            GW[(size_t)tok * 128 + k] = GW[(size_t)tok * 128 + k] * gelu_exact(a * SU[e] * tsc) * SV[e]; }
    }
}
__device__ __forceinline__ void vpass_phase(const Args& A, LAS unsigned char* lds, int G) {
    const int tid = otid(), lane = tid & 63, wave = __builtin_amdgcn_readfirstlane(tid >> 6);
    unsigned char* ws = A.ws; const unsigned char* VQ = ws + WS_VE; const int* IDX = (const int*)(ws + WS_IDX); const float* GW = (const float*)(ws + WS_GW);
    const bf16_t* H2B = (const bf16_t*)(ws + WS_XN); float* OUT = A.out;
    const int xcd = (int)(xb_xcc_id() & 7u); int si = 0, slice, tb;
    volatile LAS int* bc = (volatile LAS int*)(lds + LDS_BYTES - 128);
    if (threadIdx.x == 0) bc[1] = -1;
    LAS unsigned* sidx = (LAS unsigned*)(lds + 16384 + wave * 4096);
    LAS float* sw = (LAS float*)(lds + 16384 + wave * 4096 + 2048);
    while (pop_item((unsigned*)(ws + WS_CTL) + CW_V, xcd, si, slice, tb, bc)) {
        int ln = (int)threadIdx.x; asm volatile("" : "+v"(ln)); ln &= 63;
        const int sub = ln >> 3, piece = ln & 7; const bool b3 = (ln & 8) != 0, b4 = (ln & 16) != 0, b5 = (ln & 32) != 0;
        const int c0 = (b5 ? 2 : 0) + (b4 ? 4 : 0) + (b3 ? 8 : 0);
        { const int t0 = tb * TBK + wave;
#pragma unroll
          for (int i = 0; i < 4; ++i) { const u32x2 v = *((const u32x2*)(IDX + (size_t)(t0 + NWAVES * i) * 128) + ln); *(LAS u32x2*)(sidx + i * 128 + 2 * ln) = v;
              const f32x2 g = *((const f32x2*)(GW + (size_t)(t0 + NWAVES * i) * 128) + ln); *(LAS f32x2*)(sw + i * 128 + 2 * ln) = g; }
          asm volatile("s_waitcnt vmcnt(0) lgkmcnt(0)" ::: "memory"); }
        const unsigned colb = (unsigned)(slice * SLW + 16 * piece);
#define VP_G(buf, I, H) do { const u32x4 i0_ = *(const LAS u32x4*)(sidx + (I) * 128 + 16 * sub + 8 * (H)), i1_ = *(const LAS u32x4*)(sidx + (I) * 128 + 16 * sub + 8 * (H) + 4); \
            const unsigned ex_[8] = {i0_.x, i0_.y, i0_.z, i0_.w, i1_.x, i1_.y, i1_.z, i1_.w}; \
            _Pragma("unroll") for (int j_ = 0; j_ < 8; ++j_) buf[j_] = *(const u32x4*)(VQ + (ex_[j_] * (unsigned)DM + colb)); \
            asm volatile("" ::: "memory"); } while (0)
#define VP_H(hv, I) do { hv = *(const unsigned*)((const unsigned char*)H2B + (((unsigned)(tb * TBK + wave + NWAVES * (I)) * (unsigned)DM + colb + c0) * 2u)); asm volatile("" ::: "memory"); } while (0)
#define VP_C(buf, I, H) do { const f32x4 w0_ = *(const LAS f32x4*)(sw + (I) * 128 + 16 * sub + 8 * (H)), w1_ = *(const LAS f32x4*)(sw + (I) * 128 + 16 * sub + 8 * (H) + 4); \
            const float wk_[8] = {w0_[0], w0_[1], w0_[2], w0_[3], w1_[0], w1_[1], w1_[2], w1_[3]}; \
            _Pragma("unroll") for (int j_ = 0; j_ < 8; ++j_) { const unsigned wd_[4] = {buf[j_].x, buf[j_].y, buf[j_].z, buf[j_].w}; \
                _Pragma("unroll") for (int d_ = 0; d_ < 4; ++d_) { const f32x2 lo_ = __builtin_amdgcn_cvt_pk_f32_fp8((int)wd_[d_], false), hi_ = __builtin_amdgcn_cvt_pk_f32_fp8((int)wd_[d_], true); \
                    acc[4 * d_] += wk_[j_] * lo_.x; acc[4 * d_ + 1] += wk_[j_] * lo_.y; acc[4 * d_ + 2] += wk_[j_] * hi_.x; acc[4 * d_ + 3] += wk_[j_] * hi_.y; } } } while (0)
#define VP_F(hv, I) do { float w8_[8], w4_[4], w2_[2]; \
            _Pragma("unroll") for (int q_ = 0; q_ < 8; ++q_) w8_[q_] = xsl<8>(acc[q_], acc[q_ + 8], b3, ln); \
            _Pragma("unroll") for (int q_ = 0; q_ < 4; ++q_) w4_[q_] = xsl<16>(w8_[q_], w8_[q_ + 4], b4, ln); \
            _Pragma("unroll") for (int q_ = 0; q_ < 2; ++q_) w2_[q_] = xsl<32>(w4_[q_], w4_[q_ + 2], b5, ln); \
            *(f32x2*)((unsigned char*)OUT + (((unsigned)(tb * TBK + wave + NWAVES * (I)) * (unsigned)DM + colb + c0) * 4u)) = (f32x2){bflo(hv) + w2_[0], bfhi(hv) + w2_[1]}; \
            _Pragma("unroll") for (int c_ = 0; c_ < 16; ++c_) acc[c_] = 0.f; } while (0)
        { u32x4 bufA[8], bufB[8]; unsigned hv; float acc[16];
#pragma unroll
          for (int c = 0; c < 16; ++c) acc[c] = 0.f;
          VP_G(bufA, 0, 0); VP_G(bufB, 0, 1);
          VP_C(bufA, 0, 0); VP_G(bufA, 1, 0);
          VP_C(bufB, 0, 1); VP_H(hv, 0); VP_G(bufB, 1, 1); VP_F(hv, 0);
          VP_C(bufA, 1, 0); VP_G(bufA, 2, 0);
          VP_C(bufB, 1, 1); VP_H(hv, 1); VP_G(bufB, 2, 1); VP_F(hv, 1);
          VP_C(bufA, 2, 0); VP_G(bufA, 3, 0);
          VP_C(bufB, 2, 1); VP_H(hv, 2); VP_G(bufB, 3, 1); VP_F(hv, 2);
          VP_C(bufA, 3, 0);
          VP_C(bufB, 3, 1); VP_H(hv, 3); VP_F(hv, 3); }
#undef VP_G
#undef VP_H
#undef VP_C
#undef VP_F
    }
}
}


#ifndef GATHER_VER
#define GATHER_VER 2
#endif
constexpr int NPHASE = (GATHER_VER == 2) ? 10 : 8;
__global__ void __launch_bounds__(NTHREADS, 2) mega_fwd(Args args) {
    extern __shared__ __attribute__((aligned(16))) unsigned char lds_raw[];
    LAS unsigned char* lds = (LAS unsigned char*)lds_raw;
    const int G = gridDim.x;
    unsigned char* ws = args.ws;
    const int lo = args.ph_lo, hi = args.ph_hi;
#ifndef PHASE_MASK
#define PHASE_MASK 0x3FF
#endif
#ifndef REPEAT_MASK
#define REPEAT_MASK 0x00
#endif
#define NREP(k) (((REPEAT_MASK >> (k)) & 1) ? 2 : 1)
#define IN(k) (lo <= (k) && (k) < hi && ((PHASE_MASK >> (k)) & 1))
#ifndef CG_SEAMS
#define CG_SEAMS 0
#endif
    volatile LAS unsigned* xst = (volatile LAS unsigned*)(lds + LDS_BYTES - 64);
    if (threadIdx.x < 2) xst[threadIdx.x] = 0u;
    __syncthreads();
    XcdBarrier xbar = xcd_barrier_post((unsigned*)(ws + WS_CTL) + 64, xst);
#define SEAM_IN(k) do { if (IN(k)) { if (CG_SEAMS) cg::this_grid().sync(); else xcd_barrier(xbar); } } while (0)
#define SEAM(k) do { if (IN(k) && IN((k) + 1)) { if (CG_SEAMS) cg::this_grid().sync(); else xcd_barrier(xbar); } } while (0)
    if (IN(0)) for (int rep_ = 0; rep_ < NREP(0); ++rep_) { p0_prologue<0>(args, lds, G, args.probe); }
    SEAM(0);
    if (IN(1)) for (int rep_ = 0; rep_ < NREP(1); ++rep_) {
        p1_meta_finish(args, lds, G);
        __syncthreads();
        pg8::Gemm g{(const bf16_t*)(ws + WS_XN), (const bf16_t*)(ws + WS_WTIN), MTOK, INW, DM / 2, nullptr, nullptr, (const float*)(ws + WS_SXA), (const float*)(ws + WS_SWB)}; pg8::StaticOrder S; S.init(MTOK, INW, G, (int)blockIdx.x);
        Epi1 E{(bf16_t*)(ws + WS_Q), (bf16_t*)(ws + WS_K), (bf16_t*)(ws + WS_V), (bf16_t*)(ws + WS_GA), (bf16_t*)(ws + WS_GB), nullptr, (const float*)(ws + WS_CS), args.in[I_QNG], args.in[I_KNG], (bf16_t*)(ws + WS_UB)};
        pg8::gemm_phase<Epi1, pg8::StaticOrder, true, GEMM_SP2>(lds, g, S, E);
    }
    SEAM(1);
    if (IN(2)) for (int rep_ = 0; rep_ < NREP(2); ++rep_) {
#ifndef REP_SSM
#define REP_SSM 1
#endif
#ifndef REP_ATT
#define REP_ATT 1
#endif
        if (args.probe == 0 && blockIdx.x >= 128) p0_prologue<1>(args, lds, G, 0);
        if (args.probe != 2) for (int q_ = 0; q_ < REP_SSM; ++q_) ssm::ssm_mm_phase(args, lds, G, args.probe);
        __syncthreads();
        if (args.probe == 0 || args.probe == 2) for (int q_ = 0; q_ < REP_ATT; ++q_) att::attn_phase(args, lds, G);
    }
    SEAM(2);
    if (IN(3)) {
        sg::quant_pass<SW>((const bf16_t*)(ws + WS_YS), ws + WS_YS8, (float*)(ws + WS_SYS), G);
        sg::quant_pass<AW>((const bf16_t*)(ws + WS_ATT), ws + WS_AT8, (float*)(ws + WS_SAT), G);
        SEAM_IN(3);
    }
    if (IN(3)) for (int rep_ = 0; rep_ < NREP(3); ++rep_) {
        pg8::Gemm g{(const bf16_t*)(ws + WS_YS8), (const bf16_t*)(ws + WS_WTGLU), MTOK, 2 * DM, SW / 2, (const bf16_t*)(ws + WS_AT8), (const bf16_t*)(ws + WS_WTATT),
                    (const float*)(ws + WS_SYS), (const float*)(ws + WS_SWG), (const float*)(ws + WS_SAT), (const float*)(ws + WS_SWA)};
        pg8::P3Order S; S.base.init(MTOK, DM, G, (int)blockIdx.x);
        EpiP3 E{EpiGlu{(const bf16_t*)(ws + WS_GB), (bf16_t*)(ws + WS_YB)}, EpiMix{(const bf16_t*)(ws + WS_GA), (const bf16_t*)(ws + WS_YB), (bf16_t*)(ws + WS_MIX)}};
        pg8::gemm_phase<EpiP3, pg8::P3Order, true, GEMM_SP2>(lds, g, S, E);
    }
    SEAM(3);
    if (IN(4)) { sg::quant_pass<DM>((const bf16_t*)(ws + WS_MIX), ws + WS_MIX8, (float*)(ws + WS_SMX), G); SEAM_IN(4); }
    if (IN(4)) for (int rep_ = 0; rep_ < NREP(4); ++rep_) {
        pg8::Gemm g{(const bf16_t*)(ws + WS_MIX8), (const bf16_t*)(ws + WS_WTOUT), MTOK, DM, DM / 2, nullptr, nullptr, (const float*)(ws + WS_SMX), (const float*)(ws + WS_SWO)}; pg8::StaticOrder S; S.init(MTOK, DM, G, (int)blockIdx.x);
        EpiOut E{args.in[I_X], (bf16_t*)(ws + WS_XN), (float*)(ws + WS_PARTSS)};
        pg8::gemm_phase<EpiOut, pg8::StaticOrder, true, GEMM_SP2>(lds, g, S, E);
    }
    SEAM(4);
    if (IN(6)) { sg::quant_rows(args, G); }
    SEAM(5);
    if (IN(5)) for (int rep_ = 0; rep_ < NREP(5); ++rep_) {
        pg8::Gemm g{(const bf16_t*)(ws + WS_HQ), (const bf16_t*)(ws + WS_WTQ), MTOK, DM, DM / 2, nullptr, nullptr, (const float*)(ws + WS_HT), (const float*)(ws + WS_SWQ)}; pg8::StaticOrder S; S.init(MTOK, DM, G, (int)blockIdx.x);
        EpiQP E{(bf16_t*)(ws + WS_QP)};
        pg8::gemm_phase<EpiQP, pg8::StaticOrder, true, GEMM_SP2>(lds, g, S, E);
        asm volatile("s_waitcnt vmcnt(0)" ::: "memory");
        __syncthreads();
        tk::peer_topk_phase(args, lds, G);
    }
    SEAM(6);
#if GATHER_VER == 2
    if (IN(7)) { sg::upass_phase(args, lds, G); }
    SEAM(7);
    if (IN(8)) for (int rep_ = 0; rep_ < NREP(8); ++rep_) { sg::combine_phase(args, G); }
    SEAM(8);
    if (IN(9)) { sg::vpass_phase(args, lds, G); }
#endif
#undef IN
#undef SEAM
}

extern "C" void kernel_launch(void* const* d_in, const int* in_sizes, int n_in, void* d_out, int out_size, void* d_ws, size_t ws_size, hipStream_t stream) {
    static int grid = 0;
    if (grid == 0) {
        if (n_in != 28 || out_size != MTOK * DM || ws_size < WS_END) { fprintf(stderr, "kernel_launch: unexpected problem (n_in %d out %d ws %zu, need %zu)\n", n_in, out_size, ws_size, (size_t)WS_END); grid = -1; return; }
        int dev = 0, cus = 0, per_cu = 0;
        (void)hipGetDevice(&dev); (void)hipDeviceGetAttribute(&cus, hipDeviceAttributeMultiprocessorCount, dev);
        if (hipFuncSetAttribute((const void*)mega_fwd, hipFuncAttributeMaxDynamicSharedMemorySize, LDS_BYTES) != hipSuccess) { fprintf(stderr, "kernel_launch: hipFuncSetAttribute failed\n"); grid = -1; return; }
        (void)hipOccupancyMaxActiveBlocksPerMultiprocessor(&per_cu, (const void*)mega_fwd, NTHREADS, LDS_BYTES);
        (void)hipGetLastError();
        if (per_cu < 1) { fprintf(stderr, "kernel_launch: occupancy query says %d blocks/CU\n", per_cu); per_cu = 1; }
        if (cus < 192) { fprintf(stderr, "kernel_launch: needs >= 192 CUs (SSM items on workgroups 0..127, deferred prologue work on the rest)\n"); grid = -1; return; }
        grid = cus;
        fprintf(stderr, "kernel_launch: grid %d (cus %d, per_cu %d), ws %zu MiB\n", grid, cus, per_cu, ws_size >> 20);
    }
    if (grid < 0) return;
    if (hipMemsetAsync((char*)d_ws + WS_CTL, 0, 64 * 1024, stream) != hipSuccess) { fprintf(stderr, "kernel_launch: memset of the control words failed\n"); return; }
    Args a{};
    for (int i = 0; i < 28; ++i) a.in[i] = (const float*)d_in[i];
    a.out = (float*)d_out; a.ws = (unsigned char*)d_ws;
#if MK_SINGLE
    a.ph_lo = 0; a.ph_hi = NPHASE;
    void* kargs[] = {&a};
    hipError_t e = hipLaunchCooperativeKernel((const void*)mega_fwd, dim3(grid), dim3(NTHREADS), kargs, LDS_BYTES, stream);
    if (e != hipSuccess) fprintf(stderr, "cooperative launch failed: %s (grid %d)\n", hipGetErrorString(e), grid);
#else
#ifndef PROBE_PHASE
#define PROBE_PHASE -1
#endif
    for (int p = 0; p < NPHASE; ++p) {
        a.ph_lo = p; a.ph_hi = p + 1;
#ifndef PROBE_SUB
#define PROBE_SUB 0
#endif
        for (int rep = 0; rep < (p == PROBE_PHASE ? 2 : 1); ++rep) { a.probe = (rep == 1) ? PROBE_SUB : 0;
            if (rep == 1) (void)hipMemsetAsync((char*)d_ws + WS_CTL + 32768, 0, 16384, stream);
            hipLaunchKernelGGL(mega_fwd, dim3(grid), dim3(NTHREADS), LDS_BYTES, stream, a); }
    }
#endif
}
```

```cpp
#include <hip/hip_runtime.h>
#include <hip/hip_cooperative_groups.h>
#include <cstdio>
#include <cstdint>
namespace cg = cooperative_groups;

#ifndef GEMM_SP2
#define GEMM_SP2 true
#endif
#ifndef MK_SINGLE
#define MK_SINGLE 1
#endif

#define LAS __attribute__((address_space(3)))
typedef unsigned short bf16_t;
typedef short bf16x8 __attribute__((ext_vector_type(8)));
typedef float f32x4 __attribute__((ext_vector_type(4)));
typedef float f32x2 __attribute__((ext_vector_type(2)));
typedef unsigned u32x4 __attribute__((ext_vector_type(4)));
typedef int i32x4 __attribute__((ext_vector_type(4)));
typedef unsigned u32x2 __attribute__((ext_vector_type(2)));
typedef __bf16 bf16x2_t __attribute__((ext_vector_type(2)));

constexpr int DM = 2048, SEQ = 4096, NMETA = 16, MTOK = 2 * SEQ, NPOS = SEQ + NMETA;
constexpr int AW = 1024, SW = 1024, INW = 8192;
constexpr float EPS = 1e-6f;
constexpr float LOG2E = 1.4426950408889634f;
constexpr float QSCALE = 0.125f * LOG2E;
constexpr float LAM_INIT = 0.2f;
constexpr int NEXP = 16384;

constexpr size_t MiB = 1u << 20;
constexpr size_t WS_CTL = 0;
constexpr size_t WS_WTIN = 1 * MiB;
constexpr size_t WS_WTATT = WS_WTIN + 32 * MiB;
constexpr size_t WS_WTGLU = WS_WTATT + 4 * MiB;
constexpr size_t WS_WTOUT = WS_WTGLU + 8 * MiB;
constexpr size_t WS_WTQ = WS_WTOUT + 8 * MiB;
constexpr size_t WS_UE = WS_WTQ + 8 * MiB;
constexpr size_t WS_VE = WS_UE + 64 * MiB;
constexpr size_t WS_XN = WS_VE + 64 * MiB;
constexpr size_t WS_Q = WS_XN + 32 * MiB;
constexpr size_t WS_K = WS_Q + 16 * MiB;
constexpr size_t WS_V = WS_K + 16 * MiB;
constexpr size_t WS_MIX = WS_Q;
constexpr size_t WS_U = WS_V + 16 * MiB;
constexpr size_t WS_QP = WS_U;
constexpr size_t WS_GA = WS_U + 32 * MiB;
constexpr size_t WS_GB = WS_GA + 32 * MiB;
constexpr size_t WS_ATT = WS_GB + 32 * MiB;
constexpr size_t WS_YS = WS_ATT + 16 * MiB;
constexpr size_t WS_YB = WS_YS + 16 * MiB;
constexpr size_t WS_IDX = WS_YB + 32 * MiB;
constexpr size_t WS_GW = WS_IDX + 4 * MiB;
constexpr size_t WS_MISC = WS_GW + 4 * MiB;
constexpr size_t WS_PARTSS = WS_MISC;
constexpr size_t WS_CS = WS_PARTSS + 1 * MiB;
constexpr size_t WS_MPART = WS_CS + 2 * MiB;
constexpr size_t WS_KM = WS_MPART + 2 * MiB;
constexpr size_t WS_VM = WS_KM + 128 * 1024;
constexpr size_t WS_UM = WS_VM + 128 * 1024;
constexpr size_t WS_ABAR = WS_UM + 64 * 1024;
constexpr size_t WS_BBAR = WS_ABAR + 32 * 1024;
constexpr size_t WS_PAR = WS_BBAR + 512 * 1024;
constexpr size_t WS_SU = WS_PAR + 64 * 1024;
constexpr size_t WS_SV = WS_SU + 64 * 1024;
constexpr size_t WS_K12 = WS_SV + 64 * 1024;
constexpr size_t WS_UMB = WS_K12 + 512 * 1024;
constexpr size_t WS_UB = WS_UMB + 64 * 1024;
constexpr size_t WS_HT = WS_UB + 16 * MiB;
constexpr size_t WS_MP32 = WS_HT + 64 * 1024;
constexpr size_t WS_SXA = WS_MP32 + 6 * MiB;
constexpr size_t WS_SWB = WS_SXA + 64 * 1024;
constexpr size_t WS_SWQ = WS_SWB + 64 * 1024;
constexpr size_t WS_SWG = WS_SWQ + 64 * 1024;
constexpr size_t WS_SWA = WS_SWG + 64 * 1024;
constexpr size_t WS_SWO = WS_SWA + 64 * 1024;
constexpr size_t WS_SYS = WS_SWO + 64 * 1024;
constexpr size_t WS_SAT = WS_SYS + 64 * 1024;
constexpr size_t WS_SMX = WS_SAT + 64 * 1024;
constexpr size_t WS_END = WS_SMX + 64 * 1024;
constexpr size_t WS_YS8 = WS_V;
constexpr size_t WS_AT8 = WS_V + 8 * MiB;
constexpr size_t WS_MIX8 = WS_V;
constexpr size_t WS_HQ = WS_ATT;
constexpr size_t WS_APART = WS_Q;
constexpr size_t WS_H2 = WS_GA;

__device__ __forceinline__ unsigned f2bf(float f) { unsigned u = __builtin_bit_cast(unsigned, f); return (u + 0x7fffu + ((u >> 16) & 1u)) >> 16; }
__device__ __forceinline__ unsigned pk2(float lo, float hi) { return f2bf(lo) | (f2bf(hi) << 16); }
__device__ __forceinline__ float bf2f(unsigned short h) { return __builtin_bit_cast(float, (unsigned)h << 16); }
__device__ __forceinline__ float bflo(unsigned w) { return __builtin_bit_cast(float, w << 16); }
__device__ __forceinline__ float bfhi(unsigned w) { return __builtin_bit_cast(float, w & 0xffff0000u); }
__device__ __forceinline__ int otid() { int t = threadIdx.x; asm volatile("" : "+v"(t)); return t; }
template <int CTRL> __device__ __forceinline__ float dpp_f(float v) { return __builtin_bit_cast(float, __builtin_amdgcn_update_dpp(0, __builtin_bit_cast(int, v), CTRL, 0xF, 0xF, true)); }
__device__ __forceinline__ float row_sum16(float v) { v += dpp_f<0x128>(v); v += dpp_f<0x124>(v); v += dpp_f<0x122>(v); v += dpp_f<0x121>(v); return v; }
__device__ __forceinline__ float wave_sum(float v) { v = row_sum16(v); v += __shfl_xor(v, 16); v += __shfl_xor(v, 32); return v; }
__device__ __forceinline__ float wave_max(float v) {
#pragma unroll
    for (int o = 1; o < 64; o <<= 1) v = fmaxf(v, __shfl_xor(v, o));
    return v;
}
__device__ __forceinline__ float sigmoidf_(float x) { return __builtin_amdgcn_rcpf(1.0f + __builtin_amdgcn_exp2f(x * -1.4426950408889634f)); }
__device__ __forceinline__ float gelu_exact(float x) { return 0.5f * x * (1.0f + erff(x * 0.70710678118654752f)); }
__device__ __forceinline__ float dot2bf(unsigned a, unsigned b, float acc) { return __builtin_amdgcn_fdot2_f32_bf16(__builtin_bit_cast(bf16x2_t, a), __builtin_bit_cast(bf16x2_t, b), acc, false); }

namespace pg8 {
#define PG8_LAS __attribute__((address_space(3)))
constexpr int BM = 256, BK = 64, HALF = 128, HTB = HALF * BK * 2, STAGE_BYTES = 8 * HTB, NXCD = 8, WGM = 8;
__host__ __device__ __forceinline__ int lds_byte(int r, int c) { const int st = (r >> 4) * 2 + (c >> 5), rr = r & 15, cc = c & 31, ob = rr * 64 + cc * 2; return st * 1024 + (ob ^ (((ob >> 9) & 1) << 5)); }
__host__ __device__ __forceinline__ void stage_rc(int b, int& R, int& C) { const int st = b / 1024, sb = b % 1024, swz = sb ^ (((sb >> 9) & 1) << 5); R = (st >> 1) * 16 + swz / 64; C = (st & 1) * 32 + (swz % 64) / 2; }
__host__ __device__ __forceinline__ int perm32(int rho) { const int n = rho >> 4, i = rho & 15; return 8 * (i >> 2) + 4 * n + (i & 3); }
struct Unit { int pm, pn, sel; };
struct Gemm { const bf16_t* A; const bf16_t* Bt; int M, N, K; const bf16_t* A2 = nullptr; const bf16_t* Bt2 = nullptr; const float* sa = nullptr; const float* sb = nullptr; const float* sa2 = nullptr; const float* sb2 = nullptr; };
struct StaticOrder {
    int nM, nN, nwg, G, c;
    __host__ __device__ __forceinline__ void init(int M, int N, int G_, int c_) { nM = M / BM; nN = N / BM; nwg = nM * nN; G = G_; c = c_; }
    __host__ __device__ __forceinline__ bool next(int i, Unit& u) const {
        const long L = (long)i * G + c; if (L >= nwg) return false;
        int wgid = (int)L; { const int q = nwg / NXCD, r = nwg % NXCD, xcd = wgid % NXCD, off = wgid / NXCD; wgid = (xcd < r ? xcd * (q + 1) : r * (q + 1) + (xcd - r) * q) + off; }
        const int nig = WGM * nN, gid = wgid / nig, fm = gid * WGM, gsz = (nM - fm) < WGM ? (nM - fm) : WGM;
        u.pm = fm + ((wgid % nig) % gsz); u.pn = (wgid % nig) / gsz; u.sel = 0; return true;
    }
    __device__ __forceinline__ void a_ready(const Unit&) const {}
    __device__ __forceinline__ void done(const Unit&) const {}
};
struct GluOrder {
    StaticOrder base;
    __device__ __forceinline__ bool next(int i, Unit& u) const { Unit b; if (!base.next(i >> 1, b)) return false; u.pm = b.pm; u.pn = 2 * b.pn + (i & 1); u.sel = 0; return true; }
    __device__ __forceinline__ void a_ready(const Unit&) const {}
    __device__ __forceinline__ void done(const Unit&) const {}
};

struct P3Order {
    StaticOrder base;
    __device__ __forceinline__ bool next(int i, Unit& u) const { Unit b; const int r = i / 3, j = i - 3 * r; if (!base.next(r, b)) return false;
        u.pm = b.pm; u.pn = (j < 2) ? 2 * b.pn + j : b.pn; u.sel = (j == 2) ? 1 : 0; return true; }
    __device__ __forceinline__ void a_ready(const Unit&) const {}
    __device__ __forceinline__ void done(const Unit&) const {}
};
template <class Epi, class Sched, bool ALIGN_EPI = false, bool SP2 = false>
__device__ __forceinline__ void gemm_phase(PG8_LAS unsigned char* lds, const Gemm g, const Sched& S, const Epi& E) {
    const int tid = threadIdx.x, wid = __builtin_amdgcn_readfirstlane(tid >> 6), lane = tid & 63, wr = wid >> 2, wc = wid & 3, fr = lane & 15, fq = lane >> 4;
    const int K = g.K, nt = K / BK;
    unsigned voffA[2], voffB[2];
#pragma unroll
    for (int i = 0; i < 2; ++i) { int R, C; stage_rc(tid * 16 + i * 8192, R, C); const int Rb = Epi::PERM ? ((R & ~31) + perm32(R & 31)) : R;
        voffA[i] = (unsigned)(R * K + C) * 2u; voffB[i] = (unsigned)(Rb * K + C) * 2u; }
    const size_t kstep = (size_t)(BK * 2);
    const size_t hstep = (size_t)HALF * K * 2;
    const size_t tstep = 2 * hstep;
    const unsigned ldsw = (unsigned)wid * 1024u;
    const int aoff = lds_byte(wr * 64 + fr, fq * 8), boff = lds_byte(wc * 32 + fr, fq * 8);
#define PG8_SA(b, h) (((b) * 2 + (h)) * HTB)
#define PG8_SB(b, h) ((4 + (b) * 2 + (h)) * HTB)
#define PG8_STAGE(bufoff, gbase, voff) do { _Pragma("unroll") for (int _i = 0; _i < 2; ++_i) \
        __builtin_amdgcn_global_load_lds((const unsigned*)((const char*)(gbase) + (voff)[_i]), (PG8_LAS unsigned*)(lds + (bufoff) + ldsw + _i * 8192), 16, 0, 0); } while (0)
#define PG8_LDA(dst, b, h) do { _Pragma("unroll") for (int m = 0; m < 4; ++m) _Pragma("unroll") for (int k = 0; k < 2; ++k) dst[m][k] = *(const PG8_LAS bf16x8*)(lds + PG8_SA(b, h) + aoff + m * 2048 + k * 1024); } while (0)
#define PG8_LDB(dst, b, h) do { _Pragma("unroll") for (int n = 0; n < 2; ++n) _Pragma("unroll") for (int k = 0; k < 2; ++k) dst[n][k] = *(const PG8_LAS bf16x8*)(lds + PG8_SB(b, h) + boff + n * 2048 + k * 1024); } while (0)
#define PG8_MMA(ai, bj, At, Bt) do { __builtin_amdgcn_s_setprio(1); _Pragma("unroll") for (int m = 0; m < 4; ++m) _Pragma("unroll") for (int n = 0; n < 2; ++n) _Pragma("unroll") for (int k = 0; k < 2; ++k) \
        { if constexpr (Epi::I8) acc[ai][bj][m][n] = __builtin_bit_cast(f32x4, __builtin_amdgcn_mfma_i32_16x16x64_i8(__builtin_bit_cast(i32x4, Bt[n][k]), __builtin_bit_cast(i32x4, At[m][k]), __builtin_bit_cast(i32x4, acc[ai][bj][m][n]), 0, 0, 0)); \
          else acc[ai][bj][m][n] = __builtin_amdgcn_mfma_f32_16x16x32_bf16(Bt[n][k], At[m][k], acc[ai][bj][m][n], 0, 0, 0); } __builtin_amdgcn_s_setprio(0); } while (0)
#define PG8_WAIT_V(n) asm volatile("s_waitcnt vmcnt(" #n ")" ::: "memory")
#define PG8_WAIT_L(n) asm volatile("s_waitcnt lgkmcnt(" #n ")" ::: "memory")
#define PG8_BAR __builtin_amdgcn_s_barrier()
#define PG8_SCHED __builtin_amdgcn_sched_barrier(0)
    Unit cur, nxt; int ui = 0;
    if (!S.next(0, cur)) return;
    f32x4 acc[2][2][4][2];
#pragma unroll
    for (int a = 0; a < 2; ++a)
#pragma unroll
        for (int b = 0; b < 2; ++b)
#pragma unroll
            for (int m = 0; m < 4; ++m)
#pragma unroll
                for (int n = 0; n < 2; ++n) acc[a][b][m][n] = (f32x4){0.f, 0.f, 0.f, 0.f};
    bf16x8 At[4][2], B0[2][2], B1[2][2];
    const char* cA = (const char*)(cur.sel ? g.A2 : g.A) + (size_t)cur.pm * tstep; const char* cB = (const char*)(cur.sel ? g.Bt2 : g.Bt) + (size_t)cur.pn * tstep;
    S.a_ready(cur);
    if constexpr (SP2) {
        PG8_STAGE(PG8_SB(0, 0), cB, voffB); PG8_STAGE(PG8_SB(0, 1), cB + hstep, voffB); PG8_STAGE(PG8_SA(0, 0), cA, voffA); PG8_STAGE(PG8_SA(0, 1), cA + hstep, voffA);
        if (wr == 1) PG8_BAR;
        PG8_WAIT_V(2); PG8_BAR;
        PG8_STAGE(PG8_SB(1, 0), cB + kstep, voffB); PG8_STAGE(PG8_SA(1, 0), cA + kstep, voffA); PG8_STAGE(PG8_SB(1, 1), cB + hstep + kstep, voffB);
        PG8_WAIT_V(6); PG8_BAR;
    } else {
        PG8_STAGE(PG8_SB(0, 0), cB, voffB); PG8_STAGE(PG8_SA(0, 0), cA, voffA); PG8_STAGE(PG8_SB(0, 1), cB + hstep, voffB); PG8_STAGE(PG8_SA(0, 1), cA + hstep, voffA);
        if (wr == 1) PG8_BAR;
        PG8_WAIT_V(4); PG8_BAR;
        PG8_STAGE(PG8_SB(1, 0), cB + kstep, voffB); PG8_STAGE(PG8_SA(1, 0), cA + kstep, voffA); PG8_STAGE(PG8_SB(1, 1), cB + hstep + kstep, voffB);
        PG8_WAIT_V(6); PG8_BAR;
    }
    for (;;) {
        const bool has_next = S.next(ui + 1, nxt);
        const char* nA = has_next ? (const char*)(nxt.sel ? g.A2 : g.A) + (size_t)nxt.pm * tstep : cA; const char* nB = has_next ? (const char*)(nxt.sel ? g.Bt2 : g.Bt) + (size_t)nxt.pn * tstep : cB;
        for (int t = 0; t < nt; t += 2) {
            const bool last = (t == nt - 2);
            const char* a1 = cA + (size_t)(t + 1) * kstep;
            const char* a2 = last ? nA : cA + (size_t)(t + 2) * kstep; const char* b2 = last ? nB : cB + (size_t)(t + 2) * kstep;
            const char* a3 = a2 + kstep; const char* b3 = b2 + kstep;
            if (last && has_next) S.a_ready(nxt);
            if constexpr (SP2) {
            PG8_LDB(B0, 0, 0); PG8_LDB(B1, 0, 1); PG8_SCHED; PG8_LDA(At, 0, 0); PG8_STAGE(PG8_SA(1, 1), a1 + hstep, voffA);
            PG8_WAIT_V(8); PG8_WAIT_L(0); PG8_BAR; PG8_MMA(0, 0, At, B0); PG8_MMA(0, 1, At, B1); PG8_BAR; PG8_SCHED;
            PG8_LDA(At, 0, 1); PG8_STAGE(PG8_SB(0, 0), b2, voffB); PG8_STAGE(PG8_SB(0, 1), b2 + hstep, voffB); PG8_STAGE(PG8_SA(0, 0), a2, voffA);
            PG8_WAIT_V(8); PG8_WAIT_L(0); PG8_BAR; PG8_MMA(1, 0, At, B0); PG8_MMA(1, 1, At, B1); PG8_BAR; PG8_SCHED;
            PG8_LDB(B0, 1, 0); PG8_LDB(B1, 1, 1); PG8_SCHED; PG8_LDA(At, 1, 0); PG8_STAGE(PG8_SA(0, 1), a2 + hstep, voffA);
            PG8_WAIT_V(8); PG8_WAIT_L(0); PG8_BAR; PG8_MMA(0, 0, At, B0); PG8_MMA(0, 1, At, B1); PG8_BAR; PG8_SCHED;
            PG8_LDA(At, 1, 1); PG8_STAGE(PG8_SB(1, 0), b3, voffB); PG8_STAGE(PG8_SB(1, 1), b3 + hstep, voffB); PG8_STAGE(PG8_SA(1, 0), a3, voffA);
            PG8_WAIT_V(8); PG8_WAIT_L(0); PG8_BAR; PG8_MMA(1, 0, At, B0); PG8_MMA(1, 1, At, B1); PG8_BAR; PG8_SCHED;
            } else {
            PG8_LDB(B0, 0, 0); PG8_SCHED; PG8_LDA(At, 0, 0); PG8_STAGE(PG8_SA(1, 1), a1 + hstep, voffA);
            PG8_WAIT_L(8); PG8_BAR; PG8_WAIT_L(0); PG8_MMA(0, 0, At, B0); PG8_BAR; PG8_SCHED;
            PG8_LDB(B1, 0, 1); PG8_STAGE(PG8_SB(0, 0), b2, voffB);
            PG8_BAR; PG8_WAIT_L(0); PG8_MMA(0, 1, At, B1); PG8_BAR;
            PG8_LDA(At, 0, 1); PG8_STAGE(PG8_SA(0, 0), a2, voffA);
            PG8_BAR; PG8_WAIT_L(0); PG8_MMA(1, 0, At, B0); PG8_BAR; PG8_SCHED;
            PG8_STAGE(PG8_SB(0, 1), b2 + hstep, voffB);
            PG8_WAIT_V(6); PG8_BAR; PG8_MMA(1, 1, At, B1); PG8_BAR;
            PG8_LDB(B0, 1, 0); PG8_SCHED; PG8_LDA(At, 1, 0); PG8_STAGE(PG8_SA(0, 1), a2 + hstep, voffA);
            PG8_WAIT_L(8); PG8_BAR; PG8_WAIT_L(0); PG8_MMA(0, 0, At, B0); PG8_BAR; PG8_SCHED;
            PG8_LDB(B1, 1, 1); PG8_STAGE(PG8_SB(1, 0), b3, voffB);
            PG8_BAR; PG8_WAIT_L(0); PG8_MMA(0, 1, At, B1); PG8_BAR;
            PG8_LDA(At, 1, 1); PG8_STAGE(PG8_SA(1, 0), a3, voffA);
            PG8_BAR; PG8_WAIT_L(0); PG8_MMA(1, 0, At, B0); PG8_BAR; PG8_SCHED;
            PG8_STAGE(PG8_SB(1, 1), b3 + hstep, voffB);
            PG8_WAIT_V(6); PG8_BAR; PG8_MMA(1, 1, At, B1); PG8_BAR;
            }
        }
        if constexpr (ALIGN_EPI) { if (wr == 0) PG8_BAR; }
        if constexpr (Epi::I8) {
            int ln_ = (int)__builtin_amdgcn_mbcnt_hi(~0u, __builtin_amdgcn_mbcnt_lo(~0u, 0u)); asm volatile("" : "+v"(ln_));
            const int fr_ = ln_ & 15, fq_ = ln_ >> 4;
            float sxr[2][4];
#pragma unroll
            for (int ai = 0; ai < 2; ++ai)
#pragma unroll
                for (int m = 0; m < 4; ++m) sxr[ai][m] = (cur.sel ? g.sa2 : g.sa)[cur.pm * 256 + ai * 128 + wr * 64 + m * 16 + fr_];
#pragma unroll
            for (int bj = 0; bj < 2; ++bj)
#pragma unroll
                for (int n = 0; n < 2; ++n) { const f32x4 swv = *(const f32x4*)((cur.sel ? g.sb2 : g.sb) + cur.pn * 256 + bj * 128 + wc * 32 + 8 * fq_ + 4 * n);
#pragma unroll
                    for (int ai = 0; ai < 2; ++ai)
#pragma unroll
                        for (int m = 0; m < 4; ++m) { const i32x4 iv = __builtin_bit_cast(i32x4, acc[ai][bj][m][n]);
                            acc[ai][bj][m][n] = (f32x4){(float)iv[0], (float)iv[1], (float)iv[2], (float)iv[3]} * sxr[ai][m] * swv; } }
            if constexpr (Epi::OPQ) E(acc, cur, wr, wc, fr_, fq_);
            else E(acc, cur, wr, wc, fr, fq);
        } else
        E(acc, cur, wr, wc, fr, fq);
        S.done(cur);
        if (!has_next) break;
#pragma unroll
        for (int a = 0; a < 2; ++a)
#pragma unroll
            for (int b = 0; b < 2; ++b)
#pragma unroll
                for (int m = 0; m < 4; ++m)
#pragma unroll
                    for (int n = 0; n < 2; ++n) acc[a][b][m][n] = (f32x4){0.f, 0.f, 0.f, 0.f};
        cur = nxt; cA = nA; cB = nB; ++ui;
        if constexpr (ALIGN_EPI) { if (wr == 1) PG8_BAR; }
    }
    PG8_WAIT_V(0);
    if constexpr (!ALIGN_EPI) { if (wr == 0) PG8_BAR; }
    PG8_BAR;
#undef PG8_SA
#undef PG8_SB
#undef PG8_STAGE
#undef PG8_LDA
#undef PG8_LDB
#undef PG8_MMA
#undef PG8_WAIT_V
#undef PG8_WAIT_L
#undef PG8_BAR
#undef PG8_SCHED
}
}
using pg8::Unit;

__device__ __forceinline__ u32x4 pack8(const f32x4 a, const f32x4 b) { u32x4 w; w.x = pk2(a[0], a[1]); w.y = pk2(a[2], a[3]); w.z = pk2(b[0], b[1]); w.w = pk2(b[2], b[3]); return w; }

__device__ __forceinline__ unsigned pk_u8x4(const f32x4 v) { unsigned w = 0; w = __builtin_amdgcn_cvt_pk_u8_f32(v[0] * 255.0f, 0, w); w = __builtin_amdgcn_cvt_pk_u8_f32(v[1] * 255.0f, 1, w); w = __builtin_amdgcn_cvt_pk_u8_f32(v[2] * 255.0f, 2, w); w = __builtin_amdgcn_cvt_pk_u8_f32(v[3] * 255.0f, 3, w); return w; }
__device__ __forceinline__ f32x4 un_u8x4(unsigned w) { return (f32x4){(float)(w & 255u), (float)((w >> 8) & 255u), (float)((w >> 16) & 255u), (float)(w >> 24)} * (1.0f / 255.0f); }
struct Epi1 {
    static constexpr bool PERM = true; static constexpr bool I8 = true; static constexpr bool OPQ = true;
    bf16_t *Q, *K, *V, *GA, *GB; float* U; const float* cs; const float *gq, *gk; bf16_t* UB;
    __device__ __forceinline__ void operator()(const f32x4 (&acc)[2][2][4][2], const Unit& u, int wr, int wc, int fr, int fq) const {
        const int type = u.pn >> 2;
        const int row0 = u.pm * 256 + wr * 64 + fr;
        if (type <= 1) {
            const int sh = (u.pn & 3) * 4 + wc;
            bf16_t* dst = type == 0 ? Q : K; const float* g = type == 0 ? gq : gk; const float osc = type == 0 ? QSCALE : 1.0f;
            f32x4 gv[2][2];
#pragma unroll
            for (int bj = 0; bj < 2; ++bj)
#pragma unroll
                for (int n = 0; n < 2; ++n) gv[bj][n] = *(const f32x4*)(g + 32 * bj + 8 * fq + 4 * n);
#pragma unroll
            for (int ai = 0; ai < 2; ++ai) {
                f32x4 cv[4][2], sv[4][2];
#pragma unroll
                for (int m = 0; m < 4; ++m) { const int pos = NMETA + ((row0 + ai * 128 + m * 16) & (SEQ - 1)); const float* csr = cs + (size_t)pos * 64 + 8 * fq;
                    cv[m][0] = *(const f32x4*)(csr); cv[m][1] = *(const f32x4*)(csr + 4); sv[m][0] = *(const f32x4*)(csr + 32); sv[m][1] = *(const f32x4*)(csr + 36); }
                asm volatile("" ::: "memory");
#pragma unroll
                for (int m = 0; m < 4; ++m) {
                    const int r = row0 + ai * 128 + m * 16;
                    float ss = 0.f;
#pragma unroll
                    for (int bj = 0; bj < 2; ++bj)
#pragma unroll
                        for (int n = 0; n < 2; ++n) { const f32x4 x = acc[ai][bj][m][n]; ss += (x[0] * x[0] + x[1] * x[1]) + (x[2] * x[2] + x[3] * x[3]); }
                    ss += __shfl_xor(ss, 16); ss += __shfl_xor(ss, 32);
                    const float rs = rsqrtf(ss * (1.0f / 64.0f) + EPS);
                    f32x4 olo[2], ohi[2];
#pragma unroll
                    for (int n = 0; n < 2; ++n) { const f32x4 lo = acc[ai][0][m][n] * rs * gv[0][n], hi = acc[ai][1][m][n] * rs * gv[1][n];
                        olo[n] = (lo * cv[m][n] - hi * sv[m][n]) * osc; ohi[n] = (hi * cv[m][n] + lo * sv[m][n]) * osc; }
                    bf16_t* p = dst + (size_t)r * AW + sh * 64 + 8 * fq;
                    *(u32x4*)(p) = pack8(olo[0], olo[1]); *(u32x4*)(p + 32) = pack8(ohi[0], ohi[1]);
                }
            }
        } else {
            const int colt = (u.pn & 3) * 256 + wc * 32 + 8 * fq;
#pragma unroll
            for (int ai = 0; ai < 2; ++ai)
#pragma unroll
                for (int m = 0; m < 4; ++m) {
                    const int r = row0 + ai * 128 + m * 16;
#pragma unroll
                    for (int bj = 0; bj < 2; ++bj) {
                        const f32x4 v0 = acc[ai][bj][m][0], v1 = acc[ai][bj][m][1];
                        if (type == 2) *(u32x4*)(V + (size_t)r * AW + colt + bj * 128) = pack8(v0, v1);
                        else if (type == 3) { if (U) { float* p = U + (size_t)r * SW + colt + bj * 128; *(f32x4*)p = v0; *(f32x4*)(p + 4) = v1; } *(u32x4*)(UB + (size_t)r * SW + colt + bj * 128) = pack8(v0, v1); }
                        else {
                            unsigned char* G = (unsigned char*)((type < 6) ? GA : GB); const int col = ((u.pn - (type < 6 ? 16 : 24)) * 256) + wc * 32 + 8 * fq + bj * 128;
                            f32x4 s0, s1;
#pragma unroll
                            for (int i = 0; i < 4; ++i) { s0[i] = sigmoidf_(v0[i]); s1[i] = sigmoidf_(v1[i]); }
                            *(u32x2*)(G + (size_t)r * DM + col) = (u32x2){pk_u8x4(s0), pk_u8x4(s1)};
                        }
                    }
                }
        }
    }
};
struct EpiGlu {
    static constexpr bool PERM = true; static constexpr bool I8 = false; static constexpr bool OPQ = false;
    const bf16_t* GB; bf16_t* YB;
    __device__ __forceinline__ void operator()(const f32x4 (&acc)[2][2][4][2], const Unit& u, int wr, int wc, int fr, int fq) const {
        const int row0 = u.pm * 256 + wr * 64 + fr, col = u.pn * 128 + wc * 32 + 8 * fq;
        u32x2 gbv[2][4];
#pragma unroll
        for (int ai = 0; ai < 2; ++ai)
#pragma unroll
            for (int m = 0; m < 4; ++m) gbv[ai][m] = __builtin_nontemporal_load((const u32x2*)((const unsigned char*)GB + (size_t)(row0 + ai * 128 + m * 16) * DM + col));
        asm volatile("" ::: "memory");
#pragma unroll
        for (int ai = 0; ai < 2; ++ai)
#pragma unroll
            for (int m = 0; m < 4; ++m) {
                const size_t off = (size_t)(row0 + ai * 128 + m * 16) * DM + col;
                const u32x2 gb = gbv[ai][m];
                f32x4 o0, o1;
#pragma unroll
                for (int i = 0; i < 4; ++i) { o0[i] = acc[ai][0][m][0][i] * sigmoidf_(acc[ai][1][m][0][i]); o1[i] = acc[ai][0][m][1][i] * sigmoidf_(acc[ai][1][m][1][i]); }
                o0 = o0 * un_u8x4(gb.x); o1 = o1 * un_u8x4(gb.y);
                *(u32x4*)(YB + off) = pack8(o0, o1);
            }
    }
};
struct EpiMix {
    static constexpr bool PERM = true; static constexpr bool I8 = false; static constexpr bool OPQ = false;
    const bf16_t *GA, *YB; bf16_t* MIX;
    __device__ __forceinline__ void operator()(const f32x4 (&acc)[2][2][4][2], const Unit& u, int wr, int wc, int fr, int fq) const {
        const int row0 = u.pm * 256 + wr * 64 + fr, col0 = u.pn * 256 + wc * 32 + 8 * fq;
#pragma unroll
        for (int ai = 0; ai < 2; ++ai)
#pragma unroll
        for (int mh = 0; mh < 2; ++mh) {
            u32x2 gav[2][2]; u32x4 ybv[2][2];
#pragma unroll
            for (int m = 0; m < 2; ++m)
#pragma unroll
                for (int bj = 0; bj < 2; ++bj) { const size_t off = (size_t)(row0 + ai * 128 + (2 * mh + m) * 16) * DM + col0 + bj * 128; gav[m][bj] = __builtin_nontemporal_load((const u32x2*)((const unsigned char*)GA + off)); ybv[m][bj] = *(const u32x4*)(YB + off); }
            asm volatile("" ::: "memory");
#pragma unroll
            for (int m = 0; m < 2; ++m)
#pragma unroll
                for (int bj = 0; bj < 2; ++bj) {
                    const size_t off = (size_t)(row0 + ai * 128 + (2 * mh + m) * 16) * DM + col0 + bj * 128;
                    const u32x2 ga = gav[m][bj]; const u32x4 yb = ybv[m][bj];
                    const f32x4 g0 = un_u8x4(ga.x), g1 = un_u8x4(ga.y);
                    f32x4 o0 = acc[ai][bj][2 * mh + m][0], o1 = acc[ai][bj][2 * mh + m][1];
                    o0[0] = o0[0] * g0[0] + bflo(yb.x); o0[1] = o0[1] * g0[1] + bfhi(yb.x); o0[2] = o0[2] * g0[2] + bflo(yb.y); o0[3] = o0[3] * g0[3] + bfhi(yb.y);
                    o1[0] = o1[0] * g1[0] + bflo(yb.z); o1[1] = o1[1] * g1[1] + bfhi(yb.z); o1[2] = o1[2] * g1[2] + bflo(yb.w); o1[3] = o1[3] * g1[3] + bfhi(yb.w);
                    *(u32x4*)(MIX + off) = pack8(o0, o1);
                }
        }
    }
};
struct EpiP3 {
    static constexpr bool PERM = true; static constexpr bool I8 = true; static constexpr bool OPQ = false;
    EpiGlu g; EpiMix m;
    __device__ __forceinline__ void operator()(const f32x4 (&acc)[2][2][4][2], const Unit& u, int wr, int wc, int fr, int fq) const { if (u.sel) m(acc, u, wr, wc, fr, fq); else g(acc, u, wr, wc, fr, fq); }
};
struct EpiOut {
    static constexpr bool PERM = true; static constexpr bool I8 = true; static constexpr bool OPQ = false;
    const float* X; bf16_t* H2B; float* PARTSS;
    __device__ __forceinline__ void operator()(const f32x4 (&acc)[2][2][4][2], const Unit& u, int wr, int wc, int fr, int fq) const {
        const int row0 = u.pm * 256 + wr * 64 + fr, col0 = u.pn * 256 + wc * 32 + 8 * fq;
#pragma unroll
        for (int ai = 0; ai < 2; ++ai)
#pragma unroll
        for (int mh = 0; mh < 2; ++mh) {
            f32x4 xv[2][2][2];
#pragma unroll
            for (int m = 0; m < 2; ++m)
#pragma unroll
                for (int bj = 0; bj < 2; ++bj)
#pragma unroll
                    for (int n = 0; n < 2; ++n) xv[m][bj][n] = __builtin_nontemporal_load((const f32x4*)(X + (size_t)(row0 + ai * 128 + (2 * mh + m) * 16) * DM + col0 + bj * 128 + n * 4));
            asm volatile("" ::: "memory");
#pragma unroll
            for (int m = 0; m < 2; ++m) {
                const int r = row0 + ai * 128 + (2 * mh + m) * 16; float ss = 0.f;
#pragma unroll
                for (int bj = 0; bj < 2; ++bj) {
                    const f32x4 h0 = xv[m][bj][0] + acc[ai][bj][2 * mh + m][0], h1 = xv[m][bj][1] + acc[ai][bj][2 * mh + m][1];
                    ss += ((h0[0] * h0[0] + h0[1] * h0[1]) + (h0[2] * h0[2] + h0[3] * h0[3])) + ((h1[0] * h1[0] + h1[1] * h1[1]) + (h1[2] * h1[2] + h1[3] * h1[3]));
                    *(u32x4*)(H2B + (size_t)r * DM + col0 + bj * 128) = pack8(h0, h1);
                }
                ss += __shfl_xor(ss, 16); ss += __shfl_xor(ss, 32);
                if (fq == 0) PARTSS[(size_t)(u.pn * 4 + wc) * MTOK + r] = ss;
            }
        }
    }
};
struct EpiQP {
    static constexpr bool PERM = true; static constexpr bool I8 = true; static constexpr bool OPQ = false;
    bf16_t* QP;
    __device__ __forceinline__ void operator()(const f32x4 (&acc)[2][2][4][2], const Unit& u, int wr, int wc, int fr, int fq) const {
        const int rl0 = wr * 64 + fr, col0 = u.pn * 256 + wc * 32 + 8 * fq;
#pragma unroll
        for (int ai = 0; ai < 2; ++ai)
#pragma unroll
            for (int m = 0; m < 4; ++m) {
                const int rl = rl0 + ai * 128 + m * 16;
#pragma unroll
                for (int bj = 0; bj < 2; ++bj)
                    *(u32x4*)(QP + (size_t)(u.pm * 256 + rl) * DM + col0 + bj * 128) = pack8(acc[ai][bj][m][0], acc[ai][bj][m][1]);
            }
    }
};

struct Args { const float* in[28]; float* out; unsigned char* ws; int ph_lo, ph_hi, probe, pad; };
enum { I_X = 0, I_META, I_N1G, I_WIN, I_QNG, I_KNG, I_LQ1, I_LK1, I_LQ2, I_LK2, I_SUBLN, I_WATT, I_ARE, I_AIM, I_LOGDT, I_BRE, I_BIM, I_CRE, I_CIM, I_SSMD, I_WGLU, I_WOUT, I_N2G, I_WQ, I_K1, I_K2, I_PU, I_PV };

constexpr int NWAVES = 8, NTHREADS = 512;
constexpr int RING_BYTES = 131072, LDS_EXTRA_OFF = RING_BYTES, LDS_BYTES = 147456;

template <class RowMap>
__device__ __forceinline__ void transpose_item(const float* W, int K, int N, bf16_t* WT, LAS float* scr, int item, int lane, RowMap rm, const float* kscale = nullptr) {
    const int nblk = N / 32, kb = item / nblk, nb = item % nblk, k0 = 64 * kb, n0 = 32 * nb;
    float tv[32];
#pragma unroll
    for (int i = 0; i < 32; ++i) { tv[i] = __builtin_nontemporal_load(W + (size_t)(k0 + 2 * i + (lane >> 5)) * N + n0 + (lane & 31)); if (kscale) tv[i] *= kscale[k0 + 2 * i + (lane >> 5)]; }
#pragma unroll
    for (int i = 0; i < 32; ++i) scr[(2 * i + (lane >> 5)) * 33 + (lane & 31)] = tv[i];
    asm volatile("s_waitcnt lgkmcnt(0)" ::: "memory");
    const int c = lane & 7;
#pragma unroll
    for (int j = 0; j < 4; ++j) { const int n = (lane >> 3) + 8 * j; const LAS float* s = scr + (8 * c) * 33 + n;
        u32x4 o; o.x = pk2(s[0 * 33], s[1 * 33]); o.y = pk2(s[2 * 33], s[3 * 33]); o.z = pk2(s[4 * 33], s[5 * 33]); o.w = pk2(s[6 * 33], s[7 * 33]);
        *(u32x4*)(WT + (size_t)rm(n0 + n) * K + k0 + 8 * c) = o; }
    asm volatile("s_waitcnt lgkmcnt(0)" ::: "memory");
}
struct MapId { __device__ __forceinline__ int operator()(int n) const { return n; } };
struct MapWin { __device__ __forceinline__ int operator()(int n) const { if (n >= 2048) return n; const int w = n & 255; return (n & ~255) + 128 * ((w >> 5) & 1) + 32 * (w >> 6) + (w & 31); } };
struct MapGlu { __device__ __forceinline__ int operator()(int n) const { const int hi = n >= 2048, j = n & 2047; return (j >> 7) * 256 + 128 * hi + (j & 127); } };

__device__ __forceinline__ void rms_row_to_bf16(const float* xrow, const float* g, bf16_t* orow, int lane) {
    const f32x4* xr = (const f32x4*)xrow + lane; const f32x4* gr = (const f32x4*)g + lane;
    f32x4 v[8]; float s = 0.f;
#pragma unroll
    for (int j = 0; j < 8; ++j) { v[j] = __builtin_nontemporal_load(xr + 64 * j); s += (v[j][0] * v[j][0] + v[j][1] * v[j][1]) + (v[j][2] * v[j][2] + v[j][3] * v[j][3]); }
    const float rs = rsqrtf(wave_sum(s) * (1.0f / DM) + EPS);
    u32x2* o = (u32x2*)orow + lane;
#pragma unroll
    for (int j = 0; j < 8; ++j) { const f32x4 y = v[j] * rs * gr[64 * j]; u32x2 w; w.x = pk2(y[0], y[1]); w.y = pk2(y[2], y[3]); o[64 * j] = w; }
}

__device__ __forceinline__ void rms_row_to_i8(const float* xrow, const float* g, unsigned char* qrow, float* sx, int lane) {
    const f32x4* xr = (const f32x4*)xrow + lane; const f32x4* gr = (const f32x4*)g + lane;
    f32x4 v[8]; float s = 0.f, mx = 0.f;
#pragma unroll
    for (int j = 0; j < 8; ++j) { v[j] = __builtin_nontemporal_load(xr + 64 * j); s += (v[j][0] * v[j][0] + v[j][1] * v[j][1]) + (v[j][2] * v[j][2] + v[j][3] * v[j][3]);
        v[j] = v[j] * gr[64 * j]; mx = fmaxf(mx, fmaxf(fmaxf(fabsf(v[j][0]), fabsf(v[j][1])), fmaxf(fabsf(v[j][2]), fabsf(v[j][3])))); }
    const float rs = rsqrtf(wave_sum(s) * (1.0f / DM) + EPS);
    mx = wave_max(mx);
    const float inv = mx > 0.f ? 127.0f / mx : 0.f;
    unsigned* o = (unsigned*)qrow + lane;
#pragma unroll
    for (int j = 0; j < 8; ++j) { const int q0 = (int)rintf(v[j][0] * inv), q1 = (int)rintf(v[j][1] * inv), q2 = (int)rintf(v[j][2] * inv), q3 = (int)rintf(v[j][3] * inv);
        o[64 * j] = (unsigned)(q0 & 255) | ((unsigned)(q1 & 255) << 8) | ((unsigned)(q2 & 255) << 16) | ((unsigned)q3 << 24); }
    if (lane == 0) *sx = mx * rs * (1.0f / 127.0f);
}
template <int K, class RowMap>
__device__ __forceinline__ void strip_item(const float* Wm, int N, const float* kscale, RowMap rm, unsigned char* WT8, float* sw, LAS unsigned char* lds, int strip) {
    const int tid = otid(), col = tid & 31, rp = tid >> 5;
    constexpr int CP = 2 * K + 16;
    const float* W = Wm + 32 * strip + col;
    float mx = 0.f;
#pragma unroll 1
    for (int i0 = 0; i0 < K / 32; i0 += 16) {
        float v[32];
#pragma unroll
        for (int i = 0; i < 16; ++i) { const int k = 2 * (rp + 16 * (i0 + i)); v[2 * i] = __builtin_nontemporal_load(W + (size_t)k * N); v[2 * i + 1] = __builtin_nontemporal_load(W + (size_t)(k + 1) * N); }
        asm volatile("" ::: "memory");
#pragma unroll
        for (int i = 0; i < 16; ++i) { const int k = 2 * (rp + 16 * (i0 + i)); if (kscale) { v[2 * i] *= kscale[k]; v[2 * i + 1] *= kscale[k + 1]; }
            mx = fmaxf(mx, fmaxf(fabsf(v[2 * i]), fabsf(v[2 * i + 1])));
            *(LAS unsigned*)(lds + col * CP + k * 2) = pk2(v[2 * i], v[2 * i + 1]); }
    }
    LAS float* smax = (LAS float*)(lds + 32 * CP);
    smax[rp * 32 + col] = mx;
    __syncthreads();
    constexpr int TPC = K / 16, CPP = 512 / TPC;
#pragma unroll 1
    for (int p = 0; p < 32 / CPP; ++p) {
        const int c = CPP * p + tid / TPC, kc = (tid % TPC) * 16;
        float cm = 0.f;
#pragma unroll
        for (int j = 0; j < 16; ++j) cm = fmaxf(cm, smax[j * 32 + c]);
        const float inv = cm > 0.f ? 127.0f / cm : 0.f;
        const u32x4 lo = *(const LAS u32x4*)(lds + c * CP + kc * 2), hi = *(const LAS u32x4*)(lds + c * CP + kc * 2 + 16);
        const unsigned wd[8] = {lo.x, lo.y, lo.z, lo.w, hi.x, hi.y, hi.z, hi.w}; u32x4 o;
#pragma unroll
        for (int q = 0; q < 4; ++q) { const int q0 = (int)rintf(bflo(wd[2 * q]) * inv), q1 = (int)rintf(bfhi(wd[2 * q]) * inv), q2 = (int)rintf(bflo(wd[2 * q + 1]) * inv), q3 = (int)rintf(bfhi(wd[2 * q + 1]) * inv);
            const unsigned pk = (unsigned)(q0 & 255) | ((unsigned)(q1 & 255) << 8) | ((unsigned)(q2 & 255) << 16) | ((unsigned)q3 << 24);
            if (q == 0) o.x = pk; else if (q == 1) o.y = pk; else if (q == 2) o.z = pk; else o.w = pk; }
        const int n = rm(32 * strip + c);
        *(u32x4*)(WT8 + (size_t)n * K + kc) = o;
        if ((tid % TPC) == 0) sw[n] = cm * (1.0f / 127.0f);
    }
    __syncthreads();
}

constexpr int XROWS = 2 * NEXP;
template <int MODE>
__device__ __forceinline__ void p0_prologue(const Args& A, LAS unsigned char* lds, int G, int probe = 0) {
    const int tid = otid(), lane = tid & 63, wave = __builtin_amdgcn_readfirstlane(tid >> 6);
    const int gw = MODE ? (blockIdx.x - 128) * NWAVES + wave : blockIdx.x * NWAVES + wave, NGW = MODE ? (G - 128) * NWAVES : G * NWAVES;
    unsigned char* ws = A.ws;
#pragma unroll 1
    for (int step = 0; step < 3; ++step) {
    const int part = (MODE == 0 && (blockIdx.x & 1)) ? (step + 2) % 3 : step;
    if (part == 0 && (probe == 0 || probe == 1)) {
        LAS float* scr = (LAS float*)(lds + wave * 16384);
        constexpr int I_IN = (DM / 64) * (INW / 32), I_AT = (AW / 64) * (DM / 32), I_GL = (SW / 64) * (2 * DM / 32), I_OU = (DM / 64) * (DM / 32), I_Q = I_OU;
        constexpr int NIT = I_IN + I_AT + I_GL + I_OU + I_Q;
        if (MODE == 0) { for (int st = blockIdx.x; st < INW / 32; st += G) strip_item<DM>(A.in[I_WIN], INW, nullptr, MapWin(), ws + WS_WTIN, (float*)(ws + WS_SWB), lds, st); }
        else {
            for (int it = (int)blockIdx.x - 128; it < 320; it += G - 128) {
                if (it < 64) strip_item<DM>(A.in[I_WQ], DM, A.in[I_N2G], MapId(), ws + WS_WTQ, (float*)(ws + WS_SWQ), lds, it);
                else if (it < 128) strip_item<DM>(A.in[I_WOUT], DM, nullptr, MapId(), ws + WS_WTOUT, (float*)(ws + WS_SWO), lds, it - 64);
                else if (it < 256) strip_item<SW>(A.in[I_WGLU], 2 * DM, nullptr, MapGlu(), ws + WS_WTGLU, (float*)(ws + WS_SWG), lds, it - 128);
                else strip_item<AW>(A.in[I_WATT], DM, nullptr, MapId(), ws + WS_WTATT, (float*)(ws + WS_SWA), lds, it - 256);
            }
        }
    }
    if (part == 1 && MODE == 0 && (probe == 0 || probe == 2)) for (int m = gw; m < MTOK; m += NGW) rms_row_to_i8(A.in[I_X] + (size_t)m * DM, A.in[I_N1G], ws + WS_XN + (size_t)m * DM, (float*)(ws + WS_SXA) + m, lane);
    if (part == 2 && (probe == 0 || probe == 3)) {
        float* su = (float*)(ws + WS_SU); float* sv = (float*)(ws + WS_SV);
        for (int it = MODE ? gw + XROWS : gw; it < (MODE ? 2 * NEXP : XROWS); it += NGW) {
            const int tb = it >= NEXP, e = it - tb * NEXP;
            const f32x4* src = (const f32x4*)(A.in[tb ? I_PV : I_PU] + (size_t)e * DM) + lane;
            f32x4 v[8]; float mx = 0.f;
#pragma unroll
            for (int j = 0; j < 8; ++j) { v[j] = __builtin_nontemporal_load(src + 64 * j); if (!tb) v[j] = v[j] * *((const f32x4*)A.in[I_N2G] + lane + 64 * j);
                mx = fmaxf(mx, fmaxf(fmaxf(fabsf(v[j][0]), fabsf(v[j][1])), fmaxf(fabsf(v[j][2]), fabsf(v[j][3])))); }
            mx = wave_max(mx);
            unsigned* dst = (unsigned*)(ws + (tb ? WS_VE : WS_UE) + (size_t)e * DM) + lane;
            if (!tb) {
                const float inv = mx > 0.f ? 127.0f / mx : 0.f;
#pragma unroll
                for (int j = 0; j < 8; ++j) { const int q0 = (int)rintf(v[j][0] * inv), q1 = (int)rintf(v[j][1] * inv), q2 = (int)rintf(v[j][2] * inv), q3 = (int)rintf(v[j][3] * inv);
                    dst[64 * j] = (unsigned)(q0 & 255) | ((unsigned)(q1 & 255) << 8) | ((unsigned)(q2 & 255) << 16) | ((unsigned)(q3 & 255) << 24); }
                if (lane == 0) su[e] = mx * (1.0f / 127.0f);
            } else {
                const float inv = mx > 0.f ? 448.0f / mx : 0.f;
#pragma unroll
                for (int j = 0; j < 8; ++j) { int p = __builtin_amdgcn_cvt_pk_fp8_f32(v[j][0] * inv, v[j][1] * inv, 0, false); p = __builtin_amdgcn_cvt_pk_fp8_f32(v[j][2] * inv, v[j][3] * inv, p, true); dst[64 * j] = (unsigned)p; }
                if (lane == 0) sv[e] = mx * (1.0f / 448.0f);
            }
        }
    }
    }
    if (MODE == 0 && (probe == 0 || probe == 4)) {
        { bf16_t* k12 = (bf16_t*)(ws + WS_K12);
          for (int i = blockIdx.x * NTHREADS + tid; i < 2 * 8 * 128 * 128; i += G * NTHREADS) k12[i] = (bf16_t)f2bf(i < 131072 ? A.in[I_K1][i] : A.in[I_K2][i - 131072]); }
        float* cs = (float*)(ws + WS_CS);
        for (int i = blockIdx.x * NTHREADS + tid; i < NPOS * 32; i += G * NTHREADS) {
            const int pos = i >> 5, j = i & 31; const float invf = exp2f(-(float)j * (13.287712379549449f / 32.0f));
            const float ang = (float)pos * invf; float sn, cn; sincosf(ang, &sn, &cn); cs[pos * 64 + j] = cn; cs[pos * 64 + 32 + j] = sn;
        }
        float* abar = (float*)(ws + WS_ABAR); float* bbar = (float*)(ws + WS_BBAR);
        for (int i = blockIdx.x * NTHREADS + tid; i < 64 * 64; i += G * NTHREADS) {
            const int g = i >> 6; const float are = A.in[I_ARE][i], aim = A.in[I_AIM][i], dt = expf(A.in[I_LOGDT][g]);
            const float mag = expf(are * dt); float sn, cn; sincosf(aim * dt, &sn, &cn); const float br = mag * cn, bi = mag * sn;
            abar[2 * i] = br; abar[2 * i + 1] = bi;
            const float nr = br - 1.0f, ni = bi, den = 1.0f / (are * are + aim * aim);
            const float fr_ = (nr * are + ni * aim) * den, fi_ = (ni * are - nr * aim) * den;
            for (int c = 0; c < 16; ++c) { const float b_r = A.in[I_BRE][i * 16 + c], b_i = A.in[I_BIM][i * 16 + c];
                bbar[(i * 16 + c) * 2] = fr_ * b_r - fi_ * b_i; bbar[(i * 16 + c) * 2 + 1] = fr_ * b_i + fi_ * b_r; }
        }
        if (blockIdx.x == 0 && wave == 0) {
            const float s1 = wave_sum(A.in[I_LQ1][lane] * A.in[I_LK1][lane]), s2 = wave_sum(A.in[I_LQ2][lane] * A.in[I_LK2][lane]);
            const float gqm = wave_max(fabsf(A.in[I_QNG][lane])), gkm = wave_max(fabsf(A.in[I_KNG][lane]));
            if (lane == 0) { float* par = (float*)(ws + WS_PAR); par[0] = expf(s1) - expf(s2) + LAM_INIT; par[1] = 8.0f * gqm * gkm * LOG2E * 1.01f; }
        }
    }
    if (MODE == 0 && (probe == 0 || probe == 5)) {
        __syncthreads();
        LAS float* hm = (LAS float*)(lds + wave * 16384);
        float* macc = (float*)(ws + WS_MP32);
        for (int it = gw; it < 48 * 32; it += NGW) {
            const int cb = it % 48, ks = it / 48, k0 = ks * 64;
            float w[64];
            const float* wp = A.in[I_WIN] + (size_t)k0 * INW + 1024 + cb * 64 + lane;
#pragma unroll
            for (int q = 0; q < 64; ++q) w[q] = wp[(size_t)q * INW];
            const float gk = A.in[I_N1G][k0 + lane];
#pragma unroll
            for (int r = 0; r < 16; ++r) hm[r * 64 + lane] = A.in[I_META][(size_t)r * DM + k0 + lane] * gk;
            asm volatile("s_waitcnt lgkmcnt(0)" ::: "memory");
            float acc[16];
#pragma unroll
            for (int r = 0; r < 16; ++r) acc[r] = 0.f;
#pragma unroll
            for (int q4 = 0; q4 < 16; ++q4) {
#pragma unroll
                for (int r = 0; r < 16; ++r) { const f32x4 h = *(const LAS f32x4*)(hm + r * 64 + 4 * q4); acc[r] += (h[0] * w[4 * q4] + h[1] * w[4 * q4 + 1]) + (h[2] * w[4 * q4 + 2] + h[3] * w[4 * q4 + 3]); }
                if ((q4 & 3) == 3) __builtin_amdgcn_sched_barrier(0);
            }
#pragma unroll
            for (int r = 0; r < 16; ++r) macc[((size_t)ks * 16 + r) * 3072 + cb * 64 + lane] = acc[r];
            asm volatile("s_waitcnt lgkmcnt(0)" ::: "memory");
        }
    }
}
__device__ __forceinline__ void p1_meta_finish(const Args& A, LAS unsigned char* lds, int G) {
    const int tid = otid(), lane = tid & 63, wave = __builtin_amdgcn_readfirstlane(tid >> 6); unsigned char* ws = A.ws;
    const float* mp = (const float*)(ws + WS_MP32); const float* cs = (const float*)(ws + WS_CS);
    bf16_t* KM = (bf16_t*)(ws + WS_KM); bf16_t* VM = (bf16_t*)(ws + WS_VM); float* UM = (float*)(ws + WS_UM); bf16_t* UMB = (bf16_t*)(ws + WS_UMB);
    LAS float* rsm = (LAS float*)(lds + LDS_EXTRA_OFF + 12288);
    for (int r = wave; r < 16; r += NWAVES) { const f32x4* mr = (const f32x4*)(A.in[I_META] + (size_t)r * DM) + lane; float sq = 0.f;
#pragma unroll
        for (int j = 0; j < 8; ++j) { const f32x4 v = mr[64 * j]; sq += (v[0] * v[0] + v[1] * v[1]) + (v[2] * v[2] + v[3] * v[3]); }
        sq = wave_sum(sq); if (lane == 0) rsm[r] = rsqrtf(sq * (1.0f / DM) + EPS); }
    __syncthreads();
    for (int t = blockIdx.x * NWAVES + wave; t < 16 * 16; t += G * NWAVES) {
        const int r = t >> 4, sh = t & 15, d = lane; float kv = 0.f;
        for (int ks = 0; ks < 32; ++ks) kv += mp[((size_t)ks * 16 + r) * 3072 + sh * 64 + d];
        kv *= rsm[r];
        const float rs = rsqrtf(wave_sum(kv * kv) * (1.0f / 64.0f) + EPS);
        const float a = kv * rs * A.in[I_KNG][d], bq = __shfl_xor(a, 32);
        const int j = d & 31; const float cn = cs[r * 64 + j], sn = cs[r * 64 + 32 + j];
        KM[r * 1024 + sh * 64 + d] = (bf16_t)f2bf((d < 32) ? (a * cn - bq * sn) : (a * cn + bq * sn));
    }
    for (int i = blockIdx.x * NTHREADS + tid; i < 16 * 2048; i += G * NTHREADS) {
        const int r = i >> 11, c = i & 2047; float v = 0.f;
        for (int ks = 0; ks < 32; ++ks) v += mp[((size_t)ks * 16 + r) * 3072 + 1024 + c];
        v *= rsm[r];
        if (c < 1024) VM[r * 1024 + c] = (bf16_t)f2bf(v); else { UM[r * 1024 + c - 1024] = v; UMB[r * 1024 + c - 1024] = (bf16_t)f2bf(v); }
    }
    for (int i = blockIdx.x * NTHREADS + tid; i < 48 * 1024; i += G * NTHREADS) { KM[16 * 1024 + i] = 0; VM[16 * 1024 + i] = 0; }
}

namespace att {
typedef float f32x16 __attribute__((ext_vector_type(16)));
typedef short s16x4 __attribute__((ext_vector_type(4)));
typedef short v4i16_t __attribute__((ext_vector_type(4)));
constexpr int KP = 272, VP = 320, KBUF = 64 * KP, VBUF = 64 * VP, STG = KBUF + VBUF;
constexpr int X_OFF = 0, OST_OFF = 65536, QF_OFF = 2 * STG, WSL_OFF = QF_OFF + 32768;
__device__ __forceinline__ int crow(int r, int hi) { return (r & 3) + 8 * (r >> 2) + 4 * hi; }
__device__ __forceinline__ s16x4 vtr(const LAS unsigned char* p) { return __builtin_bit_cast(s16x4, __builtin_amdgcn_ds_read_tr16_b64_v4i16((LAS v4i16_t*)p)); }
__device__ __forceinline__ unsigned cvtpk(float lo, float hi) { f32x2 v = {lo, hi}; bf16x2_t b = __builtin_convertvector(v, bf16x2_t); return __builtin_bit_cast(unsigned, b); }

__device__ __forceinline__ void attn_unit(const Args& A, int b, int h, int qb, LAS unsigned char* lds, float lam, float Mb) {
    const int tid = otid(), lane = tid & 63, wave = __builtin_amdgcn_readfirstlane(tid >> 6);
    const int c = wave >> 2, w4 = wave & 3, r32 = lane & 31, hh = lane >> 5;
    unsigned char* ws = A.ws;
    const bf16_t* Q = (const bf16_t*)(ws + WS_Q); const bf16_t* K = (const bf16_t*)(ws + WS_K); const bf16_t* V = (const bf16_t*)(ws + WS_V);
    const bf16_t* KM = (const bf16_t*)(ws + WS_KM); const bf16_t* VM = (const bf16_t*)(ws + WS_VM); bf16_t* ATT = (bf16_t*)(ws + WS_ATT);
    const int tq = qb * 128 + 32 * w4 + r32;
    LAS unsigned char* qfl = lds + QF_OFF + wave * 4096 + lane * 16;
    { const bf16_t* qp = Q + (size_t)(b * SEQ + tq) * AW + h * 128 + c * 64 + 8 * hh;
#pragma unroll
      for (int ds = 0; ds < 4; ++ds) *(LAS bf16x8*)(qfl + ds * 1024) = *(const bf16x8*)(qp + 16 * ds); }
    f32x16 o[4];
#pragma unroll
    for (int d = 0; d < 4; ++d)
#pragma unroll
        for (int r = 0; r < 16; ++r) o[d][r] = 0.f;
    float l = 0.f;
    const int ntile = 2 * qb + 3;
    const int srow = tid >> 3, sch = tid & 7;
    u32x4 st[4];
#define ATT_LOAD(kt) do { const bf16_t* kr; const bf16_t* vr; if ((kt) == 0) { kr = KM + (size_t)srow * AW; vr = VM + (size_t)srow * AW; } \
        else { const size_t row = (size_t)(b * SEQ + ((kt) - 1) * 64 + srow) * AW; kr = K + row; vr = V + row; } \
        kr += h * 128 + sch * 8; vr += h * 128 + sch * 8; st[0] = *(const u32x4*)kr; st[1] = *(const u32x4*)(kr + 64); st[2] = *(const u32x4*)vr; st[3] = *(const u32x4*)(vr + 64); } while (0)
#define ATT_STORE(buf) do { LAS unsigned char* kb_ = lds + (buf) * STG + srow * KP + sch * 16; LAS unsigned char* vb_ = lds + (buf) * STG + KBUF + srow * VP + sch * 16; \
        *(LAS u32x4*)kb_ = st[0]; *(LAS u32x4*)(kb_ + 128) = st[1]; *(LAS u32x4*)vb_ = st[2]; *(LAS u32x4*)(vb_ + 128) = st[3]; } while (0)
    ATT_LOAD(0); ATT_STORE(0);
    __syncthreads();
    const int koff = r32 * KP + (c * 64 + 8 * hh) * 2;
    const int voff = (4 * hh + ((lane & 15) >> 2)) * VP + (16 * ((lane >> 4) & 1) + 4 * (lane & 3)) * 2;
    const float NEG = -INFINITY;
#pragma unroll 1
    for (int kt = 0; kt < ntile; ++kt) {
        const int cur = kt & 1;
        if (kt + 1 < ntile) ATT_LOAD(kt + 1);
        const LAS unsigned char* Kb = lds + cur * STG + koff; const LAS unsigned char* Vb = lds + cur * STG + KBUF + voff;
        f32x16 p0, p1;
#pragma unroll
        for (int r = 0; r < 16; ++r) { p0[r] = -Mb; p1[r] = -Mb; }
#pragma unroll
        for (int ds = 0; ds < 4; ++ds) {
            const bf16x8 a0 = *(const LAS bf16x8*)(Kb + ds * 32), a1 = *(const LAS bf16x8*)(Kb + 32 * KP + ds * 32);
            const bf16x8 qv = *(const LAS bf16x8*)(qfl + ds * 1024);
            p0 = __builtin_amdgcn_mfma_f32_32x32x16_bf16(a0, qv, p0, 0, 0, 0);
            p1 = __builtin_amdgcn_mfma_f32_32x32x16_bf16(a1, qv, p1, 0, 0, 0);
        }
        if (kt == 0) {
#pragma unroll
            for (int r = 0; r < 16; ++r) { if (r >= 8) p0[r] = NEG; p1[r] = NEG; }
        } else if (kt - 1 >= 2 * qb) {
            const int lim = tq - (kt - 1) * 64 - 4 * hh;
#pragma unroll
            for (int r = 0; r < 16; ++r) { const int kc = (r & 3) + 8 * (r >> 2); if (kc > lim) p0[r] = NEG; if (kc + 32 > lim) p1[r] = NEG; }
        }
        float sacc = 0.f;
#pragma unroll
        for (int r = 0; r < 16; ++r) { p0[r] = __builtin_amdgcn_exp2f(p0[r]); p1[r] = __builtin_amdgcn_exp2f(p1[r]); sacc += p0[r] + p1[r]; }
        l += sacc;
        bf16x8 pa[4];
        { u32x4 w;
          w.x = cvtpk(p0[0], p0[1]); w.y = cvtpk(p0[2], p0[3]); w.z = cvtpk(p0[4], p0[5]); w.w = cvtpk(p0[6], p0[7]); pa[0] = __builtin_bit_cast(bf16x8, w);
          w.x = cvtpk(p0[8], p0[9]); w.y = cvtpk(p0[10], p0[11]); w.z = cvtpk(p0[12], p0[13]); w.w = cvtpk(p0[14], p0[15]); pa[1] = __builtin_bit_cast(bf16x8, w);
          w.x = cvtpk(p1[0], p1[1]); w.y = cvtpk(p1[2], p1[3]); w.z = cvtpk(p1[4], p1[5]); w.w = cvtpk(p1[6], p1[7]); pa[2] = __builtin_bit_cast(bf16x8, w);
          w.x = cvtpk(p1[8], p1[9]); w.y = cvtpk(p1[10], p1[11]); w.z = cvtpk(p1[12], p1[13]); w.w = cvtpk(p1[14], p1[15]); pa[3] = __builtin_bit_cast(bf16x8, w); }
        __builtin_amdgcn_sched_barrier(0);
        __builtin_amdgcn_s_setprio(1);
#pragma unroll
        for (int db = 0; db < 4; ++db) {
            s16x4 lo[4], hi[4];
#pragma unroll
            for (int ks = 0; ks < 4; ++ks) { lo[ks] = vtr(Vb + (16 * ks) * VP + db * 64); hi[ks] = vtr(Vb + (16 * ks + 8) * VP + db * 64); }
#pragma unroll
            for (int ks = 0; ks < 4; ++ks) {
                const bf16x8 vf = (bf16x8){lo[ks][0], lo[ks][1], lo[ks][2], lo[ks][3], hi[ks][0], hi[ks][1], hi[ks][2], hi[ks][3]};
                o[db] = __builtin_amdgcn_mfma_f32_32x32x16_bf16(pa[ks], vf, o[db], 0, 0, 0);
            }
        }
        __builtin_amdgcn_s_setprio(0);
        if (kt + 1 < ntile) ATT_STORE(cur ^ 1);
        __syncthreads();
    }
#undef ATT_LOAD
#undef ATT_STORE
    l += __shfl_xor(l, 32);
    LAS float* wsl = (LAS float*)(lds + WSL_OFF);
    LAS float* X = (LAS float*)(lds + X_OFF);
    if (hh == 0) wsl[c * 128 + 32 * w4 + r32] = (c == 0 ? 1.0f : lam) / l;
    __syncthreads();
    if (c == 1) {
#pragma unroll
        for (int r = 0; r < 16; ++r) { const int ql = 32 * w4 + crow(r, hh); const float sc = wsl[128 + ql];
#pragma unroll
            for (int db = 0; db < 4; ++db) X[ql * 128 + 32 * db + r32] = o[db][r] * sc;
            if ((r & 3) == 3) __builtin_amdgcn_sched_barrier(0); }
    }
    __syncthreads();
    if (c == 0) {
        LAS bf16_t* ost = (LAS bf16_t*)(lds + OST_OFF + w4 * 8192);
        float gsub[4];
#pragma unroll
        for (int db = 0; db < 4; ++db) gsub[db] = A.in[I_SUBLN][32 * db + r32] * (1.0f - LAM_INIT);
#pragma unroll
        for (int r = 0; r < 16; ++r) {
            const int qw = crow(r, hh), ql = 32 * w4 + qw; const float sc = wsl[ql];
            float d[4], ss = 0.f;
#pragma unroll
            for (int db = 0; db < 4; ++db) { d[db] = o[db][r] * sc - X[ql * 128 + 32 * db + r32]; ss += d[db] * d[db]; }
            ss = row_sum16(ss); ss += __shfl_xor(ss, 16);
            const float rs = rsqrtf(ss * (1.0f / 128.0f) + EPS);
#pragma unroll
            for (int db = 0; db < 4; ++db) ost[qw * 128 + 32 * db + r32] = (bf16_t)f2bf(d[db] * rs * gsub[db]);
            if ((r & 3) == 3) __builtin_amdgcn_sched_barrier(0);
        }
        asm volatile("s_waitcnt lgkmcnt(0)" ::: "memory");
#pragma unroll
        for (int it = 0; it < 8; ++it) { const int row = it * 4 + (lane >> 4), ch = lane & 15;
            const u32x4 v = *(const LAS u32x4*)(ost + row * 128 + ch * 8);
            *(u32x4*)(ATT + (size_t)(b * SEQ + qb * 128 + 32 * w4 + row) * AW + h * 128 + ch * 8) = v; }
    }
    __syncthreads();
}
__device__ __forceinline__ void attn_phase(const Args& A, LAS unsigned char* lds, int G) {
    const float* par = (const float*)(A.ws + WS_PAR); const float lam = par[0], Mb = par[1];
    const int bx = blockIdx.x, vcu = (G % 8 == 0) ? (bx % 8) * (G / 8) + bx / 8 : bx;
    for (int item = vcu; item < 256; item += G) {
        const int bh = item >> 4, pr = item & 15;
#pragma unroll 1
        for (int u2 = 0; u2 < 2; ++u2) attn_unit(A, bh >> 3, bh & 7, u2 ? pr : 31 - pr, lds, lam, Mb);
    }
}
}

__device__ __forceinline__ float gelu_as(float v) {
    const float av = fabsf(v), t = __builtin_amdgcn_rcpf(av * 0.2316418882f + 1.0f);
    float q = t * 0.5307027145f + (-0.7265760135f); q = q * t + 0.7107068705f; q = q * t + (-0.142248368f); q = q * t + 0.127414796f; q = q * t;
    const float e = __builtin_amdgcn_exp2f((v * v) * (-0.72134752044f)), m = v * (q * e);
    return v < 0.f ? m : v - m;
}

namespace ssm {
typedef float f32x16 __attribute__((ext_vector_type(16)));
constexpr int L_APOW = 0, L_BB = 8704, L_CC = L_BB + 8192, L_KT = L_CC + 8192, L_DS = L_KT + 16384, L_XIN = L_DS + 64, XPITCH = 272, XBLK = 32 * XPITCH;
static_assert(L_XIN + 8 * XBLK <= RING_BYTES, "ssm LDS map");
__device__ __forceinline__ unsigned cvtpk(float lo, float hi) { f32x2 v = {lo, hi}; bf16x2_t b = __builtin_convertvector(v, bf16x2_t); return __builtin_bit_cast(unsigned, b); }
__device__ __forceinline__ void ssm_mm_phase(const Args& A, LAS unsigned char* lds, int G, int probe = 0) {
    const int tid = otid(), lane = tid & 63, wave = __builtin_amdgcn_readfirstlane(tid >> 6), r32 = lane & 31, hh = lane >> 5;
    unsigned char* ws = A.ws;
    const bf16_t* UB = (const bf16_t*)(ws + WS_UB); const bf16_t* UMB = (const bf16_t*)(ws + WS_UMB); bf16_t* YS = (bf16_t*)(ws + WS_YS);
    const float* abar = (const float*)(ws + WS_ABAR); const float* bbar = (const float*)(ws + WS_BBAR);
    LAS float* apow = (LAS float*)(lds + L_APOW); LAS float* Bb = (LAS float*)(lds + L_BB); LAS float* Cc = (LAS float*)(lds + L_CC); LAS float* Kt = (LAS float*)(lds + L_KT);
    if (blockIdx.x < 128) {
        const int item = blockIdx.x, b = item >> 6, g = item & 63;
        __syncthreads();
        if (tid < 64) { const float ar = abar[(g * 64 + tid) * 2], ai = abar[(g * 64 + tid) * 2 + 1]; float pr = 1.f, pi = 0.f;
            for (int t = 0; t <= 16; ++t) { apow[(t * 64 + tid) * 2] = pr; apow[(t * 64 + tid) * 2 + 1] = pi; const float nr = pr * ar - pi * ai, ni = pr * ai + pi * ar; pr = nr; pi = ni; } }
        *(LAS f32x4*)(Bb + 4 * tid) = *(const f32x4*)(bbar + (size_t)g * 2048 + 4 * tid);
        if (tid < 16) ((LAS float*)(lds + L_DS))[tid] = A.in[I_SSMD][g * 16 + tid];
#pragma unroll
        for (int q = 0; q < 2; ++q) { const int idx = 2 * tid + q, cc_ = idx >> 6, pp_ = idx & 63;
            Cc[(pp_ * 16 + cc_) * 2] = A.in[I_CRE][g * 1024 + idx]; Cc[(pp_ * 16 + cc_) * 2 + 1] = A.in[I_CIM][g * 1024 + idx]; }
        __syncthreads();
        { const int tau = tid >> 5, c = (tid >> 1) & 15, ch = tid & 1; float acc[8];
#pragma unroll
          for (int i = 0; i < 8; ++i) acc[i] = 0.f;
          for (int p = 0; p < 64; ++p) {
              const float cr = Cc[(p * 16 + c) * 2], ci = Cc[(p * 16 + c) * 2 + 1], ar = apow[(tau * 64 + p) * 2], ai = apow[(tau * 64 + p) * 2 + 1];
              const float wr = cr * ar - ci * ai, wi = cr * ai + ci * ar;
              const LAS f32x4* bp = (const LAS f32x4*)(Bb + (p * 16 + 8 * ch) * 2);
#pragma unroll
              for (int q = 0; q < 4; ++q) { const f32x4 bv = bp[q]; acc[2 * q] += wr * bv[0] - wi * bv[1]; acc[2 * q + 1] += wr * bv[2] - wi * bv[3]; }
          }
#pragma unroll
          for (int i = 0; i < 8; ++i) Kt[(tau * 16 + c) * 16 + 8 * ch + i] = acc[i]; }
        __syncthreads();
        if (probe == 3) return;
        if (wave < 4) {
            const int mb = wave;
            bf16x8 pf[16];
            { const int p = 16 * mb + (r32 >> 1), ri = r32 & 1;
#pragma unroll
              for (int sstep = 0; sstep < 16; ++sstep) {
                  const float ar = apow[((15 - sstep) * 64 + p) * 2], ai = apow[((15 - sstep) * 64 + p) * 2 + 1];
                  const float ca = ri ? ai : ar, cb_ = ri ? ar : -ai;
                  const LAS f32x4* bp = (const LAS f32x4*)(Bb + (p * 16 + 8 * hh) * 2); float v[8];
#pragma unroll
                  for (int q = 0; q < 4; ++q) { const f32x4 bv = bp[q]; v[2 * q] = ca * bv[0] + cb_ * bv[1]; v[2 * q + 1] = ca * bv[2] + cb_ * bv[3]; }
                  u32x4 w; w.x = cvtpk(v[0], v[1]); w.y = cvtpk(v[2], v[3]); w.z = cvtpk(v[4], v[5]); w.w = cvtpk(v[6], v[7]); pf[sstep] = __builtin_bit_cast(bf16x8, w);
                  if ((sstep & 3) == 3) __builtin_amdgcn_sched_barrier(0); } }
            const int pst = 16 * mb + (r32 >> 1);
            const float sca = apow[(16 * 64 + pst) * 2], scb = (r32 & 1) ? apow[(16 * 64 + pst) * 2 + 1] : -apow[(16 * 64 + pst) * 2 + 1];
            const int sig = (r32 & 3) + 4 * (r32 >> 3) + 16 * ((r32 >> 2) & 1);
            float xc;
            { f32x16 acc;
#pragma unroll
              for (int r = 0; r < 16; ++r) acc[r] = 0.f;
#pragma unroll
              for (int sstep = 0; sstep < 16; ++sstep) { const bf16x8 bf = *(const bf16x8*)(UMB + (size_t)sstep * SW + g * 16 + 8 * hh); acc = __builtin_amdgcn_mfma_f32_32x32x16_bf16(bf, pf[sstep], acc, 0, 0, 0); }
              xc = acc[0]; }
            bf16x8 ufr[16];
            { const bf16_t* up = UB + (size_t)(b * SEQ + 16 * sig) * SW + g * 16 + 8 * hh;
#pragma unroll
              for (int sstep = 0; sstep < 16; ++sstep) ufr[sstep] = *(const bf16x8*)(up + (size_t)sstep * SW); }
#pragma unroll 1
            for (int cb = 0; cb < 8; ++cb) {
                f32x16 acc;
#pragma unroll
                for (int r = 0; r < 16; ++r) acc[r] = 0.f;
#pragma unroll
                for (int sstep = 0; sstep < 16; ++sstep) acc = __builtin_amdgcn_mfma_f32_32x32x16_bf16(ufr[sstep], pf[sstep], acc, 0, 0, 0);
                if (cb + 1 < 8) {
                    const bf16_t* up = UB + (size_t)(b * SEQ + 16 * (32 * (cb + 1) + sig)) * SW + g * 16 + 8 * hh;
#pragma unroll
                    for (int sstep = 0; sstep < 16; ++sstep) ufr[sstep] = *(const bf16x8*)(up + (size_t)sstep * SW);
                }
                float xin[16]; float xs_ = hh ? 0.f : xc;
#pragma unroll
                for (int r = 0; r < 16; ++r) { xin[r] = xs_; const float pv = dpp_f<0xB1>(xs_); xs_ = sca * xs_ + scb * pv + acc[r]; }
                float f = __shfl_xor(xs_, 32); if (!hh) f = 0.f;
#pragma unroll
                for (int r = 0; r < 16; ++r) { xin[r] += f; const float pv = dpp_f<0xB1>(f); f = sca * f + scb * pv; }
                xs_ += f;
                xc = __shfl_xor(xs_, 32);
                LAS bf16_t* xo = (LAS bf16_t*)(lds + L_XIN + cb * XBLK + (16 * hh) * XPITCH) + 32 * mb + r32;
#pragma unroll
                for (int r = 0; r < 16; ++r) xo[r * (XPITCH / 2)] = (bf16_t)f2bf(xin[r]);
            }
        }
        __syncthreads();
        if (probe == 4) return;
        {
            const int cb = wave, tl = r32 >> 4, c = r32 & 15;
            const size_t row0 = (size_t)(b * SEQ + 16 * (32 * cb + r32));
            bf16x8 ufr[16];
            { const bf16_t* up = UB + row0 * SW + g * 16 + 8 * hh;
#pragma unroll
              for (int ks = 0; ks < 16; ++ks) ufr[ks] = *(const bf16x8*)(up + (size_t)ks * SW); }
            bf16x8 kl[16];
#pragma unroll
            for (int d1 = 0; d1 < 16; ++d1) {
                const int tau = d1 - 1 + tl; float v[8];
                if (tau >= 0) { const LAS f32x4* kp = (const LAS f32x4*)(Kt + (tau * 16 + c) * 16 + 8 * hh); const f32x4 k0 = kp[0], k1 = kp[1];
                    v[0] = k0[0]; v[1] = k0[1]; v[2] = k0[2]; v[3] = k0[3]; v[4] = k1[0]; v[5] = k1[1]; v[6] = k1[2]; v[7] = k1[3]; }
                else {
#pragma unroll
                    for (int i = 0; i < 8; ++i) v[i] = 0.f; }
                u32x4 wv; wv.x = cvtpk(v[0], v[1]); wv.y = cvtpk(v[2], v[3]); wv.z = cvtpk(v[4], v[5]); wv.w = cvtpk(v[6], v[7]); kl[d1] = __builtin_bit_cast(bf16x8, wv);
                if ((d1 & 3) == 3) __builtin_amdgcn_sched_barrier(0);
            }
            const LAS unsigned char* xi_ = lds + L_XIN + cb * XBLK + r32 * XPITCH + 16 * hh;
#pragma unroll
            for (int mb = 0; mb < 8; ++mb) {
                int dq = 4 * hh; asm volatile("" : "+v"(dq));
                const f32x4 d0 = *(const LAS f32x4*)((LAS float*)(lds + L_DS) + dq), d1 = *(const LAS f32x4*)((LAS float*)(lds + L_DS) + dq + 8);
                const float dsk[8] = {d0[0], d0[1], d0[2], d0[3], d1[0], d1[1], d1[2], d1[3]};
                f32x16 acc;
#pragma unroll
                for (int r = 0; r < 16; ++r) acc[r] = 0.f;
#pragma unroll
                for (int ks = 0; ks < 16; ++ks) if (ks <= 2 * mb + 1) acc = __builtin_amdgcn_mfma_f32_32x32x16_bf16(kl[2 * mb - ks + 1], ufr[ks], acc, 0, 0, 0);
                int cq = c + 64 * hh; asm volatile("" : "+v"(cq));
#pragma unroll
                for (int ks = 0; ks < 8; ++ks) {
                    float v[8];
#pragma unroll
                    for (int i2 = 0; i2 < 4; ++i2) { const int p = 8 * ks + 4 * hh + i2;
                        const float c_r = Cc[(cq + 128 * ks + 16 * i2) * 2], c_i = Cc[(cq + 128 * ks + 16 * i2) * 2 + 1], ar = apow[((2 * mb + tl + 1) * 64 + p) * 2], ai = apow[((2 * mb + tl + 1) * 64 + p) * 2 + 1];
                        v[2 * i2] = c_r * ar - c_i * ai; v[2 * i2 + 1] = -(c_r * ai + c_i * ar); }
                    u32x4 wv; wv.x = cvtpk(v[0], v[1]); wv.y = cvtpk(v[2], v[3]); wv.z = cvtpk(v[4], v[5]); wv.w = cvtpk(v[6], v[7]);
                    acc = __builtin_amdgcn_mfma_f32_32x32x16_bf16(__builtin_bit_cast(bf16x8, wv), *(const LAS bf16x8*)(xi_ + 32 * ks), acc, 0, 0, 0);
                }
#pragma unroll
                for (int t2 = 0; t2 < 2; ++t2) {
                    const u32x4 uf = __builtin_bit_cast(u32x4, ufr[2 * mb + t2]);
                    const unsigned s0 = hh ? uf.x : uf.z, s1 = hh ? uf.y : uf.w;
                    const unsigned r0 = (unsigned)__shfl_xor((int)s0, 32), r1 = (unsigned)__shfl_xor((int)s1, 32);
                    const unsigned own0 = hh ? uf.z : uf.x, own1 = hh ? uf.w : uf.y;
                    const unsigned c0a = hh ? r0 : own0, c0b = hh ? r1 : own1, c1a = hh ? own0 : r0, c1b = hh ? own1 : r1;
                    const unsigned ua[2] = {c0a, c1a}, ub[2] = {c0b, c1b};
#pragma unroll
                    for (int ch = 0; ch < 2; ++ch) {
                        const size_t off = (row0 + 2 * mb + t2) * SW + g * 16 + 4 * hh + 8 * ch;
                        const float y0 = gelu_as(acc[8 * t2 + 4 * ch + 0] + dsk[4 * ch + 0] * bflo(ua[ch])), y1 = gelu_as(acc[8 * t2 + 4 * ch + 1] + dsk[4 * ch + 1] * bfhi(ua[ch]));
                        const float y2 = gelu_as(acc[8 * t2 + 4 * ch + 2] + dsk[4 * ch + 2] * bflo(ub[ch])), y3 = gelu_as(acc[8 * t2 + 4 * ch + 3] + dsk[4 * ch + 3] * bfhi(ub[ch]));
                        u32x2 o; o.x = cvtpk(y0, y1); o.y = cvtpk(y2, y3); *(u32x2*)(YS + off) = o;
                    }
                }
                __builtin_amdgcn_sched_barrier(0);
            }
        }
    }
}
}

namespace tk {
typedef float f32x16 __attribute__((ext_vector_type(16)));
__device__ __forceinline__ unsigned fkey(float f) { const unsigned u = __builtin_bit_cast(unsigned, f); return (u & 0x80000000u) ? ~u : (u | 0x80000000u); }
__device__ __forceinline__ float kval(unsigned k) { const unsigned u = (k & 0x80000000u) ? (k & 0x7fffffffu) : ~k; return __builtin_bit_cast(float, u); }
__device__ __forceinline__ void ce(unsigned& a, unsigned& b) { const unsigned hi = a > b ? a : b, lo = a > b ? b : a; a = hi; b = lo; }
template <int N> __device__ __forceinline__ void sort_desc(unsigned (&a)[N]) {
#pragma unroll
    for (int k = 2; k <= N; k <<= 1)
#pragma unroll
        for (int j = k >> 1; j > 0; j >>= 1)
#pragma unroll
            for (int i = 0; i < N; ++i) { const int l = i ^ j; if (l > i) { if ((i & k) == 0) ce(a[i], a[l]); else ce(a[l], a[i]); } }
}
__device__ __forceinline__ void merge_top16(unsigned (&a)[16], const unsigned (&b)[16]) {
#pragma unroll
    for (int i = 0; i < 16; ++i) a[i] = a[i] > b[15 - i] ? a[i] : b[15 - i];
#pragma unroll
    for (int j = 8; j > 0; j >>= 1)
#pragma unroll
        for (int i = 0; i < 16; ++i) { const int l = i ^ j; if (l > i) ce(a[i], a[l]); }
}
__device__ __forceinline__ void peer_topk_phase(const Args& A, LAS unsigned char* lds, int G) {
    const int tid = otid(), lane = tid & 63, wave = __builtin_amdgcn_readfirstlane(tid >> 6), r32 = lane & 31, hh = lane >> 5;
    unsigned char* ws = A.ws;
    const bf16_t* QP = (const bf16_t*)(ws + WS_QP); const bf16_t* K12 = (const bf16_t*)(ws + WS_K12); int* IDX = (int*)(ws + WS_IDX); float* GW = (float*)(ws + WS_GW);
    LAS unsigned* tl = (LAS unsigned*)(lds + wave * 8192);
    pg8::StaticOrder S5; S5.init(MTOK, DM, G, (int)blockIdx.x);
    pg8::Unit u5;
    for (int ui = 0; S5.next(ui, u5); ++ui) {
        const int h = u5.pn, tb = u5.pm * 8 + wave, tok = tb * 32 + r32;
        unsigned lst[2][16];
#pragma unroll
        for (int half = 0; half < 2; ++half) {
            const bf16_t* qp = QP + (size_t)tok * DM + h * 256 + half * 128 + 8 * hh;
            const bf16_t* kp = K12 + ((size_t)(half * 8 + h) * 128 + r32) * 128 + 8 * hh;
            bf16x8 qf[8];
#pragma unroll
            for (int ds = 0; ds < 8; ++ds) qf[ds] = *(const bf16x8*)(qp + 16 * ds);
            f32x16 sc[4];
#pragma unroll
            for (int kb = 0; kb < 4; ++kb) {
#pragma unroll
                for (int r = 0; r < 16; ++r) sc[kb][r] = 0.f;
#pragma unroll
                for (int ds = 0; ds < 8; ++ds) { const bf16x8 kf = *(const bf16x8*)(kp + (size_t)kb * 32 * 128 + 16 * ds); sc[kb] = __builtin_amdgcn_mfma_f32_32x32x16_bf16(kf, qf[ds], sc[kb], 0, 0, 0); }
            }
            unsigned g0[16], g1[16];
#pragma unroll
            for (int r = 0; r < 16; ++r) { const int kc = (r & 3) + 8 * (r >> 2) + 4 * hh; g0[r] = (fkey(sc[0][r]) & ~127u) | (unsigned)(127 - kc); g1[r] = (fkey(sc[1][r]) & ~127u) | (unsigned)(127 - 32 - kc); }
            sort_desc<16>(g0); sort_desc<16>(g1); merge_top16(g0, g1);
#pragma unroll
            for (int r = 0; r < 16; ++r) { const int kc = (r & 3) + 8 * (r >> 2) + 4 * hh; lst[half][r] = (fkey(sc[2][r]) & ~127u) | (unsigned)(127 - 64 - kc); g1[r] = (fkey(sc[3][r]) & ~127u) | (unsigned)(127 - 96 - kc); }
            sort_desc<16>(lst[half]); sort_desc<16>(g1); merge_top16(lst[half], g1); merge_top16(lst[half], g0);
        }
        unsigned mine[16], oth[16];
#pragma unroll
        for (int i = 0; i < 16; ++i) { const unsigned send = hh ? lst[0][i] : lst[1][i]; mine[i] = hh ? lst[1][i] : lst[0][i]; oth[i] = (unsigned)__shfl_xor((int)send, 32); }
        merge_top16(mine, oth);
#pragma unroll
        for (int i = 0; i < 16; ++i) tl[(16 * hh + i) * 64 + r32] = mine[i];
        asm volatile("s_waitcnt lgkmcnt(0)" ::: "memory");
        float v1[16], v2[16];
#pragma unroll
        for (int i = 0; i < 16; ++i) { v1[i] = kval(tl[i * 64 + r32] & ~127u); v2[i] = kval(tl[(16 + i) * 64 + r32] & ~127u); }
#define CKEY(i, j) ((fkey(v1[i] + v2[j]) & ~255u) | (unsigned)(255 - (16 * (i) + (j))))
        unsigned c0[16], c1[16];
#pragma unroll
        for (int j = 0; j < 16; ++j) c0[j] = CKEY(0, j);
#pragma unroll
        for (int j = 0; j < 8; ++j) c1[j] = CKEY(1, j);
#pragma unroll
        for (int j = 0; j < 5; ++j) c1[8 + j] = CKEY(2, j);
        c1[13] = CKEY(3, 0); c1[14] = CKEY(3, 1); c1[15] = CKEY(3, 2);
        sort_desc<16>(c1); merge_top16(c0, c1);
        c1[0] = CKEY(3, 3); c1[1] = CKEY(4, 0); c1[2] = CKEY(4, 1); c1[3] = CKEY(4, 2); c1[4] = CKEY(5, 0); c1[5] = CKEY(5, 1); c1[6] = CKEY(6, 0); c1[7] = CKEY(6, 1);
        c1[8] = CKEY(7, 0); c1[9] = CKEY(7, 1); c1[10] = CKEY(8, 0); c1[11] = CKEY(9, 0); c1[12] = CKEY(10, 0); c1[13] = CKEY(11, 0); c1[14] = CKEY(12, 0); c1[15] = CKEY(13, 0);
        sort_desc<16>(c1); merge_top16(c0, c1);
        c1[0] = CKEY(14, 0); c1[1] = CKEY(15, 0);
#pragma unroll
        for (int i = 2; i < 16; ++i) c1[i] = 0u;
        sort_desc<16>(c1); merge_top16(c0, c1);
#undef CKEY
        float ev[16], se = 0.f; const float mx = kval(c0[0] & ~255u);
#pragma unroll
        for (int k = 0; k < 16; ++k) { ev[k] = __expf(kval(c0[k] & ~255u) - mx); se += ev[k]; }
        const float inv = 1.0f / se;
        if (hh == 0) {
            int ex[16];
#pragma unroll
            for (int k = 0; k < 16; ++k) { const int cid = 255 - (int)(c0[k] & 255u), i = cid >> 4, j = cid & 15;
                const int e1 = 127 - (int)(tl[i * 64 + r32] & 127u), e2 = 127 - (int)(tl[(16 + j) * 64 + r32] & 127u); ex[k] = e1 * 128 + e2; }
            int* ip = IDX + (size_t)tok * 128 + h * 16;
#pragma unroll
            for (int k = 0; k < 16; k += 4) *(u32x4*)(ip + k) = (u32x4){(unsigned)ex[k], (unsigned)ex[k + 1], (unsigned)ex[k + 2], (unsigned)ex[k + 3]};
        } else {
            float* gp = GW + (size_t)tok * 128 + h * 16;
#pragma unroll
            for (int k = 0; k < 16; k += 4) *(f32x4*)(gp + k) = (f32x4){ev[k] * inv, ev[k + 1] * inv, ev[k + 2] * inv, ev[k + 3] * inv};
        }
        asm volatile("s_waitcnt lgkmcnt(0)" ::: "memory");
    }
}
}

#define XB_TMO      128
#define XB_XCNT(j)  (256  + 64 * (j))
#define XB_XSUB(j)  (1280 + 64 * (j))
#define XB_XGEN(j)  (2304 + 64 * (j))
#define XB_TOP      3328
#define XB_TOPGEN   3392
#define XCD_BAR_WORDS 3456
#define XB_SPIN_CAP (1u << 18)
__device__ __forceinline__ unsigned xb_ld(unsigned* p)              { return __hip_atomic_load(p, __ATOMIC_RELAXED, __HIP_MEMORY_SCOPE_AGENT); }
__device__ __forceinline__ unsigned xb_add(unsigned* p, unsigned v) { return __hip_atomic_fetch_add(p, v, __ATOMIC_RELAXED, __HIP_MEMORY_SCOPE_AGENT); }
__device__ __forceinline__ unsigned xb_xcc_id() { return (unsigned)__builtin_amdgcn_s_getreg((3 << 11) | 20) & 0xFu; }
#define XB_SPIN(cond, bar) do { unsigned _sp = 0; while (cond) { __builtin_amdgcn_s_sleep(1); \
    if ((++_sp & 255u) == 0u) { if (xb_ld(&(bar)[XB_TMO])) break; if (_sp > XB_SPIN_CAP) { atomicAdd(&(bar)[XB_TMO], 1u); break; } } } } while (0)
struct XcdBarrier { unsigned* bar; unsigned x; volatile LAS unsigned* st; };
__device__ __forceinline__ XcdBarrier xcd_barrier_post(unsigned* bar, volatile LAS unsigned* st) {
    XcdBarrier b; b.bar = bar; b.x = xb_xcc_id(); b.st = st;
    if (threadIdx.x == 0) (void)xb_add(&bar[XB_XCNT(b.x)], 1u);
    return b;
}
__device__ __forceinline__ void xcd_barrier_complete(unsigned* bar, unsigned x, unsigned& nloc, unsigned& nx) {
    const unsigned G = gridDim.x * gridDim.y * gridDim.z;
    unsigned sum, cnt, mine, sp = 0u;
    for (;;) {
        sum = 0u; cnt = 0u; mine = 0u;
#pragma unroll
        for (unsigned j = 0; j < 16; ++j) { const unsigned c = xb_ld(&bar[XB_XCNT(j)]); sum += c; cnt += (c > 0u) ? 1u : 0u; mine = (j == x) ? c : mine; }
        if (sum == G) break;
        __builtin_amdgcn_s_sleep(1);
        if ((++sp & 255u) == 0u) { if (xb_ld(&bar[XB_TMO])) break; if (sp > XB_SPIN_CAP) { atomicAdd(&bar[XB_TMO], 1u); break; } }
    }
    nloc = mine > 0u ? mine : 1u; nx = cnt > 0u ? cnt : 1u;
}
__device__ __forceinline__ void xcd_barrier(const XcdBarrier& b) {
    asm volatile("s_waitcnt vmcnt(0)" ::: "memory");
    __syncthreads();
    if (threadIdx.x == 0) {
        unsigned* bar = b.bar;
        __builtin_amdgcn_s_waitcnt(0);
        unsigned nloc = b.st[0], nx = b.st[1];
        if (nloc == 0u) { xcd_barrier_complete(bar, b.x, nloc, nx); b.st[0] = nloc; b.st[1] = nx; }
        const unsigned old = xb_add(&bar[XB_XSUB(b.x)], 1u);
        const unsigned gen = old / nloc;
        if (old + 1u == (gen + 1u) * nloc) {
            __builtin_amdgcn_fence(__ATOMIC_RELEASE, "agent");
            asm volatile("s_waitcnt vmcnt(0)" ::: "memory");
            const unsigned og = xb_add(&bar[XB_TOP], 1u);
            const unsigned tg = og / nx;
            if (og + 1u == (tg + 1u) * nx) xb_add(&bar[XB_TOPGEN], 1u);
            else XB_SPIN(xb_ld(&bar[XB_TOPGEN]) == tg, bar);
            __builtin_amdgcn_fence(__ATOMIC_ACQUIRE, "agent");
            xb_add(&bar[XB_XGEN(b.x)], 1u);
            asm volatile("s_waitcnt vmcnt(0)" ::: "memory");
        } else {
            XB_SPIN(xb_ld(&bar[XB_XGEN(b.x)]) == gen, bar);
            __builtin_amdgcn_fence(__ATOMIC_ACQUIRE, "agent");
            asm volatile("s_waitcnt vmcnt(0)" ::: "memory");
        }
    }
    __syncthreads();
}

namespace sg {
constexpr int NSL = 16, SLW = 128, TBK = 32, NTB = MTOK / TBK;
constexpr int CW_U = 8192, CW_V = 8192 + 64 * NSL;
template <int D> __device__ __forceinline__ float xsl(float a, float b, bool bit, int ln) { const float send = bit ? a : b, keep = bit ? b : a;
    return keep + __builtin_bit_cast(float, __builtin_amdgcn_ds_bpermute((ln ^ D) << 2, __builtin_bit_cast(int, send))); }
template <int D> __device__ __forceinline__ float xs(float a, float b, bool bit) { const float send = bit ? a : b, keep = bit ? b : a; return keep + __shfl_xor(send, D); }
__device__ __forceinline__ void quant_rows(const Args& A, int G) {
    const int tid = otid(), lane = tid & 63, wave = __builtin_amdgcn_readfirstlane(tid >> 6);
    unsigned char* ws = A.ws; const bf16_t* H2G = (const bf16_t*)(ws + WS_XN); const float* PARTSS = (const float*)(ws + WS_PARTSS);
    const int NW = G * NWAVES;
    for (int r0 = blockIdx.x * NWAVES + wave; r0 < MTOK; r0 += 4 * NW) {
        u32x4 hb[4][4]; float ssq[4];
#pragma unroll
        for (int q = 0; q < 4; ++q) { const int r = r0 + q * NW; const bool ok = r < MTOK; const u32x4* hp = (const u32x4*)(H2G + (size_t)(ok ? r : r0) * DM) + lane;
#pragma unroll
            for (int j = 0; j < 4; ++j) hb[q][j] = hp[64 * j];
            ssq[q] = (lane < 32) ? PARTSS[(size_t)lane * MTOK + (ok ? r : r0)] : 0.f; }
        asm volatile("" ::: "memory");
#pragma unroll
        for (int q = 0; q < 4; ++q) {
            const int r = r0 + q * NW; if (r >= MTOK) break;
            const float rs = rsqrtf(wave_sum(ssq[q]) * (1.0f / DM) + EPS);
            float hm = 0.f;
#pragma unroll
            for (int j = 0; j < 4; ++j) { hm = fmaxf(hm, fmaxf(fmaxf(fabsf(bflo(hb[q][j].x)), fabsf(bfhi(hb[q][j].x))), fmaxf(fabsf(bflo(hb[q][j].y)), fabsf(bfhi(hb[q][j].y)))));
                hm = fmaxf(hm, fmaxf(fmaxf(fabsf(bflo(hb[q][j].z)), fabsf(bfhi(hb[q][j].z))), fmaxf(fabsf(bflo(hb[q][j].w)), fabsf(bfhi(hb[q][j].w))))); }
            hm = wave_max(hm);
            const float hinv = hm > 0.f ? 127.0f / hm : 0.f;
            u32x2* dst = (u32x2*)(ws + WS_HQ + (size_t)r * DM) + lane;
#pragma unroll
            for (int j = 0; j < 4; ++j) { const unsigned wd[4] = {hb[q][j].x, hb[q][j].y, hb[q][j].z, hb[q][j].w}; u32x2 o;
#pragma unroll
                for (int h2 = 0; h2 < 2; ++h2) { const int q0 = (int)rintf(bflo(wd[2 * h2]) * hinv), q1 = (int)rintf(bfhi(wd[2 * h2]) * hinv), q2 = (int)rintf(bflo(wd[2 * h2 + 1]) * hinv), q3 = (int)rintf(bfhi(wd[2 * h2 + 1]) * hinv);
                    const unsigned pk = (unsigned)(q0 & 255) | ((unsigned)(q1 & 255) << 8) | ((unsigned)(q2 & 255) << 16) | ((unsigned)(q3 & 255) << 24); if (h2 == 0) o.x = pk; else o.y = pk; }
                dst[64 * j] = o; }
            if (lane == 0) ((float*)(ws + WS_HT))[r] = hm * (1.0f / 127.0f) * rs;
        }
    }
}
template <int NCOL>
__device__ __forceinline__ void quant_pass(const bf16_t* src, unsigned char* dst, float* sc, int G) {
    const int tid = otid(), lane = tid & 63, wave = __builtin_amdgcn_readfirstlane(tid >> 6);
    constexpr int NL = NCOL / 512;
    const int NW = G * NWAVES;
    for (int r0 = blockIdx.x * NWAVES + wave; r0 < MTOK; r0 += 4 * NW) {
        u32x4 hb[4][NL];
#pragma unroll
        for (int q = 0; q < 4; ++q) { const int r = r0 + q * NW; const bool ok = r < MTOK; const u32x4* hp = (const u32x4*)(src + (size_t)(ok ? r : r0) * NCOL) + lane;
#pragma unroll
            for (int j = 0; j < NL; ++j) hb[q][j] = hp[64 * j]; }
        asm volatile("" ::: "memory");
#pragma unroll
        for (int q = 0; q < 4; ++q) {
            const int r = r0 + q * NW; if (r >= MTOK) break;
            float hm = 0.f;
#pragma unroll
            for (int j = 0; j < NL; ++j) { hm = fmaxf(hm, fmaxf(fmaxf(fabsf(bflo(hb[q][j].x)), fabsf(bfhi(hb[q][j].x))), fmaxf(fabsf(bflo(hb[q][j].y)), fabsf(bfhi(hb[q][j].y)))));
                hm = fmaxf(hm, fmaxf(fmaxf(fabsf(bflo(hb[q][j].z)), fabsf(bfhi(hb[q][j].z))), fmaxf(fabsf(bflo(hb[q][j].w)), fabsf(bfhi(hb[q][j].w))))); }
            hm = wave_max(hm);
            const float hinv = hm > 0.f ? 127.0f / hm : 0.f;
            u32x2* d = (u32x2*)(dst + (size_t)r * NCOL) + lane;
#pragma unroll
            for (int j = 0; j < NL; ++j) { const unsigned wd[4] = {hb[q][j].x, hb[q][j].y, hb[q][j].z, hb[q][j].w}; u32x2 o;
#pragma unroll
                for (int h2 = 0; h2 < 2; ++h2) { const int q0 = (int)rintf(bflo(wd[2 * h2]) * hinv), q1 = (int)rintf(bfhi(wd[2 * h2]) * hinv), q2 = (int)rintf(bflo(wd[2 * h2 + 1]) * hinv), q3 = (int)rintf(bfhi(wd[2 * h2 + 1]) * hinv);
                    const unsigned pk = (unsigned)(q0 & 255) | ((unsigned)(q1 & 255) << 8) | ((unsigned)(q2 & 255) << 16) | ((unsigned)q3 << 24); if (h2 == 0) o.x = pk; else o.y = pk; }
                d[64 * j] = o; }
            if (lane == 0) sc[r] = hm * (1.0f / 127.0f);
        }
    }
}
__device__ __forceinline__ bool pop_item(unsigned* ctr, int xcd, int& si, int& slice, int& tb, volatile LAS int* bc) {
    for (;;) {
        if (si >= NSL) return false;
        const int s = (2 * xcd + si) & (NSL - 1);
        __syncthreads();
        if (threadIdx.x == 0) { const int pre = bc[1]; bc[0] = pre >= 0 ? pre : (int)__hip_atomic_fetch_add(ctr + 64 * s, 1u, __ATOMIC_RELAXED, __HIP_MEMORY_SCOPE_AGENT); bc[1] = -1; }
        __syncthreads();
        const int t = bc[0];
        if (t < NTB) { slice = s; tb = t;
            if (threadIdx.x == 0) bc[1] = (int)__hip_atomic_fetch_add(ctr + 64 * s, 1u, __ATOMIC_RELAXED, __HIP_MEMORY_SCOPE_AGENT);
            return true; }
        ++si;
    }
}
__device__ __forceinline__ void upass_phase(const Args& A, LAS unsigned char* lds, int G) {
    const int tid = otid(), lane = tid & 63, wave = __builtin_amdgcn_readfirstlane(tid >> 6), sub = lane >> 3, piece = lane & 7;
    unsigned char* ws = A.ws; const unsigned char* UQ = ws + WS_UE; const unsigned char* HQ = ws + WS_HQ; const int* IDX = (const int*)(ws + WS_IDX); float* AP = (float*)(ws + WS_APART);
    const bool b0 = (lane & 1) != 0, b1 = (lane & 2) != 0, b2 = (lane & 4) != 0;
    const int j0 = (b2 ? 2 : 0) + (b1 ? 4 : 0) + (b0 ? 8 : 0);
    const int xcd = (int)(xb_xcc_id() & 7u); int si = 0, slice, tb;
    volatile LAS int* bc = (volatile LAS int*)(lds + LDS_BYTES - 128);
    if (threadIdx.x == 0) bc[1] = -1;
    LAS unsigned* sidx = (LAS unsigned*)(lds + 16384 + wave * 4096);
    LAS u32x4* shq = (LAS u32x4*)(lds + 16384 + wave * 4096 + 2048);
    while (pop_item((unsigned*)(ws + WS_CTL) + CW_U, xcd, si, slice, tb, bc)) {
        { const int t0 = tb * TBK + wave;
#pragma unroll
          for (int i = 0; i < 4; ++i) { const u32x2 v = *((const u32x2*)(IDX + (size_t)(t0 + NWAVES * i) * 128) + lane); *(LAS u32x2*)(sidx + i * 128 + 2 * lane) = v; }
          if (lane < 32) { const int i = lane >> 3, pc = lane & 7; shq[lane] = *(const u32x4*)(HQ + (size_t)(t0 + NWAVES * i) * DM + slice * SLW + 16 * pc); }
          asm volatile("s_waitcnt vmcnt(0) lgkmcnt(0)" ::: "memory"); }
#define UP_G(buf, I, H) do { const u32x4 i0_ = *(const LAS u32x4*)(sidx + (I) * 128 + 16 * sub + 8 * (H)), i1_ = *(const LAS u32x4*)(sidx + (I) * 128 + 16 * sub + 8 * (H) + 4); \
            const unsigned ex_[8] = {i0_.x, i0_.y, i0_.z, i0_.w, i1_.x, i1_.y, i1_.z, i1_.w}; \
            _Pragma("unroll") for (int j_ = 0; j_ < 8; ++j_) buf[j_] = *(const u32x4*)(UQ + (size_t)ex_[j_] * DM + slice * SLW + 16 * piece); \
            asm volatile("" ::: "memory"); } while (0)
#define UP_C(vv, buf, I) do { const u32x4 hq_ = shq[(I) * 8 + piece]; _Pragma("unroll") for (int j_ = 0; j_ < 8; ++j_) { \
            int sd_ = __builtin_amdgcn_sdot4((int)buf[j_].x, (int)hq_.x, 0, false); sd_ = __builtin_amdgcn_sdot4((int)buf[j_].y, (int)hq_.y, sd_, false); \
            sd_ = __builtin_amdgcn_sdot4((int)buf[j_].z, (int)hq_.z, sd_, false); sd_ = __builtin_amdgcn_sdot4((int)buf[j_].w, (int)hq_.w, sd_, false); vv[j_] = (float)sd_; } } while (0)
#define UP_F(I) do { float w8_[8], w4_[4], w2_[2]; \
            _Pragma("unroll") for (int q_ = 0; q_ < 8; ++q_) w8_[q_] = xs<1>(vlo[q_], vhi[q_], b0); \
            _Pragma("unroll") for (int q_ = 0; q_ < 4; ++q_) w4_[q_] = xs<2>(w8_[q_], w8_[q_ + 4], b1); \
            _Pragma("unroll") for (int q_ = 0; q_ < 2; ++q_) w2_[q_] = xs<4>(w4_[q_], w4_[q_ + 2], b2); \
            *(f32x2*)(AP + ((size_t)slice * MTOK + tb * TBK + wave + NWAVES * (I)) * 128 + 16 * sub + j0) = (f32x2){w2_[0], w2_[1]}; } while (0)
        { u32x4 bufA[8], bufB[8]; float vlo[8], vhi[8];
          UP_G(bufA, 0, 0); UP_G(bufB, 0, 1);
          UP_C(vlo, bufA, 0); UP_G(bufA, 1, 0);
          UP_C(vhi, bufB, 0); UP_G(bufB, 1, 1); UP_F(0);
          UP_C(vlo, bufA, 1); UP_G(bufA, 2, 0);
          UP_C(vhi, bufB, 1); UP_G(bufB, 2, 1); UP_F(1);
          UP_C(vlo, bufA, 2); UP_G(bufA, 3, 0);
          UP_C(vhi, bufB, 2); UP_G(bufB, 3, 1); UP_F(2);
          UP_C(vlo, bufA, 3);
          UP_C(vhi, bufB, 3); UP_F(3); }
#undef UP_G
#undef UP_C
#undef UP_F
    }
}
__device__ __forceinline__ void combine_phase(const Args& A, int G) {
    const int tid = otid(), lane = tid & 63, wave = __builtin_amdgcn_readfirstlane(tid >> 6);
    unsigned char* ws = A.ws; const float* AP = (const float*)(ws + WS_APART); const int* IDX = (const int*)(ws + WS_IDX); float* GW = (float*)(ws + WS_GW);
    const float* SU = (const float*)(ws + WS_SU); const float* SV = (const float*)(ws + WS_SV); const float* HT = (const float*)(ws + WS_HT);
    for (int tok = blockIdx.x * NWAVES + wave; tok < MTOK; tok += G * NWAVES) {
        const float tsc = HT[tok];
#pragma unroll
        for (int hf = 0; hf < 2; ++hf) { const int k = lane + 64 * hf; float a = 0.f;
#pragma unroll
            for (int sl = 0; sl < NSL; ++sl) a += __builtin_nontemporal_load(AP + ((size_t)sl * MTOK + tok) * 128 + k);
            const int e = IDX[(size_t)tok * 128 + k];
            GW[(size_t)tok * 128 + k] = GW[(size_t)tok * 128 + k] * gelu_exact(a * SU[e] * tsc) * SV[e]; }
    }
}
__device__ __forceinline__ void vpass_phase(const Args& A, LAS unsigned char* lds, int G) {
    const int tid = otid(), lane = tid & 63, wave = __builtin_amdgcn_readfirstlane(tid >> 6);
    unsigned char* ws = A.ws; const unsigned char* VQ = ws + WS_VE; const int* IDX = (const int*)(ws + WS_IDX); const float* GW = (const float*)(ws + WS_GW);
    const bf16_t* H2B = (const bf16_t*)(ws + WS_XN); float* OUT = A.out;
    const int xcd = (int)(xb_xcc_id() & 7u); int si = 0, slice, tb;
    volatile LAS int* bc = (volatile LAS int*)(lds + LDS_BYTES - 128);
    if (threadIdx.x == 0) bc[1] = -1;
    LAS unsigned* sidx = (LAS unsigned*)(lds + 16384 + wave * 4096);
    LAS float* sw = (LAS float*)(lds + 16384 + wave * 4096 + 2048);
    while (pop_item((unsigned*)(ws + WS_CTL) + CW_V, xcd, si, slice, tb, bc)) {
        int ln = (int)threadIdx.x; asm volatile("" : "+v"(ln)); ln &= 63;
        const int sub = ln >> 3, piece = ln & 7; const bool b3 = (ln & 8) != 0, b4 = (ln & 16) != 0, b5 = (ln & 32) != 0;
        const int c0 = (b5 ? 2 : 0) + (b4 ? 4 : 0) + (b3 ? 8 : 0);
        { const int t0 = tb * TBK + wave;
#pragma unroll
          for (int i = 0; i < 4; ++i) { const u32x2 v = *((const u32x2*)(IDX + (size_t)(t0 + NWAVES * i) * 128) + ln); *(LAS u32x2*)(sidx + i * 128 + 2 * ln) = v;
              const f32x2 g = *((const f32x2*)(GW + (size_t)(t0 + NWAVES * i) * 128) + ln); *(LAS f32x2*)(sw + i * 128 + 2 * ln) = g; }
          asm volatile("s_waitcnt vmcnt(0) lgkmcnt(0)" ::: "memory"); }
        const unsigned colb = (unsigned)(slice * SLW + 16 * piece);
#define VP_G(buf, I, H) do { const u32x4 i0_ = *(const LAS u32x4*)(sidx + (I) * 128 + 16 * sub + 8 * (H)), i1_ = *(const LAS u32x4*)(sidx + (I) * 128 + 16 * sub + 8 * (H) + 4); \
            const unsigned ex_[8] = {i0_.x, i0_.y, i0_.z, i0_.w, i1_.x, i1_.y, i1_.z, i1_.w}; \
            _Pragma("unroll") for (int j_ = 0; j_ < 8; ++j_) buf[j_] = *(const u32x4*)(VQ + (ex_[j_] * (unsigned)DM + colb)); \
            asm volatile("" ::: "memory"); } while (0)
#define VP_H(hv, I) do { hv = *(const unsigned*)((const unsigned char*)H2B + (((unsigned)(tb * TBK + wave + NWAVES * (I)) * (unsigned)DM + colb + c0) * 2u)); asm volatile("" ::: "memory"); } while (0)
#define VP_C(buf, I, H) do { const f32x4 w0_ = *(const LAS f32x4*)(sw + (I) * 128 + 16 * sub + 8 * (H)), w1_ = *(const LAS f32x4*)(sw + (I) * 128 + 16 * sub + 8 * (H) + 4); \
            const float wk_[8] = {w0_[0], w0_[1], w0_[2], w0_[3], w1_[0], w1_[1], w1_[2], w1_[3]}; \
            _Pragma("unroll") for (int j_ = 0; j_ < 8; ++j_) { const unsigned wd_[4] = {buf[j_].x, buf[j_].y, buf[j_].z, buf[j_].w}; \
                _Pragma("unroll") for (int d_ = 0; d_ < 4; ++d_) { const f32x2 lo_ = __builtin_amdgcn_cvt_pk_f32_fp8((int)wd_[d_], false), hi_ = __builtin_amdgcn_cvt_pk_f32_fp8((int)wd_[d_], true); \
                    acc[4 * d_] += wk_[j_] * lo_.x; acc[4 * d_ + 1] += wk_[j_] * lo_.y; acc[4 * d_ + 2] += wk_[j_] * hi_.x; acc[4 * d_ + 3] += wk_[j_] * hi_.y; } } } while (0)
#define VP_F(hv, I) do { float w8_[8], w4_[4], w2_[2]; \
            _Pragma("unroll") for (int q_ = 0; q_ < 8; ++q_) w8_[q_] = xsl<8>(acc[q_], acc[q_ + 8], b3, ln); \
            _Pragma("unroll") for (int q_ = 0; q_ < 4; ++q_) w4_[q_] = xsl<16>(w8_[q_], w8_[q_ + 4], b4, ln); \
            _Pragma("unroll") for (int q_ = 0; q_ < 2; ++q_) w2_[q_] = xsl<32>(w4_[q_], w4_[q_ + 2], b5, ln); \
            *(f32x2*)((unsigned char*)OUT + (((unsigned)(tb * TBK + wave + NWAVES * (I)) * (unsigned)DM + colb + c0) * 4u)) = (f32x2){bflo(hv) + w2_[0], bfhi(hv) + w2_[1]}; \
            _Pragma("unroll") for (int c_ = 0; c_ < 16; ++c_) acc[c_] = 0.f; } while (0)
        { u32x4 bufA[8], bufB[8]; unsigned hv; float acc[16];
#pragma unroll
          for (int c = 0; c < 16; ++c) acc[c] = 0.f;
          VP_G(bufA, 0, 0); VP_G(bufB, 0, 1);
          VP_C(bufA, 0, 0); VP_G(bufA, 1, 0);
          VP_C(bufB, 0, 1); VP_H(hv, 0); VP_G(bufB, 1, 1); VP_F(hv, 0);
          VP_C(bufA, 1, 0); VP_G(bufA, 2, 0);
          VP_C(bufB, 1, 1); VP_H(hv, 1); VP_G(bufB, 2, 1); VP_F(hv, 1);
          VP_C(bufA, 2, 0); VP_G(bufA, 3, 0);
          VP_C(bufB, 2, 1); VP_H(hv, 2); VP_G(bufB, 3, 1); VP_F(hv, 2);
          VP_C(bufA, 3, 0);
          VP_C(bufB, 3, 1); VP_H(hv, 3); VP_F(hv, 3); }
#undef VP_G
#undef VP_H
#undef VP_C
#undef VP_F
    }
}
}


#ifndef GATHER_VER
#define GATHER_VER 2
#endif
constexpr int NPHASE = (GATHER_VER == 2) ? 10 : 8;
__global__ void __launch_bounds__(NTHREADS, 2) mega_fwd(Args args) {
    extern __shared__ __attribute__((aligned(16))) unsigned char lds_raw[];
    LAS unsigned char* lds = (LAS unsigned char*)lds_raw;
    const int G = gridDim.x;
    unsigned char* ws = args.ws;
    const int lo = args.ph_lo, hi = args.ph_hi;
#ifndef PHASE_MASK
#define PHASE_MASK 0x3FF
#endif
#ifndef REPEAT_MASK
#define REPEAT_MASK 0x00
#endif
#define NREP(k) (((REPEAT_MASK >> (k)) & 1) ? 2 : 1)
#define IN(k) (lo <= (k) && (k) < hi && ((PHASE_MASK >> (k)) & 1))
#ifndef CG_SEAMS
#define CG_SEAMS 0
#endif
    volatile LAS unsigned* xst = (volatile LAS unsigned*)(lds + LDS_BYTES - 64);
    if (threadIdx.x < 2) xst[threadIdx.x] = 0u;
    __syncthreads();
    XcdBarrier xbar = xcd_barrier_post((unsigned*)(ws + WS_CTL) + 64, xst);
#define SEAM_IN(k) do { if (IN(k)) { if (CG_SEAMS) cg::this_grid().sync(); else xcd_barrier(xbar); } } while (0)
#define SEAM(k) do { if (IN(k) && IN((k) + 1)) { if (CG_SEAMS) cg::this_grid().sync(); else xcd_barrier(xbar); } } while (0)
    if (IN(0)) for (int rep_ = 0; rep_ < NREP(0); ++rep_) { p0_prologue<0>(args, lds, G, args.probe); }
    SEAM(0);
    if (IN(1)) for (int rep_ = 0; rep_ < NREP(1); ++rep_) {
        p1_meta_finish(args, lds, G);
        __syncthreads();
        pg8::Gemm g{(const bf16_t*)(ws + WS_XN), (const bf16_t*)(ws + WS_WTIN), MTOK, INW, DM / 2, nullptr, nullptr, (const float*)(ws + WS_SXA), (const float*)(ws + WS_SWB)}; pg8::StaticOrder S; S.init(MTOK, INW, G, (int)blockIdx.x);
        Epi1 E{(bf16_t*)(ws + WS_Q), (bf16_t*)(ws + WS_K), (bf16_t*)(ws + WS_V), (bf16_t*)(ws + WS_GA), (bf16_t*)(ws + WS_GB), nullptr, (const float*)(ws + WS_CS), args.in[I_QNG], args.in[I_KNG], (bf16_t*)(ws + WS_UB)};
        pg8::gemm_phase<Epi1, pg8::StaticOrder, true, GEMM_SP2>(lds, g, S, E);
    }
    SEAM(1);
    if (IN(2)) for (int rep_ = 0; rep_ < NREP(2); ++rep_) {
#ifndef REP_SSM
#define REP_SSM 1
#endif
#ifndef REP_ATT
#define REP_ATT 1
#endif
        if (args.probe == 0 && blockIdx.x >= 128) p0_prologue<1>(args, lds, G, 0);
        if (args.probe != 2) for (int q_ = 0; q_ < REP_SSM; ++q_) ssm::ssm_mm_phase(args, lds, G, args.probe);
        __syncthreads();
        if (args.probe == 0 || args.probe == 2) for (int q_ = 0; q_ < REP_ATT; ++q_) att::attn_phase(args, lds, G);
    }
    SEAM(2);
    if (IN(3)) {
        sg::quant_pass<SW>((const bf16_t*)(ws + WS_YS), ws + WS_YS8, (float*)(ws + WS_SYS), G);
        sg::quant_pass<AW>((const bf16_t*)(ws + WS_ATT), ws + WS_AT8, (float*)(ws + WS_SAT), G);
        SEAM_IN(3);
    }
    if (IN(3)) for (int rep_ = 0; rep_ < NREP(3); ++rep_) {
        pg8::Gemm g{(const bf16_t*)(ws + WS_YS8), (const bf16_t*)(ws + WS_WTGLU), MTOK, 2 * DM, SW / 2, (const bf16_t*)(ws + WS_AT8), (const bf16_t*)(ws + WS_WTATT),
                    (const float*)(ws + WS_SYS), (const float*)(ws + WS_SWG), (const float*)(ws + WS_SAT), (const float*)(ws + WS_SWA)};
        pg8::P3Order S; S.base.init(MTOK, DM, G, (int)blockIdx.x);
        EpiP3 E{EpiGlu{(const bf16_t*)(ws + WS_GB), (bf16_t*)(ws + WS_YB)}, EpiMix{(const bf16_t*)(ws + WS_GA), (const bf16_t*)(ws + WS_YB), (bf16_t*)(ws + WS_MIX)}};
        pg8::gemm_phase<EpiP3, pg8::P3Order, true, GEMM_SP2>(lds, g, S, E);
    }
    SEAM(3);
    if (IN(4)) { sg::quant_pass<DM>((const bf16_t*)(ws + WS_MIX), ws + WS_MIX8, (float*)(ws + WS_SMX), G); SEAM_IN(4); }
    if (IN(4)) for (int rep_ = 0; rep_ < NREP(4); ++rep_) {
        pg8::Gemm g{(const bf16_t*)(ws + WS_MIX8), (const bf16_t*)(ws + WS_WTOUT), MTOK, DM, DM / 2, nullptr, nullptr, (const float*)(ws + WS_SMX), (const float*)(ws + WS_SWO)}; pg8::StaticOrder S; S.init(MTOK, DM, G, (int)blockIdx.x);
        EpiOut E{args.in[I_X], (bf16_t*)(ws + WS_XN), (float*)(ws + WS_PARTSS)};
        pg8::gemm_phase<EpiOut, pg8::StaticOrder, true, GEMM_SP2>(lds, g, S, E);
    }
    SEAM(4);
    if (IN(6)) { sg::quant_rows(args, G); }
    SEAM(5);
    if (IN(5)) for (int rep_ = 0; rep_ < NREP(5); ++rep_) {
        pg8::Gemm g{(const bf16_t*)(ws + WS_HQ), (const bf16_t*)(ws + WS_WTQ), MTOK, DM, DM / 2, nullptr, nullptr, (const float*)(ws + WS_HT), (const float*)(ws + WS_SWQ)}; pg8::StaticOrder S; S.init(MTOK, DM, G, (int)blockIdx.x);
        EpiQP E{(bf16_t*)(ws + WS_QP)};
        pg8::gemm_phase<EpiQP, pg8::StaticOrder, true, GEMM_SP2>(lds, g, S, E);
        asm volatile("s_waitcnt vmcnt(0)" ::: "memory");
        __syncthreads();
        tk::peer_topk_phase(args, lds, G);
    }
    SEAM(6);
#if GATHER_VER == 2
    if (IN(7)) { sg::upass_phase(args, lds, G); }
    SEAM(7);
    if (IN(8)) for (int rep_ = 0; rep_ < NREP(8); ++rep_) { sg::combine_phase(args, G); }
    SEAM(8);
    if (IN(9)) { sg::vpass_phase(args, lds, G); }
#endif
#undef IN
#undef SEAM
}

extern "C" void kernel_launch(void* const* d_in, const int* in_sizes, int n_in, void* d_out, int out_size, void* d_ws, size_t ws_size, hipStream_t stream) {
    static int grid = 0;
    if (grid == 0) {
        if (n_in != 28 || out_size != MTOK * DM || ws_size < WS_END) { fprintf(stderr, "kernel_launch: unexpected problem (n_in %d out %d ws %zu, need %zu)\n", n_in, out_size, ws_size, (size_t)WS_END); grid = -1; return; }
        int dev = 0, cus = 0, per_cu = 0;
        (void)hipGetDevice(&dev); (void)hipDeviceGetAttribute(&cus, hipDeviceAttributeMultiprocessorCount, dev);
        if (hipFuncSetAttribute((const void*)mega_fwd, hipFuncAttributeMaxDynamicSharedMemorySize, LDS_BYTES) != hipSuccess) { fprintf(stderr, "kernel_launch: hipFuncSetAttribute failed\n"); grid = -1; return; }
        (void)hipOccupancyMaxActiveBlocksPerMultiprocessor(&per_cu, (const void*)mega_fwd, NTHREADS, LDS_BYTES);
        (void)hipGetLastError();
        if (per_cu < 1) { fprintf(stderr, "kernel_launch: occupancy query says %d blocks/CU\n", per_cu); per_cu = 1; }
        if (cus < 192) { fprintf(stderr, "kernel_launch: needs >= 192 CUs (SSM items on workgroups 0..127, deferred prologue work on the rest)\n"); grid = -1; return; }
        grid = cus;
        fprintf(stderr, "kernel_launch: grid %d (cus %d, per_cu %d), ws %zu MiB\n", grid, cus, per_cu, ws_size >> 20);
    }
    if (grid < 0) return;
    if (hipMemsetAsync((char*)d_ws + WS_CTL, 0, 64 * 1024, stream) != hipSuccess) { fprintf(stderr, "kernel_launch: memset of the control words failed\n"); return; }
    Args a{};
    for (int i = 0; i < 28; ++i) a.in[i] = (const float*)d_in[i];
    a.out = (float*)d_out; a.ws = (unsigned char*)d_ws;
#if MK_SINGLE
    a.ph_lo = 0; a.ph_hi = NPHASE;
    void* kargs[] = {&a};
    hipError_t e = hipLaunchCooperativeKernel((const void*)mega_fwd, dim3(grid), dim3(NTHREADS), kargs, LDS_BYTES, stream);
    if (e != hipSuccess) fprintf(stderr, "cooperative launch failed: %s (grid %d)\n", hipGetErrorString(e), grid);
#else
#ifndef PROBE_PHASE
#define PROBE_PHASE -1
#endif
    for (int p = 0; p < NPHASE; ++p) {
        a.ph_lo = p; a.ph_hi = p + 1;
#ifndef PROBE_SUB
#define PROBE_SUB 0
#endif
        for (int rep = 0; rep < (p == PROBE_PHASE ? 2 : 1); ++rep) { a.probe = (rep == 1) ? PROBE_SUB : 0;
            if (rep == 1) (void)hipMemsetAsync((char*)d_ws + WS_CTL + 32768, 0, 16384, stream);
            hipLaunchKernelGGL(mega_fwd, dim3(grid), dim3(NTHREADS), LDS_BYTES, stream, a); }
    }
#endif
}
```

```cpp
#include <hip/hip_runtime.h>
#include <hip/hip_cooperative_groups.h>
#include <cstdio>
#include <cstdint>
namespace cg = cooperative_groups;

#ifndef GEMM_SP2
#define GEMM_SP2 true
#endif
#ifndef MK_SINGLE
#define MK_SINGLE 1
#endif

#define LAS __attribute__((address_space(3)))
typedef unsigned short bf16_t;
typedef short bf16x8 __attribute__((ext_vector_type(8)));
typedef float f32x4 __attribute__((ext_vector_type(4)));
typedef float f32x2 __attribute__((ext_vector_type(2)));
typedef unsigned u32x4 __attribute__((ext_vector_type(4)));
typedef int i32x4 __attribute__((ext_vector_type(4)));
typedef unsigned u32x2 __attribute__((ext_vector_type(2)));
typedef __bf16 bf16x2_t __attribute__((ext_vector_type(2)));

constexpr int DM = 2048, SEQ = 4096, NMETA = 16, MTOK = 2 * SEQ, NPOS = SEQ + NMETA;
constexpr int AW = 1024, SW = 1024, INW = 8192;
constexpr float EPS = 1e-6f;
constexpr float LOG2E = 1.4426950408889634f;
constexpr float QSCALE = 0.125f * LOG2E;
constexpr float LAM_INIT = 0.2f;
constexpr int NEXP = 16384;

constexpr size_t MiB = 1u << 20;
constexpr size_t WS_CTL = 0;
constexpr size_t WS_WTIN = 1 * MiB;
constexpr size_t WS_WTATT = WS_WTIN + 32 * MiB;
constexpr size_t WS_WTGLU = WS_WTATT + 4 * MiB;
constexpr size_t WS_WTOUT = WS_WTGLU + 8 * MiB;
constexpr size_t WS_WTQ = WS_WTOUT + 8 * MiB;
constexpr size_t WS_UE = WS_WTQ + 8 * MiB;
constexpr size_t WS_VE = WS_UE + 64 * MiB;
constexpr size_t WS_XN = WS_VE + 64 * MiB;
constexpr size_t WS_Q = WS_XN + 32 * MiB;
constexpr size_t WS_K = WS_Q + 16 * MiB;
constexpr size_t WS_V = WS_K + 16 * MiB;
constexpr size_t WS_MIX = WS_Q;
constexpr size_t WS_U = WS_V + 16 * MiB;
constexpr size_t WS_QP = WS_U;
constexpr size_t WS_GA = WS_U + 32 * MiB;
constexpr size_t WS_GB = WS_GA + 32 * MiB;
constexpr size_t WS_ATT = WS_GB + 32 * MiB;
constexpr size_t WS_YS = WS_ATT + 16 * MiB;
constexpr size_t WS_YB = WS_YS + 16 * MiB;
constexpr size_t WS_IDX = WS_YB + 32 * MiB;
constexpr size_t WS_GW = WS_IDX + 4 * MiB;
constexpr size_t WS_MISC = WS_GW + 4 * MiB;
constexpr size_t WS_PARTSS = WS_MISC;
constexpr size_t WS_CS = WS_PARTSS + 1 * MiB;
constexpr size_t WS_MPART = WS_CS + 2 * MiB;
constexpr size_t WS_KM = WS_MPART + 2 * MiB;
constexpr size_t WS_VM = WS_KM + 128 * 1024;
constexpr size_t WS_UM = WS_VM + 128 * 1024;
constexpr size_t WS_ABAR = WS_UM + 64 * 1024;
constexpr size_t WS_BBAR = WS_ABAR + 32 * 1024;
constexpr size_t WS_PAR = WS_BBAR + 512 * 1024;
constexpr size_t WS_SU = WS_PAR + 64 * 1024;
constexpr size_t WS_SV = WS_SU + 64 * 1024;
constexpr size_t WS_K12 = WS_SV + 64 * 1024;
constexpr size_t WS_UMB = WS_K12 + 512 * 1024;
constexpr size_t WS_UB = WS_UMB + 64 * 1024;
constexpr size_t WS_HT = WS_UB + 16 * MiB;
constexpr size_t WS_MP32 = WS_HT + 64 * 1024;
constexpr size_t WS_SXA = WS_MP32 + 6 * MiB;
constexpr size_t WS_SWB = WS_SXA + 64 * 1024;
constexpr size_t WS_SWQ = WS_SWB + 64 * 1024;
constexpr size_t WS_SWG = WS_SWQ + 64 * 1024;
constexpr size_t WS_SWA = WS_SWG + 64 * 1024;
constexpr size_t WS_SWO = WS_SWA + 64 * 1024;
constexpr size_t WS_SYS = WS_SWO + 64 * 1024;
constexpr size_t WS_SAT = WS_SYS + 64 * 1024;
constexpr size_t WS_SMX = WS_SAT + 64 * 1024;
constexpr size_t WS_END = WS_SMX + 64 * 1024;
constexpr size_t WS_YS8 = WS_V;
constexpr size_t WS_AT8 = WS_V + 8 * MiB;
constexpr size_t WS_MIX8 = WS_V;
constexpr size_t WS_HQ = WS_ATT;
constexpr size_t WS_APART = WS_Q;
constexpr size_t WS_H2 = WS_GA;

__device__ __forceinline__ unsigned f2bf(float f) { unsigned u = __builtin_bit_cast(unsigned, f); return (u + 0x7fffu + ((u >> 16) & 1u)) >> 16; }
__device__ __forceinline__ unsigned pk2(float lo, float hi) { return f2bf(lo) | (f2bf(hi) << 16); }
__device__ __forceinline__ float bf2f(unsigned short h) { return __builtin_bit_cast(float, (unsigned)h << 16); }
__device__ __forceinline__ float bflo(unsigned w) { return __builtin_bit_cast(float, w << 16); }
__device__ __forceinline__ float bfhi(unsigned w) { return __builtin_bit_cast(float, w & 0xffff0000u); }
__device__ __forceinline__ int otid() { int t = threadIdx.x; asm volatile("" : "+v"(t)); return t; }
template <int CTRL> __device__ __forceinline__ float dpp_f(float v) { return __builtin_bit_cast(float, __builtin_amdgcn_update_dpp(0, __builtin_bit_cast(int, v), CTRL, 0xF, 0xF, true)); }
__device__ __forceinline__ float row_sum16(float v) { v += dpp_f<0x128>(v); v += dpp_f<0x124>(v); v += dpp_f<0x122>(v); v += dpp_f<0x121>(v); return v; }
__device__ __forceinline__ float wave_sum(float v) { v = row_sum16(v); v += __shfl_xor(v, 16); v += __shfl_xor(v, 32); return v; }
__device__ __forceinline__ float wave_max(float v) {
#pragma unroll
    for (int o = 1; o < 64; o <<= 1) v = fmaxf(v, __shfl_xor(v, o));
    return v;
}
__device__ __forceinline__ float sigmoidf_(float x) { return __builtin_amdgcn_rcpf(1.0f + __builtin_amdgcn_exp2f(x * -1.4426950408889634f)); }
__device__ __forceinline__ float gelu_exact(float x) { return 0.5f * x * (1.0f + erff(x * 0.70710678118654752f)); }
__device__ __forceinline__ float dot2bf(unsigned a, unsigned b, float acc) { return __builtin_amdgcn_fdot2_f32_bf16(__builtin_bit_cast(bf16x2_t, a), __builtin_bit_cast(bf16x2_t, b), acc, false); }

namespace pg8 {
#define PG8_LAS __attribute__((address_space(3)))
constexpr int BM = 256, BK = 64, HALF = 128, HTB = HALF * BK * 2, STAGE_BYTES = 8 * HTB, NXCD = 8, WGM = 8;
__host__ __device__ __forceinline__ int lds_byte(int r, int c) { const int st = (r >> 4) * 2 + (c >> 5), rr = r & 15, cc = c & 31, ob = rr * 64 + cc * 2; return st * 1024 + (ob ^ (((ob >> 9) & 1) << 5)); }
__host__ __device__ __forceinline__ void stage_rc(int b, int& R, int& C) { const int st = b / 1024, sb = b % 1024, swz = sb ^ (((sb >> 9) & 1) << 5); R = (st >> 1) * 16 + swz / 64; C = (st & 1) * 32 + (swz % 64) / 2; }
__host__ __device__ __forceinline__ int perm32(int rho) { const int n = rho >> 4, i = rho & 15; return 8 * (i >> 2) + 4 * n + (i & 3); }
struct Unit { int pm, pn, sel; };
struct Gemm { const bf16_t* A; const bf16_t* Bt; int M, N, K; const bf16_t* A2 = nullptr; const bf16_t* Bt2 = nullptr; const float* sa = nullptr; const float* sb = nullptr; const float* sa2 = nullptr; const float* sb2 = nullptr; };
struct StaticOrder {
    int nM, nN, nwg, G, c;
    __host__ __device__ __forceinline__ void init(int M, int N, int G_, int c_) { nM = M / BM; nN = N / BM; nwg = nM * nN; G = G_; c = c_; }
    __host__ __device__ __forceinline__ bool next(int i, Unit& u) const {
        const long L = (long)i * G + c; if (L >= nwg) return false;
        int wgid = (int)L; { const int q = nwg / NXCD, r = nwg % NXCD, xcd = wgid % NXCD, off = wgid / NXCD; wgid = (xcd < r ? xcd * (q + 1) : r * (q + 1) + (xcd - r) * q) + off; }
        const int nig = WGM * nN, gid = wgid / nig, fm = gid * WGM, gsz = (nM - fm) < WGM ? (nM - fm) : WGM;
        u.pm = fm + ((wgid % nig) % gsz); u.pn = (wgid % nig) / gsz; u.sel = 0; return true;
    }
    __device__ __forceinline__ void a_ready(const Unit&) const {}
    __device__ __forceinline__ void done(const Unit&) const {}
};
struct GluOrder {
    StaticOrder base;
    __device__ __forceinline__ bool next(int i, Unit& u) const { Unit b; if (!base.next(i >> 1, b)) return false; u.pm = b.pm; u.pn = 2 * b.pn + (i & 1); u.sel = 0; return true; }
    __device__ __forceinline__ void a_ready(const Unit&) const {}
    __device__ __forceinline__ void done(const Unit&) const {}
};

struct P3Order {
    StaticOrder base;
    __device__ __forceinline__ bool next(int i, Unit& u) const { Unit b; const int r = i / 3, j = i - 3 * r; if (!base.next(r, b)) return false;
        u.pm = b.pm; u.pn = (j < 2) ? 2 * b.pn + j : b.pn; u.sel = (j == 2) ? 1 : 0; return true; }
    __device__ __forceinline__ void a_ready(const Unit&) const {}
    __device__ __forceinline__ void done(const Unit&) const {}
};
template <class Epi, class Sched, bool ALIGN_EPI = false, bool SP2 = false>
__device__ __forceinline__ void gemm_phase(PG8_LAS unsigned char* lds, const Gemm g, const Sched& S, const Epi& E) {
    const int tid = threadIdx.x, wid = __builtin_amdgcn_readfirstlane(tid >> 6), lane = tid & 63, wr = wid >> 2, wc = wid & 3, fr = lane & 15, fq = lane >> 4;
    const int K = g.K, nt = K / BK;
    unsigned voffA[2], voffB[2];
#pragma unroll
    for (int i = 0; i < 2; ++i) { int R, C; stage_rc(tid * 16 + i * 8192, R, C); const int Rb = Epi::PERM ? ((R & ~31) + perm32(R & 31)) : R;
        voffA[i] = (unsigned)(R * K + C) * 2u; voffB[i] = (unsigned)(Rb * K + C) * 2u; }
    const size_t kstep = (size_t)(BK * 2);
    const size_t hstep = (size_t)HALF * K * 2;
    const size_t tstep = 2 * hstep;
    const unsigned ldsw = (unsigned)wid * 1024u;
    const int aoff = lds_byte(wr * 64 + fr, fq * 8), boff = lds_byte(wc * 32 + fr, fq * 8);
#define PG8_SA(b, h) (((b) * 2 + (h)) * HTB)
#define PG8_SB(b, h) ((4 + (b) * 2 + (h)) * HTB)
#define PG8_STAGE(bufoff, gbase, voff) do { _Pragma("unroll") for (int _i = 0; _i < 2; ++_i) \
        __builtin_amdgcn_global_load_lds((const unsigned*)((const char*)(gbase) + (voff)[_i]), (PG8_LAS unsigned*)(lds + (bufoff) + ldsw + _i * 8192), 16, 0, 0); } while (0)
#define PG8_LDA(dst, b, h) do { _Pragma("unroll") for (int m = 0; m < 4; ++m) _Pragma("unroll") for (int k = 0; k < 2; ++k) dst[m][k] = *(const PG8_LAS bf16x8*)(lds + PG8_SA(b, h) + aoff + m * 2048 + k * 1024); } while (0)
#define PG8_LDB(dst, b, h) do { _Pragma("unroll") for (int n = 0; n < 2; ++n) _Pragma("unroll") for (int k = 0; k < 2; ++k) dst[n][k] = *(const PG8_LAS bf16x8*)(lds + PG8_SB(b, h) + boff + n * 2048 + k * 1024); } while (0)
#define PG8_MMA(ai, bj, At, Bt) do { __builtin_amdgcn_s_setprio(1); _Pragma("unroll") for (int m = 0; m < 4; ++m) _Pragma("unroll") for (int n = 0; n < 2; ++n) _Pragma("unroll") for (int k = 0; k < 2; ++k) \
        { if constexpr (Epi::I8) acc[ai][bj][m][n] = __builtin_bit_cast(f32x4, __builtin_amdgcn_mfma_i32_16x16x64_i8(__builtin_bit_cast(i32x4, Bt[n][k]), __builtin_bit_cast(i32x4, At[m][k]), __builtin_bit_cast(i32x4, acc[ai][bj][m][n]), 0, 0, 0)); \
          else acc[ai][bj][m][n] = __builtin_amdgcn_mfma_f32_16x16x32_bf16(Bt[n][k], At[m][k], acc[ai][bj][m][n], 0, 0, 0); } __builtin_amdgcn_s_setprio(0); } while (0)
#define PG8_WAIT_V(n) asm volatile("s_waitcnt vmcnt(" #n ")" ::: "memory")
#define PG8_WAIT_L(n) asm volatile("s_waitcnt lgkmcnt(" #n ")" ::: "memory")
#define PG8_BAR __builtin_amdgcn_s_barrier()
#define PG8_SCHED __builtin_amdgcn_sched_barrier(0)
    Unit cur, nxt; int ui = 0;
    if (!S.next(0, cur)) return;
    f32x4 acc[2][2][4][2];
#pragma unroll
    for (int a = 0; a < 2; ++a)
#pragma unroll
        for (int b = 0; b < 2; ++b)
#pragma unroll
            for (int m = 0; m < 4; ++m)
#pragma unroll
                for (int n = 0; n < 2; ++n) acc[a][b][m][n] = (f32x4){0.f, 0.f, 0.f, 0.f};
    bf16x8 At[4][2], B0[2][2], B1[2][2];
    const char* cA = (const char*)(cur.sel ? g.A2 : g.A) + (size_t)cur.pm * tstep; const char* cB = (const char*)(cur.sel ? g.Bt2 : g.Bt) + (size_t)cur.pn * tstep;
    S.a_ready(cur);
    if constexpr (SP2) {
        PG8_STAGE(PG8_SB(0, 0), cB, voffB); PG8_STAGE(PG8_SB(0, 1), cB + hstep, voffB); PG8_STAGE(PG8_SA(0, 0), cA, voffA); PG8_STAGE(PG8_SA(0, 1), cA + hstep, voffA);
        if (wr == 1) PG8_BAR;
        PG8_WAIT_V(2); PG8_BAR;
        PG8_STAGE(PG8_SB(1, 0), cB + kstep, voffB); PG8_STAGE(PG8_SA(1, 0), cA + kstep, voffA); PG8_STAGE(PG8_SB(1, 1), cB + hstep + kstep, voffB);
        PG8_WAIT_V(6); PG8_BAR;
    } else {
        PG8_STAGE(PG8_SB(0, 0), cB, voffB); PG8_STAGE(PG8_SA(0, 0), cA, voffA); PG8_STAGE(PG8_SB(0, 1), cB + hstep, voffB); PG8_STAGE(PG8_SA(0, 1), cA + hstep, voffA);
        if (wr == 1) PG8_BAR;
        PG8_WAIT_V(4); PG8_BAR;
        PG8_STAGE(PG8_SB(1, 0), cB + kstep, voffB); PG8_STAGE(PG8_SA(1, 0), cA + kstep, voffA); PG8_STAGE(PG8_SB(1, 1), cB + hstep + kstep, voffB);
        PG8_WAIT_V(6); PG8_BAR;
    }
    for (;;) {
        const bool has_next = S.next(ui + 1, nxt);
        const char* nA = has_next ? (const char*)(nxt.sel ? g.A2 : g.A) + (size_t)nxt.pm * tstep : cA; const char* nB = has_next ? (const char*)(nxt.sel ? g.Bt2 : g.Bt) + (size_t)nxt.pn * tstep : cB;
        for (int t = 0; t < nt; t += 2) {
            const bool last = (t == nt - 2);
            const char* a1 = cA + (size_t)(t + 1) * kstep;
            const char* a2 = last ? nA : cA + (size_t)(t + 2) * kstep; const char* b2 = last ? nB : cB + (size_t)(t + 2) * kstep;
            const char* a3 = a2 + kstep; const char* b3 = b2 + kstep;
            if (last && has_next) S.a_ready(nxt);
            if constexpr (SP2) {
            PG8_LDB(B0, 0, 0); PG8_LDB(B1, 0, 1); PG8_SCHED; PG8_LDA(At, 0, 0); PG8_STAGE(PG8_SA(1, 1), a1 + hstep, voffA);
            PG8_WAIT_V(8); PG8_WAIT_L(0); PG8_BAR; PG8_MMA(0, 0, At, B0); PG8_MMA(0, 1, At, B1); PG8_BAR; PG8_SCHED;
            PG8_LDA(At, 0, 1); PG8_STAGE(PG8_SB(0, 0), b2, voffB); PG8_STAGE(PG8_SB(0, 1), b2 + hstep, voffB); PG8_STAGE(PG8_SA(0, 0), a2, voffA);
            PG8_WAIT_V(8); PG8_WAIT_L(0); PG8_BAR; PG8_MMA(1, 0, At, B0); PG8_MMA(1, 1, At, B1); PG8_BAR; PG8_SCHED;
            PG8_LDB(B0, 1, 0); PG8_LDB(B1, 1, 1); PG8_SCHED; PG8_LDA(At, 1, 0); PG8_STAGE(PG8_SA(0, 1), a2 + hstep, voffA);
            PG8_WAIT_V(8); PG8_WAIT_L(0); PG8_BAR; PG8_MMA(0, 0, At, B0); PG8_MMA(0, 1, At, B1); PG8_BAR; PG8_SCHED;
            PG8_LDA(At, 1, 1); PG8_STAGE(PG8_SB(1, 0), b3, voffB); PG8_STAGE(PG8_SB(1, 1), b3 + hstep, voffB); PG8_STAGE(PG8_SA(1, 0), a3, voffA);
            PG8_WAIT_V(8); PG8_WAIT_L(0); PG8_BAR; PG8_MMA(1, 0, At, B0); PG8_MMA(1, 1, At, B1); PG8_BAR; PG8_SCHED;
            } else {
            PG8_LDB(B0, 0, 0); PG8_SCHED; PG8_LDA(At, 0, 0); PG8_STAGE(PG8_SA(1, 1), a1 + hstep, voffA);
            PG8_WAIT_L(8); PG8_BAR; PG8_WAIT_L(0); PG8_MMA(0, 0, At, B0); PG8_BAR; PG8_SCHED;
            PG8_LDB(B1, 0, 1); PG8_STAGE(PG8_SB(0, 0), b2, voffB);
            PG8_BAR; PG8_WAIT_L(0); PG8_MMA(0, 1, At, B1); PG8_BAR;
            PG8_LDA(At, 0, 1); PG8_STAGE(PG8_SA(0, 0), a2, voffA);
            PG8_BAR; PG8_WAIT_L(0); PG8_MMA(1, 0, At, B0); PG8_BAR; PG8_SCHED;
            PG8_STAGE(PG8_SB(0, 1), b2 + hstep, voffB);
            PG8_WAIT_V(6); PG8_BAR; PG8_MMA(1, 1, At, B1); PG8_BAR;
            PG8_LDB(B0, 1, 0); PG8_SCHED; PG8_LDA(At, 1, 0); PG8_STAGE(PG8_SA(0, 1), a2 + hstep, voffA);
            PG8_WAIT_L(8); PG8_BAR; PG8_WAIT_L(0); PG8_MMA(0, 0, At, B0); PG8_BAR; PG8_SCHED;
            PG8_LDB(B1, 1, 1); PG8_STAGE(PG8_SB(1, 0), b3, voffB);
            PG8_BAR; PG8_WAIT_L(0); PG8_MMA(0, 1, At, B1); PG8_BAR;
            PG8_LDA(At, 1, 1); PG8_STAGE(PG8_SA(1, 0), a3, voffA);
            PG8_BAR; PG8_WAIT_L(0); PG8_MMA(1, 0, At, B0); PG8_BAR; PG8_SCHED;
            PG8_STAGE(PG8_SB(1, 1), b3 + hstep, voffB);
            PG8_WAIT_V(6); PG8_BAR; PG8_MMA(1, 1, At, B1); PG8_BAR;
            }
        }
        if constexpr (ALIGN_EPI) { if (wr == 0) PG8_BAR; }
        if constexpr (Epi::I8) {
            int ln_ = (int)__builtin_amdgcn_mbcnt_hi(~0u, __builtin_amdgcn_mbcnt_lo(~0u, 0u)); asm volatile("" : "+v"(ln_));
            const int fr_ = ln_ & 15, fq_ = ln_ >> 4;
            float sxr[2][4];
#pragma unroll
            for (int ai = 0; ai < 2; ++ai)
#pragma unroll
                for (int m = 0; m < 4; ++m) sxr[ai][m] = (cur.sel ? g.sa2 : g.sa)[cur.pm * 256 + ai * 128 + wr * 64 + m * 16 + fr_];
#pragma unroll
            for (int bj = 0; bj < 2; ++bj)
#pragma unroll
                for (int n = 0; n < 2; ++n) { const f32x4 swv = *(const f32x4*)((cur.sel ? g.sb2 : g.sb) + cur.pn * 256 + bj * 128 + wc * 32 + 8 * fq_ + 4 * n);
#pragma unroll
                    for (int ai = 0; ai < 2; ++ai)
#pragma unroll
                        for (int m = 0; m < 4; ++m) { const i32x4 iv = __builtin_bit_cast(i32x4, acc[ai][bj][m][n]);
                            acc[ai][bj][m][n] = (f32x4){(float)iv[0], (float)iv[1], (float)iv[2], (float)iv[3]} * sxr[ai][m] * swv; } }
            if constexpr (Epi::OPQ) E(acc, cur, wr, wc, fr_, fq_);
            else E(acc, cur, wr, wc, fr, fq);
        } else
        E(acc, cur, wr, wc, fr, fq);
        S.done(cur);
        if (!has_next) break;
#pragma unroll
        for (int a = 0; a < 2; ++a)
#pragma unroll
            for (int b = 0; b < 2; ++b)
#pragma unroll
                for (int m = 0; m < 4; ++m)
#pragma unroll
                    for (int n = 0; n < 2; ++n) acc[a][b][m][n] = (f32x4){0.f, 0.f, 0.f, 0.f};
        cur = nxt; cA = nA; cB = nB; ++ui;
        if constexpr (ALIGN_EPI) { if (wr == 1) PG8_BAR; }
    }
    PG8_WAIT_V(0);
    if constexpr (!ALIGN_EPI) { if (wr == 0) PG8_BAR; }
    PG8_BAR;
#undef PG8_SA
#undef PG8_SB
#undef PG8_STAGE
#undef PG8_LDA
#undef PG8_LDB
#undef PG8_MMA
#undef PG8_WAIT_V
#undef PG8_WAIT_L
#undef PG8_BAR
#undef PG8_SCHED
}
}
using pg8::Unit;

__device__ __forceinline__ u32x4 pack8(const f32x4 a, const f32x4 b) { u32x4 w; w.x = pk2(a[0], a[1]); w.y = pk2(a[2], a[3]); w.z = pk2(b[0], b[1]); w.w = pk2(b[2], b[3]); return w; }

__device__ __forceinline__ unsigned pk_u8x4(const f32x4 v) { unsigned w = 0; w = __builtin_amdgcn_cvt_pk_u8_f32(v[0] * 255.0f, 0, w); w = __builtin_amdgcn_cvt_pk_u8_f32(v[1] * 255.0f, 1, w); w = __builtin_amdgcn_cvt_pk_u8_f32(v[2] * 255.0f, 2, w); w = __builtin_amdgcn_cvt_pk_u8_f32(v[3] * 255.0f, 3, w); return w; }
__device__ __forceinline__ f32x4 un_u8x4(unsigned w) { return (f32x4){(float)(w & 255u), (float)((w >> 8) & 255u), (float)((w >> 16) & 255u), (float)(w >> 24)} * (1.0f / 255.0f); }
struct Epi1 {
    static constexpr bool PERM = true; static constexpr bool I8 = true; static constexpr bool OPQ = true;
    bf16_t *Q, *K, *V, *GA, *GB; float* U; const float* cs; const float *gq, *gk; bf16_t* UB;
    __device__ __forceinline__ void operator()(const f32x4 (&acc)[2][2][4][2], const Unit& u, int wr, int wc, int fr, int fq) const {
        const int type = u.pn >> 2;
        const int row0 = u.pm * 256 + wr * 64 + fr;
        if (type <= 1) {
            const int sh = (u.pn & 3) * 4 + wc;
            bf16_t* dst = type == 0 ? Q : K; const float* g = type == 0 ? gq : gk; const float osc = type == 0 ? QSCALE : 1.0f;
            f32x4 gv[2][2];
#pragma unroll
            for (int bj = 0; bj < 2; ++bj)
#pragma unroll
                for (int n = 0; n < 2; ++n) gv[bj][n] = *(const f32x4*)(g + 32 * bj + 8 * fq + 4 * n);
#pragma unroll
            for (int ai = 0; ai < 2; ++ai) {
                f32x4 cv[4][2], sv[4][2];
#pragma unroll
                for (int m = 0; m < 4; ++m) { const int pos = NMETA + ((row0 + ai * 128 + m * 16) & (SEQ - 1)); const float* csr = cs + (size_t)pos * 64 + 8 * fq;
                    cv[m][0] = *(const f32x4*)(csr); cv[m][1] = *(const f32x4*)(csr + 4); sv[m][0] = *(const f32x4*)(csr + 32); sv[m][1] = *(const f32x4*)(csr + 36); }
                asm volatile("" ::: "memory");
#pragma unroll
                for (int m = 0; m < 4; ++m) {
                    const int r = row0 + ai * 128 + m * 16;
                    float ss = 0.f;
#pragma unroll
                    for (int bj = 0; bj < 2; ++bj)
#pragma unroll
                        for (int n = 0; n < 2; ++n) { const f32x4 x = acc[ai][bj][m][n]; ss += (x[0] * x[0] + x[1] * x[1]) + (x[2] * x[2] + x[3] * x[3]); }
                    ss += __shfl_xor(ss, 16); ss += __shfl_xor(ss, 32);
                    const float rs = rsqrtf(ss * (1.0f / 64.0f) + EPS);
                    f32x4 olo[2], ohi[2];
#pragma unroll
                    for (int n = 0; n < 2; ++n) { const f32x4 lo = acc[ai][0][m][n] * rs * gv[0][n], hi = acc[ai][1][m][n] * rs * gv[1][n];
                        olo[n] = (lo * cv[m][n] - hi * sv[m][n]) * osc; ohi[n] = (hi * cv[m][n] + lo * sv[m][n]) * osc; }
                    bf16_t* p = dst + (size_t)r * AW + sh * 64 + 8 * fq;
                    *(u32x4*)(p) = pack8(olo[0], olo[1]); *(u32x4*)(p + 32) = pack8(ohi[0], ohi[1]);
                }
            }
        } else {
            const int colt = (u.pn & 3) * 256 + wc * 32 + 8 * fq;
#pragma unroll
            for (int ai = 0; ai < 2; ++ai)
#pragma unroll
                for (int m = 0; m < 4; ++m) {
                    const int r = row0 + ai * 128 + m * 16;
#pragma unroll
                    for (int bj = 0; bj < 2; ++bj) {
                        const f32x4 v0 = acc[ai][bj][m][0], v1 = acc[ai][bj][m][1];
                        if (type == 2) *(u32x4*)(V + (size_t)r * AW + colt + bj * 128) = pack8(v0, v1);
                        else if (type == 3) { if (U) { float* p = U + (size_t)r * SW + colt + bj * 128; *(f32x4*)p = v0; *(f32x4*)(p + 4) = v1; } *(u32x4*)(UB + (size_t)r * SW + colt + bj * 128) = pack8(v0, v1); }
                        else {
                            unsigned char* G = (unsigned char*)((type < 6) ? GA : GB); const int col = ((u.pn - (type < 6 ? 16 : 24)) * 256) + wc * 32 + 8 * fq + bj * 128;
                            f32x4 s0, s1;
#pragma unroll
                            for (int i = 0; i < 4; ++i) { s0[i] = sigmoidf_(v0[i]); s1[i] = sigmoidf_(v1[i]); }
                            *(u32x2*)(G + (size_t)r * DM + col) = (u32x2){pk_u8x4(s0), pk_u8x4(s1)};
                        }
                    }
                }
        }
    }
};
struct EpiGlu {
    static constexpr bool PERM = true; static constexpr bool I8 = false; static constexpr bool OPQ = false;
    const bf16_t* GB; bf16_t* YB;
    __device__ __forceinline__ void operator()(const f32x4 (&acc)[2][2][4][2], const Unit& u, int wr, int wc, int fr, int fq) const {
        const int row0 = u.pm * 256 + wr * 64 + fr, col = u.pn * 128 + wc * 32 + 8 * fq;
        u32x2 gbv[2][4];
#pragma unroll
        for (int ai = 0; ai < 2; ++ai)
#pragma unroll
            for (int m = 0; m < 4; ++m) gbv[ai][m] = __builtin_nontemporal_load((const u32x2*)((const unsigned char*)GB + (size_t)(row0 + ai * 128 + m * 16) * DM + col));
        asm volatile("" ::: "memory");
#pragma unroll
        for (int ai = 0; ai < 2; ++ai)
#pragma unroll
            for (int m = 0; m < 4; ++m) {
                const size_t off = (size_t)(row0 + ai * 128 + m * 16) * DM + col;
                const u32x2 gb = gbv[ai][m];
                f32x4 o0, o1;
#pragma unroll
                for (int i = 0; i < 4; ++i) { o0[i] = acc[ai][0][m][0][i] * sigmoidf_(acc[ai][1][m][0][i]); o1[i] = acc[ai][0][m][1][i] * sigmoidf_(acc[ai][1][m][1][i]); }
                o0 = o0 * un_u8x4(gb.x); o1 = o1 * un_u8x4(gb.y);
                *(u32x4*)(YB + off) = pack8(o0, o1);
            }
    }
};
struct EpiMix {
    static constexpr bool PERM = true; static constexpr bool I8 = false; static constexpr bool OPQ = false;
    const bf16_t *GA, *YB; bf16_t* MIX;
    __device__ __forceinline__ void operator()(const f32x4 (&acc)[2][2][4][2], const Unit& u, int wr, int wc, int fr, int fq) const {
        const int row0 = u.pm * 256 + wr * 64 + fr, col0 = u.pn * 256 + wc * 32 + 8 * fq;
#pragma unroll
        for (int ai = 0; ai < 2; ++ai)
#pragma unroll
        for (int mh = 0; mh < 2; ++mh) {
            u32x2 gav[2][2]; u32x4 ybv[2][2];
#pragma unroll
            for (int m = 0; m < 2; ++m)
#pragma unroll
                for (int bj = 0; bj < 2; ++bj) { const size_t off = (size_t)(row0 + ai * 128 + (2 * mh + m) * 16) * DM + col0 + bj * 128; gav[m][bj] = __builtin_nontemporal_load((const u32x2*)((const unsigned char*)GA + off)); ybv[m][bj] = *(const u32x4*)(YB + off); }
            asm volatile("" ::: "memory");
#pragma unroll
            for (int m = 0; m < 2; ++m)
#pragma unroll
                for (int bj = 0; bj < 2; ++bj) {
                    const size_t off = (size_t)(row0 + ai * 128 + (2 * mh + m) * 16) * DM + col0 + bj * 128;
                    const u32x2 ga = gav[m][bj]; const u32x4 yb = ybv[m][bj];
                    const f32x4 g0 = un_u8x4(ga.x), g1 = un_u8x4(ga.y);
                    f32x4 o0 = acc[ai][bj][2 * mh + m][0], o1 = acc[ai][bj][2 * mh + m][1];
                    o0[0] = o0[0] * g0[0] + bflo(yb.x); o0[1] = o0[1] * g0[1] + bfhi(yb.x); o0[2] = o0[2] * g0[2] + bflo(yb.y); o0[3] = o0[3] * g0[3] + bfhi(yb.y);
                    o1[0] = o1[0] * g1[0] + bflo(yb.z); o1[1] = o1[1] * g1[1] + bfhi(yb.z); o1[2] = o1[2] * g1[2] + bflo(yb.w); o1[3] = o1[3] * g1[3] + bfhi(yb.w);
                    *(u32x4*)(MIX + off) = pack8(o0, o1);
                }
        }
    }
};
struct EpiP3 {
    static constexpr bool PERM = true; static constexpr bool I8 = true; static constexpr bool OPQ = false;
    EpiGlu g; EpiMix m;
    __device__ __forceinline__ void operator()(const f32x4 (&acc)[2][2][4][2], const Unit& u, int wr, int wc, int fr, int fq) const { if (u.sel) m(acc, u, wr, wc, fr, fq); else g(acc, u, wr, wc, fr, fq); }
};
struct EpiOut {
    static constexpr bool PERM = true; static constexpr bool I8 = true; static constexpr bool OPQ = false;
    const float* X; bf16_t* H2B; float* PARTSS;
    __device__ __forceinline__ void operator()(const f32x4 (&acc)[2][2][4][2], const Unit& u, int wr, int wc, int fr, int fq) const {
        const int row0 = u.pm * 256 + wr * 64 + fr, col0 = u.pn * 256 + wc * 32 + 8 * fq;
#pragma unroll
        for (int ai = 0; ai < 2; ++ai)
#pragma unroll
        for (int mh = 0; mh < 2; ++mh) {
            f32x4 xv[2][2][2];
#pragma unroll
            for (int m = 0; m < 2; ++m)
#pragma unroll
                for (int bj = 0; bj < 2; ++bj)
#pragma unroll
                    for (int n = 0; n < 2; ++n) xv[m][bj][n] = __builtin_nontemporal_load((const f32x4*)(X + (size_t)(row0 + ai * 128 + (2 * mh + m) * 16) * DM + col0 + bj * 128 + n * 4));
            asm volatile("" ::: "memory");
#pragma unroll
            for (int m = 0; m < 2; ++m) {
                const int r = row0 + ai * 128 + (2 * mh + m) * 16; float ss = 0.f;
#pragma unroll
                for (int bj = 0; bj < 2; ++bj) {
                    const f32x4 h0 = xv[m][bj][0] + acc[ai][bj][2 * mh + m][0], h1 = xv[m][bj][1] + acc[ai][bj][2 * mh + m][1];
                    ss += ((h0[0] * h0[0] + h0[1] * h0[1]) + (h0[2] * h0[2] + h0[3] * h0[3])) + ((h1[0] * h1[0] + h1[1] * h1[1]) + (h1[2] * h1[2] + h1[3] * h1[3]));
                    *(u32x4*)(H2B + (size_t)r * DM + col0 + bj * 128) = pack8(h0, h1);
                }
                ss += __shfl_xor(ss, 16); ss += __shfl_xor(ss, 32);
                if (fq == 0) PARTSS[(size_t)(u.pn * 4 + wc) * MTOK + r] = ss;
            }
        }
    }
};
constexpr int QPT_PITCH = 528;
struct EpiQP {
    static constexpr bool PERM = true; static constexpr bool I8 = true; static constexpr bool OPQ = false;
    bf16_t* QP; LAS unsigned char* tile; bool in_lds;
    __device__ __forceinline__ void operator()(const f32x4 (&acc)[2][2][4][2], const Unit& u, int wr, int wc, int fr, int fq) const {
        const int rl0 = wr * 64 + fr, col0 = wc * 32 + 8 * fq;
        if (in_lds) { asm volatile("s_waitcnt vmcnt(0)" ::: "memory"); __builtin_amdgcn_s_barrier(); }
#pragma unroll
        for (int ai = 0; ai < 2; ++ai)
#pragma unroll
            for (int m = 0; m < 4; ++m) {
                const int rl = rl0 + ai * 128 + m * 16;
#pragma unroll
                for (int bj = 0; bj < 2; ++bj) { const u32x4 w = pack8(acc[ai][bj][m][0], acc[ai][bj][m][1]);
                    if (in_lds) *(LAS u32x4*)(tile + rl * QPT_PITCH + (col0 + bj * 128) * 2) = w;
                    else *(u32x4*)(QP + (size_t)(u.pm * 256 + rl) * DM + u.pn * 256 + col0 + bj * 128) = w; }
            }
        if (in_lds) asm volatile("s_waitcnt lgkmcnt(0)" ::: "memory");
    }
};

struct Args { const float* in[28]; float* out; unsigned char* ws; int ph_lo, ph_hi, probe, pad; };
enum { I_X = 0, I_META, I_N1G, I_WIN, I_QNG, I_KNG, I_LQ1, I_LK1, I_LQ2, I_LK2, I_SUBLN, I_WATT, I_ARE, I_AIM, I_LOGDT, I_BRE, I_BIM, I_CRE, I_CIM, I_SSMD, I_WGLU, I_WOUT, I_N2G, I_WQ, I_K1, I_K2, I_PU, I_PV };

constexpr int NWAVES = 8, NTHREADS = 512;
constexpr int RING_BYTES = 131072, LDS_EXTRA_OFF = RING_BYTES, LDS_BYTES = 147456;

template <class RowMap>
__device__ __forceinline__ void transpose_item(const float* W, int K, int N, bf16_t* WT, LAS float* scr, int item, int lane, RowMap rm, const float* kscale = nullptr) {
    const int nblk = N / 32, kb = item / nblk, nb = item % nblk, k0 = 64 * kb, n0 = 32 * nb;
    float tv[32];
#pragma unroll
    for (int i = 0; i < 32; ++i) { tv[i] = __builtin_nontemporal_load(W + (size_t)(k0 + 2 * i + (lane >> 5)) * N + n0 + (lane & 31)); if (kscale) tv[i] *= kscale[k0 + 2 * i + (lane >> 5)]; }
#pragma unroll
    for (int i = 0; i < 32; ++i) scr[(2 * i + (lane >> 5)) * 33 + (lane & 31)] = tv[i];
    asm volatile("s_waitcnt lgkmcnt(0)" ::: "memory");
    const int c = lane & 7;
#pragma unroll
    for (int j = 0; j < 4; ++j) { const int n = (lane >> 3) + 8 * j; const LAS float* s = scr + (8 * c) * 33 + n;
        u32x4 o; o.x = pk2(s[0 * 33], s[1 * 33]); o.y = pk2(s[2 * 33], s[3 * 33]); o.z = pk2(s[4 * 33], s[5 * 33]); o.w = pk2(s[6 * 33], s[7 * 33]);
        *(u32x4*)(WT + (size_t)rm(n0 + n) * K + k0 + 8 * c) = o; }
    asm volatile("s_waitcnt lgkmcnt(0)" ::: "memory");
}
struct MapId { __device__ __forceinline__ int operator()(int n) const { return n; } };
struct MapWin { __device__ __forceinline__ int operator()(int n) const { if (n >= 2048) return n; const int w = n & 255; return (n & ~255) + 128 * ((w >> 5) & 1) + 32 * (w >> 6) + (w & 31); } };
struct MapGlu { __device__ __forceinline__ int operator()(int n) const { const int hi = n >= 2048, j = n & 2047; return (j >> 7) * 256 + 128 * hi + (j & 127); } };

__device__ __forceinline__ void rms_row_to_bf16(const float* xrow, const float* g, bf16_t* orow, int lane) {
    const f32x4* xr = (const f32x4*)xrow + lane; const f32x4* gr = (const f32x4*)g + lane;
    f32x4 v[8]; float s = 0.f;
#pragma unroll
    for (int j = 0; j < 8; ++j) { v[j] = __builtin_nontemporal_load(xr + 64 * j); s += (v[j][0] * v[j][0] + v[j][1] * v[j][1]) + (v[j][2] * v[j][2] + v[j][3] * v[j][3]); }
    const float rs = rsqrtf(wave_sum(s) * (1.0f / DM) + EPS);
    u32x2* o = (u32x2*)orow + lane;
#pragma unroll
    for (int j = 0; j < 8; ++j) { const f32x4 y = v[j] * rs * gr[64 * j]; u32x2 w; w.x = pk2(y[0], y[1]); w.y = pk2(y[2], y[3]); o[64 * j] = w; }
}

__device__ __forceinline__ void rms_row_to_i8(const float* xrow, const float* g, unsigned char* qrow, float* sx, int lane) {
    const f32x4* xr = (const f32x4*)xrow + lane; const f32x4* gr = (const f32x4*)g + lane;
    f32x4 v[8]; float s = 0.f, mx = 0.f;
#pragma unroll
    for (int j = 0; j < 8; ++j) { v[j] = __builtin_nontemporal_load(xr + 64 * j); s += (v[j][0] * v[j][0] + v[j][1] * v[j][1]) + (v[j][2] * v[j][2] + v[j][3] * v[j][3]);
        v[j] = v[j] * gr[64 * j]; mx = fmaxf(mx, fmaxf(fmaxf(fabsf(v[j][0]), fabsf(v[j][1])), fmaxf(fabsf(v[j][2]), fabsf(v[j][3])))); }
    const float rs = rsqrtf(wave_sum(s) * (1.0f / DM) + EPS);
    mx = wave_max(mx);
    const float inv = mx > 0.f ? 127.0f / mx : 0.f;
    unsigned* o = (unsigned*)qrow + lane;
#pragma unroll
    for (int j = 0; j < 8; ++j) { const int q0 = (int)rintf(v[j][0] * inv), q1 = (int)rintf(v[j][1] * inv), q2 = (int)rintf(v[j][2] * inv), q3 = (int)rintf(v[j][3] * inv);
        o[64 * j] = (unsigned)(q0 & 255) | ((unsigned)(q1 & 255) << 8) | ((unsigned)(q2 & 255) << 16) | ((unsigned)q3 << 24); }
    if (lane == 0) *sx = mx * rs * (1.0f / 127.0f);
}
template <int K, class RowMap>
__device__ __forceinline__ void strip_item(const float* Wm, int N, const float* kscale, RowMap rm, unsigned char* WT8, float* sw, LAS unsigned char* lds, int strip) {
    const int tid = otid(), col = tid & 31, rp = tid >> 5;
    constexpr int CP = 2 * K + 16;
    const float* W = Wm + 32 * strip + col;
    float mx = 0.f;
#pragma unroll 1
    for (int i0 = 0; i0 < K / 32; i0 += 16) {
        float v[32];
#pragma unroll
        for (int i = 0; i < 16; ++i) { const int k = 2 * (rp + 16 * (i0 + i)); v[2 * i] = __builtin_nontemporal_load(W + (size_t)k * N); v[2 * i + 1] = __builtin_nontemporal_load(W + (size_t)(k + 1) * N); }
        asm volatile("" ::: "memory");
#pragma unroll
        for (int i = 0; i < 16; ++i) { const int k = 2 * (rp + 16 * (i0 + i)); if (kscale) { v[2 * i] *= kscale[k]; v[2 * i + 1] *= kscale[k + 1]; }
            mx = fmaxf(mx, fmaxf(fabsf(v[2 * i]), fabsf(v[2 * i + 1])));
            *(LAS unsigned*)(lds + col * CP + k * 2) = pk2(v[2 * i], v[2 * i + 1]); }
    }
    LAS float* smax = (LAS float*)(lds + 32 * CP);
    smax[rp * 32 + col] = mx;
    __syncthreads();
    constexpr int TPC = K / 16, CPP = 512 / TPC;
#pragma unroll 1
    for (int p = 0; p < 32 / CPP; ++p) {
        const int c = CPP * p + tid / TPC, kc = (tid % TPC) * 16;
        float cm = 0.f;
#pragma unroll
        for (int j = 0; j < 16; ++j) cm = fmaxf(cm, smax[j * 32 + c]);
        const float inv = cm > 0.f ? 127.0f / cm : 0.f;
        const u32x4 lo = *(const LAS u32x4*)(lds + c * CP + kc * 2), hi = *(const LAS u32x4*)(lds + c * CP + kc * 2 + 16);
        const unsigned wd[8] = {lo.x, lo.y, lo.z, lo.w, hi.x, hi.y, hi.z, hi.w}; u32x4 o;
#pragma unroll
        for (int q = 0; q < 4; ++q) { const int q0 = (int)rintf(bflo(wd[2 * q]) * inv), q1 = (int)rintf(bfhi(wd[2 * q]) * inv), q2 = (int)rintf(bflo(wd[2 * q + 1]) * inv), q3 = (int)rintf(bfhi(wd[2 * q + 1]) * inv);
            const unsigned pk = (unsigned)(q0 & 255) | ((unsigned)(q1 & 255) << 8) | ((unsigned)(q2 & 255) << 16) | ((unsigned)q3 << 24);
            if (q == 0) o.x = pk; else if (q == 1) o.y = pk; else if (q == 2) o.z = pk; else o.w = pk; }
        const int n = rm(32 * strip + c);
        *(u32x4*)(WT8 + (size_t)n * K + kc) = o;
        if ((tid % TPC) == 0) sw[n] = cm * (1.0f / 127.0f);
    }
    __syncthreads();
}

constexpr int XROWS = 2 * NEXP;
template <int MODE>
__device__ __forceinline__ void p0_prologue(const Args& A, LAS unsigned char* lds, int G, int probe = 0) {
    const int tid = otid(), lane = tid & 63, wave = __builtin_amdgcn_readfirstlane(tid >> 6);
    const int gw = MODE ? (blockIdx.x - 128) * NWAVES + wave : blockIdx.x * NWAVES + wave, NGW = MODE ? (G - 128) * NWAVES : G * NWAVES;
    unsigned char* ws = A.ws;
#pragma unroll 1
    for (int step = 0; step < 3; ++step) {
    const int part = (MODE == 0 && (blockIdx.x & 1)) ? (step + 2) % 3 : step;
    if (part == 0 && (probe == 0 || probe == 1)) {
        LAS float* scr = (LAS float*)(lds + wave * 16384);
        constexpr int I_IN = (DM / 64) * (INW / 32), I_AT = (AW / 64) * (DM / 32), I_GL = (SW / 64) * (2 * DM / 32), I_OU = (DM / 64) * (DM / 32), I_Q = I_OU;
        constexpr int NIT = I_IN + I_AT + I_GL + I_OU + I_Q;
        if (MODE == 0) { for (int st = blockIdx.x; st < INW / 32; st += G) strip_item<DM>(A.in[I_WIN], INW, nullptr, MapWin(), ws + WS_WTIN, (float*)(ws + WS_SWB), lds, st); }
        else {
            for (int it = (int)blockIdx.x - 128; it < 320; it += G - 128) {
                if (it < 64) strip_item<DM>(A.in[I_WQ], DM, A.in[I_N2G], MapId(), ws + WS_WTQ, (float*)(ws + WS_SWQ), lds, it);
                else if (it < 128) strip_item<DM>(A.in[I_WOUT], DM, nullptr, MapId(), ws + WS_WTOUT, (float*)(ws + WS_SWO), lds, it - 64);
                else if (it < 256) strip_item<SW>(A.in[I_WGLU], 2 * DM, nullptr, MapGlu(), ws + WS_WTGLU, (float*)(ws + WS_SWG), lds, it - 128);
                else strip_item<AW>(A.in[I_WATT], DM, nullptr, MapId(), ws + WS_WTATT, (float*)(ws + WS_SWA), lds, it - 256);
            }
        }
    }
    if (part == 1 && MODE == 0 && (probe == 0 || probe == 2)) for (int m = gw; m < MTOK; m += NGW) rms_row_to_i8(A.in[I_X] + (size_t)m * DM, A.in[I_N1G], ws + WS_XN + (size_t)m * DM, (float*)(ws + WS_SXA) + m, lane);
    if (part == 2 && (probe == 0 || probe == 3)) {
        float* su = (float*)(ws + WS_SU); float* sv = (float*)(ws + WS_SV);
        for (int it = MODE ? gw + XROWS : gw; it < (MODE ? 2 * NEXP : XROWS); it += NGW) {
            const int tb = it >= NEXP, e = it - tb * NEXP;
            const f32x4* src = (const f32x4*)(A.in[tb ? I_PV : I_PU] + (size_t)e * DM) + lane;
            f32x4 v[8]; float mx = 0.f;
#pragma unroll
            for (int j = 0; j < 8; ++j) { v[j] = __builtin_nontemporal_load(src + 64 * j); if (!tb) v[j] = v[j] * *((const f32x4*)A.in[I_N2G] + lane + 64 * j);
                mx = fmaxf(mx, fmaxf(fmaxf(fabsf(v[j][0]), fabsf(v[j][1])), fmaxf(fabsf(v[j][2]), fabsf(v[j][3])))); }
            mx = wave_max(mx);
            unsigned* dst = (unsigned*)(ws + (tb ? WS_VE : WS_UE) + (size_t)e * DM) + lane;
            if (!tb) {
                const float inv = mx > 0.f ? 127.0f / mx : 0.f;
#pragma unroll
                for (int j = 0; j < 8; ++j) { const int q0 = (int)rintf(v[j][0] * inv), q1 = (int)rintf(v[j][1] * inv), q2 = (int)rintf(v[j][2] * inv), q3 = (int)rintf(v[j][3] * inv);
                    dst[64 * j] = (unsigned)(q0 & 255) | ((unsigned)(q1 & 255) << 8) | ((unsigned)(q2 & 255) << 16) | ((unsigned)(q3 & 255) << 24); }
                if (lane == 0) su[e] = mx * (1.0f / 127.0f);
            } else {
                const float inv = mx > 0.f ? 448.0f / mx : 0.f;
#pragma unroll
                for (int j = 0; j < 8; ++j) { int p = __builtin_amdgcn_cvt_pk_fp8_f32(v[j][0] * inv, v[j][1] * inv, 0, false); p = __builtin_amdgcn_cvt_pk_fp8_f32(v[j][2] * inv, v[j][3] * inv, p, true); dst[64 * j] = (unsigned)p; }
                if (lane == 0) sv[e] = mx * (1.0f / 448.0f);
            }
        }
    }
    }
    if (MODE == 0 && (probe == 0 || probe == 4)) {
        { bf16_t* k12 = (bf16_t*)(ws + WS_K12);
          for (int i = blockIdx.x * NTHREADS + tid; i < 2 * 8 * 128 * 128; i += G * NTHREADS) k12[i] = (bf16_t)f2bf(i < 131072 ? A.in[I_K1][i] : A.in[I_K2][i - 131072]); }
        float* cs = (float*)(ws + WS_CS);
        for (int i = blockIdx.x * NTHREADS + tid; i < NPOS * 32; i += G * NTHREADS) {
            const int pos = i >> 5, j = i & 31; const float invf = exp2f(-(float)j * (13.287712379549449f / 32.0f));
            const float ang = (float)pos * invf; float sn, cn; sincosf(ang, &sn, &cn); cs[pos * 64 + j] = cn; cs[pos * 64 + 32 + j] = sn;
        }
        float* abar = (float*)(ws + WS_ABAR); float* bbar = (float*)(ws + WS_BBAR);
        for (int i = blockIdx.x * NTHREADS + tid; i < 64 * 64; i += G * NTHREADS) {
            const int g = i >> 6; const float are = A.in[I_ARE][i], aim = A.in[I_AIM][i], dt = expf(A.in[I_LOGDT][g]);
            const float mag = expf(are * dt); float sn, cn; sincosf(aim * dt, &sn, &cn); const float br = mag * cn, bi = mag * sn;
            abar[2 * i] = br; abar[2 * i + 1] = bi;
            const float nr = br - 1.0f, ni = bi, den = 1.0f / (are * are + aim * aim);
            const float fr_ = (nr * are + ni * aim) * den, fi_ = (ni * are - nr * aim) * den;
            for (int c = 0; c < 16; ++c) { const float b_r = A.in[I_BRE][i * 16 + c], b_i = A.in[I_BIM][i * 16 + c];
                bbar[(i * 16 + c) * 2] = fr_ * b_r - fi_ * b_i; bbar[(i * 16 + c) * 2 + 1] = fr_ * b_i + fi_ * b_r; }
        }
        if (blockIdx.x == 0 && wave == 0) {
            const float s1 = wave_sum(A.in[I_LQ1][lane] * A.in[I_LK1][lane]), s2 = wave_sum(A.in[I_LQ2][lane] * A.in[I_LK2][lane]);
            const float gqm = wave_max(fabsf(A.in[I_QNG][lane])), gkm = wave_max(fabsf(A.in[I_KNG][lane]));
            if (lane == 0) { float* par = (float*)(ws + WS_PAR); par[0] = expf(s1) - expf(s2) + LAM_INIT; par[1] = 8.0f * gqm * gkm * LOG2E * 1.01f; }
        }
    }
    if (MODE == 0 && (probe == 0 || probe == 5)) {
        __syncthreads();
        LAS float* hm = (LAS float*)(lds + wave * 16384);
        float* macc = (float*)(ws + WS_MP32);
        for (int it = gw; it < 48 * 32; it += NGW) {
            const int cb = it % 48, ks = it / 48, k0 = ks * 64;
            float w[64];
            const float* wp = A.in[I_WIN] + (size_t)k0 * INW + 1024 + cb * 64 + lane;
#pragma unroll
            for (int q = 0; q < 64; ++q) w[q] = wp[(size_t)q * INW];
            const float gk = A.in[I_N1G][k0 + lane];
#pragma unroll
            for (int r = 0; r < 16; ++r) hm[r * 64 + lane] = A.in[I_META][(size_t)r * DM + k0 + lane] * gk;
            asm volatile("s_waitcnt lgkmcnt(0)" ::: "memory");
            float acc[16];
#pragma unroll
            for (int r = 0; r < 16; ++r) acc[r] = 0.f;
#pragma unroll
            for (int q4 = 0; q4 < 16; ++q4) {
#pragma unroll
                for (int r = 0; r < 16; ++r) { const f32x4 h = *(const LAS f32x4*)(hm + r * 64 + 4 * q4); acc[r] += (h[0] * w[4 * q4] + h[1] * w[4 * q4 + 1]) + (h[2] * w[4 * q4 + 2] + h[3] * w[4 * q4 + 3]); }
                if ((q4 & 3) == 3) __builtin_amdgcn_sched_barrier(0);
            }
#pragma unroll
            for (int r = 0; r < 16; ++r) macc[((size_t)ks * 16 + r) * 3072 + cb * 64 + lane] = acc[r];
            asm volatile("s_waitcnt lgkmcnt(0)" ::: "memory");
        }
    }
}
__device__ __forceinline__ void p1_meta_finish(const Args& A, LAS unsigned char* lds, int G) {
    const int tid = otid(), lane = tid & 63, wave = __builtin_amdgcn_readfirstlane(tid >> 6); unsigned char* ws = A.ws;
    const float* mp = (const float*)(ws + WS_MP32); const float* cs = (const float*)(ws + WS_CS);
    bf16_t* KM = (bf16_t*)(ws + WS_KM); bf16_t* VM = (bf16_t*)(ws + WS_VM); float* UM = (float*)(ws + WS_UM); bf16_t* UMB = (bf16_t*)(ws + WS_UMB);
    LAS float* rsm = (LAS float*)(lds + LDS_EXTRA_OFF + 12288);
    for (int r = wave; r < 16; r += NWAVES) { const f32x4* mr = (const f32x4*)(A.in[I_META] + (size_t)r * DM) + lane; float sq = 0.f;
#pragma unroll
        for (int j = 0; j < 8; ++j) { const f32x4 v = mr[64 * j]; sq += (v[0] * v[0] + v[1] * v[1]) + (v[2] * v[2] + v[3] * v[3]); }
        sq = wave_sum(sq); if (lane == 0) rsm[r] = rsqrtf(sq * (1.0f / DM) + EPS); }
    __syncthreads();
    for (int t = blockIdx.x * NWAVES + wave; t < 16 * 16; t += G * NWAVES) {
        const int r = t >> 4, sh = t & 15, d = lane; float kv = 0.f;
        for (int ks = 0; ks < 32; ++ks) kv += mp[((size_t)ks * 16 + r) * 3072 + sh * 64 + d];
        kv *= rsm[r];
        const float rs = rsqrtf(wave_sum(kv * kv) * (1.0f / 64.0f) + EPS);
        const float a = kv * rs * A.in[I_KNG][d], bq = __shfl_xor(a, 32);
        const int j = d & 31; const float cn = cs[r * 64 + j], sn = cs[r * 64 + 32 + j];
        KM[r * 1024 + sh * 64 + d] = (bf16_t)f2bf((d < 32) ? (a * cn - bq * sn) : (a * cn + bq * sn));
    }
    for (int i = blockIdx.x * NTHREADS + tid; i < 16 * 2048; i += G * NTHREADS) {
        const int r = i >> 11, c = i & 2047; float v = 0.f;
        for (int ks = 0; ks < 32; ++ks) v += mp[((size_t)ks * 16 + r) * 3072 + 1024 + c];
        v *= rsm[r];
        if (c < 1024) VM[r * 1024 + c] = (bf16_t)f2bf(v); else { UM[r * 1024 + c - 1024] = v; UMB[r * 1024 + c - 1024] = (bf16_t)f2bf(v); }
    }
    for (int i = blockIdx.x * NTHREADS + tid; i < 48 * 1024; i += G * NTHREADS) { KM[16 * 1024 + i] = 0; VM[16 * 1024 + i] = 0; }
}

namespace att {
typedef float f32x16 __attribute__((ext_vector_type(16)));
typedef short s16x4 __attribute__((ext_vector_type(4)));
typedef short v4i16_t __attribute__((ext_vector_type(4)));
constexpr int KP = 272, VP = 320, KBUF = 64 * KP, VBUF = 64 * VP, STG = KBUF + VBUF;
constexpr int X_OFF = 0, OST_OFF = 65536, QF_OFF = 2 * STG, WSL_OFF = QF_OFF + 32768;
__device__ __forceinline__ int crow(int r, int hi) { return (r & 3) + 8 * (r >> 2) + 4 * hi; }
__device__ __forceinline__ s16x4 vtr(const LAS unsigned char* p) { return __builtin_bit_cast(s16x4, __builtin_amdgcn_ds_read_tr16_b64_v4i16((LAS v4i16_t*)p)); }
__device__ __forceinline__ unsigned cvtpk(float lo, float hi) { f32x2 v = {lo, hi}; bf16x2_t b = __builtin_convertvector(v, bf16x2_t); return __builtin_bit_cast(unsigned, b); }

__device__ __forceinline__ void attn_unit(const Args& A, int b, int h, int qb, LAS unsigned char* lds, float lam, float Mb) {
    const int tid = otid(), lane = tid & 63, wave = __builtin_amdgcn_readfirstlane(tid >> 6);
    const int c = wave >> 2, w4 = wave & 3, r32 = lane & 31, hh = lane >> 5;
    unsigned char* ws = A.ws;
    const bf16_t* Q = (const bf16_t*)(ws + WS_Q); const bf16_t* K = (const bf16_t*)(ws + WS_K); const bf16_t* V = (const bf16_t*)(ws + WS_V);
    const bf16_t* KM = (const bf16_t*)(ws + WS_KM); const bf16_t* VM = (const bf16_t*)(ws + WS_VM); bf16_t* ATT = (bf16_t*)(ws + WS_ATT);
    const int tq = qb * 128 + 32 * w4 + r32;
    LAS unsigned char* qfl = lds + QF_OFF + wave * 4096 + lane * 16;
    { const bf16_t* qp = Q + (size_t)(b * SEQ + tq) * AW + h * 128 + c * 64 + 8 * hh;
#pragma unroll
      for (int ds = 0; ds < 4; ++ds) *(LAS bf16x8*)(qfl + ds * 1024) = *(const bf16x8*)(qp + 16 * ds); }
    f32x16 o[4];
#pragma unroll
    for (int d = 0; d < 4; ++d)
#pragma unroll
        for (int r = 0; r < 16; ++r) o[d][r] = 0.f;
    float l = 0.f;
    const int ntile = 2 * qb + 3;
    const int srow = tid >> 3, sch = tid & 7;
    u32x4 st[4];
#define ATT_LOAD(kt) do { const bf16_t* kr; const bf16_t* vr; if ((kt) == 0) { kr = KM + (size_t)srow * AW; vr = VM + (size_t)srow * AW; } \
        else { const size_t row = (size_t)(b * SEQ + ((kt) - 1) * 64 + srow) * AW; kr = K + row; vr = V + row; } \
        kr += h * 128 + sch * 8; vr += h * 128 + sch * 8; st[0] = *(const u32x4*)kr; st[1] = *(const u32x4*)(kr + 64); st[2] = *(const u32x4*)vr; st[3] = *(const u32x4*)(vr + 64); } while (0)
#define ATT_STORE(buf) do { LAS unsigned char* kb_ = lds + (buf) * STG + srow * KP + sch * 16; LAS unsigned char* vb_ = lds + (buf) * STG + KBUF + srow * VP + sch * 16; \
        *(LAS u32x4*)kb_ = st[0]; *(LAS u32x4*)(kb_ + 128) = st[1]; *(LAS u32x4*)vb_ = st[2]; *(LAS u32x4*)(vb_ + 128) = st[3]; } while (0)
    ATT_LOAD(0); ATT_STORE(0);
    __syncthreads();
    const int koff = r32 * KP + (c * 64 + 8 * hh) * 2;
    const int voff = (4 * hh + ((lane & 15) >> 2)) * VP + (16 * ((lane >> 4) & 1) + 4 * (lane & 3)) * 2;
    const float NEG = -INFINITY;
#pragma unroll 1
    for (int kt = 0; kt < ntile; ++kt) {
        const int cur = kt & 1;
        if (kt + 1 < ntile) ATT_LOAD(kt + 1);
        const LAS unsigned char* Kb = lds + cur * STG + koff; const LAS unsigned char* Vb = lds + cur * STG + KBUF + voff;
        f32x16 p0, p1;
#pragma unroll
        for (int r = 0; r < 16; ++r) { p0[r] = -Mb; p1[r] = -Mb; }
#pragma unroll
        for (int ds = 0; ds < 4; ++ds) {
            const bf16x8 a0 = *(const LAS bf16x8*)(Kb + ds * 32), a1 = *(const LAS bf16x8*)(Kb + 32 * KP + ds * 32);
            const bf16x8 qv = *(const LAS bf16x8*)(qfl + ds * 1024);
            p0 = __builtin_amdgcn_mfma_f32_32x32x16_bf16(a0, qv, p0, 0, 0, 0);
            p1 = __builtin_amdgcn_mfma_f32_32x32x16_bf16(a1, qv, p1, 0, 0, 0);
        }
        if (kt == 0) {
#pragma unroll
            for (int r = 0; r < 16; ++r) { if (r >= 8) p0[r] = NEG; p1[r] = NEG; }
        } else if (kt - 1 >= 2 * qb) {
            const int lim = tq - (kt - 1) * 64 - 4 * hh;
#pragma unroll
            for (int r = 0; r < 16; ++r) { const int kc = (r & 3) + 8 * (r >> 2); if (kc > lim) p0[r] = NEG; if (kc + 32 > lim) p1[r] = NEG; }
        }
        float sacc = 0.f;
#pragma unroll
        for (int r = 0; r < 16; ++r) { p0[r] = __builtin_amdgcn_exp2f(p0[r]); p1[r] = __builtin_amdgcn_exp2f(p1[r]); sacc += p0[r] + p1[r]; }
        l += sacc;
        bf16x8 pa[4];
        { u32x4 w;
          w.x = cvtpk(p0[0], p0[1]); w.y = cvtpk(p0[2], p0[3]); w.z = cvtpk(p0[4], p0[5]); w.w = cvtpk(p0[6], p0[7]); pa[0] = __builtin_bit_cast(bf16x8, w);
          w.x = cvtpk(p0[8], p0[9]); w.y = cvtpk(p0[10], p0[11]); w.z = cvtpk(p0[12], p0[13]); w.w = cvtpk(p0[14], p0[15]); pa[1] = __builtin_bit_cast(bf16x8, w);
          w.x = cvtpk(p1[0], p1[1]); w.y = cvtpk(p1[2], p1[3]); w.z = cvtpk(p1[4], p1[5]); w.w = cvtpk(p1[6], p1[7]); pa[2] = __builtin_bit_cast(bf16x8, w);
          w.x = cvtpk(p1[8], p1[9]); w.y = cvtpk(p1[10], p1[11]); w.z = cvtpk(p1[12], p1[13]); w.w = cvtpk(p1[14], p1[15]); pa[3] = __builtin_bit_cast(bf16x8, w); }
        __builtin_amdgcn_sched_barrier(0);
        __builtin_amdgcn_s_setprio(1);
#pragma unroll
        for (int db = 0; db < 4; ++db) {
            s16x4 lo[4], hi[4];
#pragma unroll
            for (int ks = 0; ks < 4; ++ks) { lo[ks] = vtr(Vb + (16 * ks) * VP + db * 64); hi[ks] = vtr(Vb + (16 * ks + 8) * VP + db * 64); }
#pragma unroll
            for (int ks = 0; ks < 4; ++ks) {
                const bf16x8 vf = (bf16x8){lo[ks][0], lo[ks][1], lo[ks][2], lo[ks][3], hi[ks][0], hi[ks][1], hi[ks][2], hi[ks][3]};
                o[db] = __builtin_amdgcn_mfma_f32_32x32x16_bf16(pa[ks], vf, o[db], 0, 0, 0);
            }
        }
        __builtin_amdgcn_s_setprio(0);
        if (kt + 1 < ntile) ATT_STORE(cur ^ 1);
        __syncthreads();
    }
#undef ATT_LOAD
#undef ATT_STORE
    l += __shfl_xor(l, 32);
    LAS float* wsl = (LAS float*)(lds + WSL_OFF);
    LAS float* X = (LAS float*)(lds + X_OFF);
    if (hh == 0) wsl[c * 128 + 32 * w4 + r32] = (c == 0 ? 1.0f : lam) / l;
    __syncthreads();
    if (c == 1) {
#pragma unroll
        for (int r = 0; r < 16; ++r) { const int ql = 32 * w4 + crow(r, hh); const float sc = wsl[128 + ql];
#pragma unroll
            for (int db = 0; db < 4; ++db) X[ql * 128 + 32 * db + r32] = o[db][r] * sc;
            if ((r & 3) == 3) __builtin_amdgcn_sched_barrier(0); }
    }
    __syncthreads();
    if (c == 0) {
        LAS bf16_t* ost = (LAS bf16_t*)(lds + OST_OFF + w4 * 8192);
        float gsub[4];
#pragma unroll
        for (int db = 0; db < 4; ++db) gsub[db] = A.in[I_SUBLN][32 * db + r32] * (1.0f - LAM_INIT);
#pragma unroll
        for (int r = 0; r < 16; ++r) {
            const int qw = crow(r, hh), ql = 32 * w4 + qw; const float sc = wsl[ql];
            float d[4], ss = 0.f;
#pragma unroll
            for (int db = 0; db < 4; ++db) { d[db] = o[db][r] * sc - X[ql * 128 + 32 * db + r32]; ss += d[db] * d[db]; }
            ss = row_sum16(ss); ss += __shfl_xor(ss, 16);
            const float rs = rsqrtf(ss * (1.0f / 128.0f) + EPS);
#pragma unroll
            for (int db = 0; db < 4; ++db) ost[qw * 128 + 32 * db + r32] = (bf16_t)f2bf(d[db] * rs * gsub[db]);
            if ((r & 3) == 3) __builtin_amdgcn_sched_barrier(0);
        }
        asm volatile("s_waitcnt lgkmcnt(0)" ::: "memory");
#pragma unroll
        for (int it = 0; it < 8; ++it) { const int row = it * 4 + (lane >> 4), ch = lane & 15;
            const u32x4 v = *(const LAS u32x4*)(ost + row * 128 + ch * 8);
            *(u32x4*)(ATT + (size_t)(b * SEQ + qb * 128 + 32 * w4 + row) * AW + h * 128 + ch * 8) = v; }
    }
    __syncthreads();
}
__device__ __forceinline__ void attn_phase(const Args& A, LAS unsigned char* lds, int G) {
    const float* par = (const float*)(A.ws + WS_PAR); const float lam = par[0], Mb = par[1];
    const int bx = blockIdx.x, vcu = (G % 8 == 0) ? (bx % 8) * (G / 8) + bx / 8 : bx;
    for (int item = vcu; item < 256; item += G) {
        const int bh = item >> 4, pr = item & 15;
#pragma unroll 1
        for (int u2 = 0; u2 < 2; ++u2) attn_unit(A, bh >> 3, bh & 7, u2 ? pr : 31 - pr, lds, lam, Mb);
    }
}
}

__device__ __forceinline__ float gelu_as(float v) {
    const float av = fabsf(v), t = __builtin_amdgcn_rcpf(av * 0.2316418882f + 1.0f);
    float q = t * 0.5307027145f + (-0.7265760135f); q = q * t + 0.7107068705f; q = q * t + (-0.142248368f); q = q * t + 0.127414796f; q = q * t;
    const float e = __builtin_amdgcn_exp2f((v * v) * (-0.72134752044f)), m = v * (q * e);
    return v < 0.f ? m : v - m;
}

namespace ssm {
typedef float f32x16 __attribute__((ext_vector_type(16)));
constexpr int L_APOW = 0, L_BB = 8704, L_CC = L_BB + 8192, L_KT = L_CC + 8192, L_DS = L_KT + 16384, L_XIN = L_DS + 64, XPITCH = 272, XBLK = 32 * XPITCH;
static_assert(L_XIN + 8 * XBLK <= RING_BYTES, "ssm LDS map");
__device__ __forceinline__ unsigned cvtpk(float lo, float hi) { f32x2 v = {lo, hi}; bf16x2_t b = __builtin_convertvector(v, bf16x2_t); return __builtin_bit_cast(unsigned, b); }
__device__ __forceinline__ void ssm_mm_phase(const Args& A, LAS unsigned char* lds, int G, int probe = 0) {
    const int tid = otid(), lane = tid & 63, wave = __builtin_amdgcn_readfirstlane(tid >> 6), r32 = lane & 31, hh = lane >> 5;
    unsigned char* ws = A.ws;
    const bf16_t* UB = (const bf16_t*)(ws + WS_UB); const bf16_t* UMB = (const bf16_t*)(ws + WS_UMB); bf16_t* YS = (bf16_t*)(ws + WS_YS);
    const float* abar = (const float*)(ws + WS_ABAR); const float* bbar = (const float*)(ws + WS_BBAR);
    LAS float* apow = (LAS float*)(lds + L_APOW); LAS float* Bb = (LAS float*)(lds + L_BB); LAS float* Cc = (LAS float*)(lds + L_CC); LAS float* Kt = (LAS float*)(lds + L_KT);
    if (blockIdx.x < 128) {
        const int item = blockIdx.x, b = item >> 6, g = item & 63;
        __syncthreads();
        if (tid < 64) { const float ar = abar[(g * 64 + tid) * 2], ai = abar[(g * 64 + tid) * 2 + 1]; float pr = 1.f, pi = 0.f;
            for (int t = 0; t <= 16; ++t) { apow[(t * 64 + tid) * 2] = pr; apow[(t * 64 + tid) * 2 + 1] = pi; const float nr = pr * ar - pi * ai, ni = pr * ai + pi * ar; pr = nr; pi = ni; } }
        *(LAS f32x4*)(Bb + 4 * tid) = *(const f32x4*)(bbar + (size_t)g * 2048 + 4 * tid);
        if (tid < 16) ((LAS float*)(lds + L_DS))[tid] = A.in[I_SSMD][g * 16 + tid];
#pragma unroll
        for (int q = 0; q < 2; ++q) { const int idx = 2 * tid + q, cc_ = idx >> 6, pp_ = idx & 63;
            Cc[(pp_ * 16 + cc_) * 2] = A.in[I_CRE][g * 1024 + idx]; Cc[(pp_ * 16 + cc_) * 2 + 1] = A.in[I_CIM][g * 1024 + idx]; }
        __syncthreads();
        { const int tau = tid >> 5, c = (tid >> 1) & 15, ch = tid & 1; float acc[8];
#pragma unroll
          for (int i = 0; i < 8; ++i) acc[i] = 0.f;
          for (int p = 0; p < 64; ++p) {
              const float cr = Cc[(p * 16 + c) * 2], ci = Cc[(p * 16 + c) * 2 + 1], ar = apow[(tau * 64 + p) * 2], ai = apow[(tau * 64 + p) * 2 + 1];
              const float wr = cr * ar - ci * ai, wi = cr * ai + ci * ar;
              const LAS f32x4* bp = (const LAS f32x4*)(Bb + (p * 16 + 8 * ch) * 2);
#pragma unroll
              for (int q = 0; q < 4; ++q) { const f32x4 bv = bp[q]; acc[2 * q] += wr * bv[0] - wi * bv[1]; acc[2 * q + 1] += wr * bv[2] - wi * bv[3]; }
          }
#pragma unroll
          for (int i = 0; i < 8; ++i) Kt[(tau * 16 + c) * 16 + 8 * ch + i] = acc[i]; }
        __syncthreads();
        if (probe == 3) return;
        if (wave < 4) {
            const int mb = wave;
            bf16x8 pf[16];
            { const int p = 16 * mb + (r32 >> 1), ri = r32 & 1;
#pragma unroll
              for (int sstep = 0; sstep < 16; ++sstep) {
                  const float ar = apow[((15 - sstep) * 64 + p) * 2], ai = apow[((15 - sstep) * 64 + p) * 2 + 1];
                  const float ca = ri ? ai : ar, cb_ = ri ? ar : -ai;
                  const LAS f32x4* bp = (const LAS f32x4*)(Bb + (p * 16 + 8 * hh) * 2); float v[8];
#pragma unroll
                  for (int q = 0; q < 4; ++q) { const f32x4 bv = bp[q]; v[2 * q] = ca * bv[0] + cb_ * bv[1]; v[2 * q + 1] = ca * bv[2] + cb_ * bv[3]; }
                  u32x4 w; w.x = cvtpk(v[0], v[1]); w.y = cvtpk(v[2], v[3]); w.z = cvtpk(v[4], v[5]); w.w = cvtpk(v[6], v[7]); pf[sstep] = __builtin_bit_cast(bf16x8, w);
                  if ((sstep & 3) == 3) __builtin_amdgcn_sched_barrier(0); } }
            const int pst = 16 * mb + (r32 >> 1);
            const float sca = apow[(16 * 64 + pst) * 2], scb = (r32 & 1) ? apow[(16 * 64 + pst) * 2 + 1] : -apow[(16 * 64 + pst) * 2 + 1];
            const int sig = (r32 & 3) + 4 * (r32 >> 3) + 16 * ((r32 >> 2) & 1);
            float xc;
            { f32x16 acc;
#pragma unroll
              for (int r = 0; r < 16; ++r) acc[r] = 0.f;
#pragma unroll
              for (int sstep = 0; sstep < 16; ++sstep) { const bf16x8 bf = *(const bf16x8*)(UMB + (size_t)sstep * SW + g * 16 + 8 * hh); acc = __builtin_amdgcn_mfma_f32_32x32x16_bf16(bf, pf[sstep], acc, 0, 0, 0); }
              xc = acc[0]; }
            bf16x8 ufr[16];
            { const bf16_t* up = UB + (size_t)(b * SEQ + 16 * sig) * SW + g * 16 + 8 * hh;
#pragma unroll
              for (int sstep = 0; sstep < 16; ++sstep) ufr[sstep] = *(const bf16x8*)(up + (size_t)sstep * SW); }
#pragma unroll 1
            for (int cb = 0; cb < 8; ++cb) {
                f32x16 acc;
#pragma unroll
                for (int r = 0; r < 16; ++r) acc[r] = 0.f;
#pragma unroll
                for (int sstep = 0; sstep < 16; ++sstep) acc = __builtin_amdgcn_mfma_f32_32x32x16_bf16(ufr[sstep], pf[sstep], acc, 0, 0, 0);
                if (cb + 1 < 8) {
                    const bf16_t* up = UB + (size_t)(b * SEQ + 16 * (32 * (cb + 1) + sig)) * SW + g * 16 + 8 * hh;
#pragma unroll
                    for (int sstep = 0; sstep < 16; ++sstep) ufr[sstep] = *(const bf16x8*)(up + (size_t)sstep * SW);
                }
                float xin[16]; float xs_ = hh ? 0.f : xc;
#pragma unroll
                for (int r = 0; r < 16; ++r) { xin[r] = xs_; const float pv = dpp_f<0xB1>(xs_); xs_ = sca * xs_ + scb * pv + acc[r]; }
                float f = __shfl_xor(xs_, 32); if (!hh) f = 0.f;
#pragma unroll
                for (int r = 0; r < 16; ++r) { xin[r] += f; const float pv = dpp_f<0xB1>(f); f = sca * f + scb * pv; }
                xs_ += f;
                xc = __shfl_xor(xs_, 32);
                LAS bf16_t* xo = (LAS bf16_t*)(lds + L_XIN + cb * XBLK + (16 * hh) * XPITCH) + 32 * mb + r32;
#pragma unroll
                for (int r = 0; r < 16; ++r) xo[r * (XPITCH / 2)] = (bf16_t)f2bf(xin[r]);
            }
        }
        __syncthreads();
        if (probe == 4) return;
        {
            const int cb = wave, tl = r32 >> 4, c = r32 & 15;
            const size_t row0 = (size_t)(b * SEQ + 16 * (32 * cb + r32));
            bf16x8 ufr[16];
            { const bf16_t* up = UB + row0 * SW + g * 16 + 8 * hh;
#pragma unroll
              for (int ks = 0; ks < 16; ++ks) ufr[ks] = *(const bf16x8*)(up + (size_t)ks * SW); }
            bf16x8 kl[16];
#pragma unroll
            for (int d1 = 0; d1 < 16; ++d1) {
                const int tau = d1 - 1 + tl; float v[8];
                if (tau >= 0) { const LAS f32x4* kp = (const LAS f32x4*)(Kt + (tau * 16 + c) * 16 + 8 * hh); const f32x4 k0 = kp[0], k1 = kp[1];
                    v[0] = k0[0]; v[1] = k0[1]; v[2] = k0[2]; v[3] = k0[3]; v[4] = k1[0]; v[5] = k1[1]; v[6] = k1[2]; v[7] = k1[3]; }
                else {
#pragma unroll
                    for (int i = 0; i < 8; ++i) v[i] = 0.f; }
                u32x4 wv; wv.x = cvtpk(v[0], v[1]); wv.y = cvtpk(v[2], v[3]); wv.z = cvtpk(v[4], v[5]); wv.w = cvtpk(v[6], v[7]); kl[d1] = __builtin_bit_cast(bf16x8, wv);
                if ((d1 & 3) == 3) __builtin_amdgcn_sched_barrier(0);
            }
            const LAS unsigned char* xi_ = lds + L_XIN + cb * XBLK + r32 * XPITCH + 16 * hh;
#pragma unroll
            for (int mb = 0; mb < 8; ++mb) {
                int dq = 4 * hh; asm volatile("" : "+v"(dq));
                const f32x4 d0 = *(const LAS f32x4*)((LAS float*)(lds + L_DS) + dq), d1 = *(const LAS f32x4*)((LAS float*)(lds + L_DS) + dq + 8);
                const float dsk[8] = {d0[0], d0[1], d0[2], d0[3], d1[0], d1[1], d1[2], d1[3]};
                f32x16 acc;
#pragma unroll
                for (int r = 0; r < 16; ++r) acc[r] = 0.f;
#pragma unroll
                for (int ks = 0; ks < 16; ++ks) if (ks <= 2 * mb + 1) acc = __builtin_amdgcn_mfma_f32_32x32x16_bf16(kl[2 * mb - ks + 1], ufr[ks], acc, 0, 0, 0);
                int cq = c + 64 * hh; asm volatile("" : "+v"(cq));
#pragma unroll
                for (int ks = 0; ks < 8; ++ks) {
                    float v[8];
#pragma unroll
                    for (int i2 = 0; i2 < 4; ++i2) { const int p = 8 * ks + 4 * hh + i2;
                        const float c_r = Cc[(cq + 128 * ks + 16 * i2) * 2], c_i = Cc[(cq + 128 * ks + 16 * i2) * 2 + 1], ar = apow[((2 * mb + tl + 1) * 64 + p) * 2], ai = apow[((2 * mb + tl + 1) * 64 + p) * 2 + 1];
                        v[2 * i2] = c_r * ar - c_i * ai; v[2 * i2 + 1] = -(c_r * ai + c_i * ar); }
                    u32x4 wv; wv.x = cvtpk(v[0], v[1]); wv.y = cvtpk(v[2], v[3]); wv.z = cvtpk(v[4], v[5]); wv.w = cvtpk(v[6], v[7]);
                    acc = __builtin_amdgcn_mfma_f32_32x32x16_bf16(__builtin_bit_cast(bf16x8, wv), *(const LAS bf16x8*)(xi_ + 32 * ks), acc, 0, 0, 0);
                }
#pragma unroll
                for (int t2 = 0; t2 < 2; ++t2) {
                    const u32x4 uf = __builtin_bit_cast(u32x4, ufr[2 * mb + t2]);
                    const unsigned s0 = hh ? uf.x : uf.z, s1 = hh ? uf.y : uf.w;
                    const unsigned r0 = (unsigned)__shfl_xor((int)s0, 32), r1 = (unsigned)__shfl_xor((int)s1, 32);
                    const unsigned own0 = hh ? uf.z : uf.x, own1 = hh ? uf.w : uf.y;
                    const unsigned c0a = hh ? r0 : own0, c0b = hh ? r1 : own1, c1a = hh ? own0 : r0, c1b = hh ? own1 : r1;
                    const unsigned ua[2] = {c0a, c1a}, ub[2] = {c0b, c1b};
#pragma unroll
                    for (int ch = 0; ch < 2; ++ch) {
                        const size_t off = (row0 + 2 * mb + t2) * SW + g * 16 + 4 * hh + 8 * ch;
                        const float y0 = gelu_as(acc[8 * t2 + 4 * ch + 0] + dsk[4 * ch + 0] * bflo(ua[ch])), y1 = gelu_as(acc[8 * t2 + 4 * ch + 1] + dsk[4 * ch + 1] * bfhi(ua[ch]));
                        const float y2 = gelu_as(acc[8 * t2 + 4 * ch + 2] + dsk[4 * ch + 2] * bflo(ub[ch])), y3 = gelu_as(acc[8 * t2 + 4 * ch + 3] + dsk[4 * ch + 3] * bfhi(ub[ch]));
                        u32x2 o; o.x = cvtpk(y0, y1); o.y = cvtpk(y2, y3); *(u32x2*)(YS + off) = o;
                    }
                }
                __builtin_amdgcn_sched_barrier(0);
            }
        }
    }
}
}

namespace tk {
typedef float f32x16 __attribute__((ext_vector_type(16)));
__device__ __forceinline__ unsigned fkey(float f) { const unsigned u = __builtin_bit_cast(unsigned, f); return (u & 0x80000000u) ? ~u : (u | 0x80000000u); }
__device__ __forceinline__ float kval(unsigned k) { const unsigned u = (k & 0x80000000u) ? (k & 0x7fffffffu) : ~k; return __builtin_bit_cast(float, u); }
__device__ __forceinline__ void ce(unsigned& a, unsigned& b) { const unsigned hi = a > b ? a : b, lo = a > b ? b : a; a = hi; b = lo; }
template <int N> __device__ __forceinline__ void sort_desc(unsigned (&a)[N]) {
#pragma unroll
    for (int k = 2; k <= N; k <<= 1)
#pragma unroll
        for (int j = k >> 1; j > 0; j >>= 1)
#pragma unroll
            for (int i = 0; i < N; ++i) { const int l = i ^ j; if (l > i) { if ((i & k) == 0) ce(a[i], a[l]); else ce(a[l], a[i]); } }
}
__device__ __forceinline__ void merge_top16(unsigned (&a)[16], const unsigned (&b)[16]) {
#pragma unroll
    for (int i = 0; i < 16; ++i) a[i] = a[i] > b[15 - i] ? a[i] : b[15 - i];
#pragma unroll
    for (int j = 8; j > 0; j >>= 1)
#pragma unroll
        for (int i = 0; i < 16; ++i) { const int l = i ^ j; if (l > i) ce(a[i], a[l]); }
}
__device__ __forceinline__ void peer_topk_phase(const Args& A, LAS unsigned char* lds, int G, bool qlds) {
    const int tid = otid(), lane = tid & 63, wave = __builtin_amdgcn_readfirstlane(tid >> 6), r32 = lane & 31, hh = lane >> 5;
    unsigned char* ws = A.ws;
    const bf16_t* QP = (const bf16_t*)(ws + WS_QP); const bf16_t* K12 = (const bf16_t*)(ws + WS_K12); int* IDX = (int*)(ws + WS_IDX); float* GW = (float*)(ws + WS_GW);
    LAS unsigned* tl = (LAS unsigned*)(lds + wave * 32 * QPT_PITCH);
    pg8::StaticOrder S5; S5.init(MTOK, DM, G, (int)blockIdx.x);
    pg8::Unit u5;
    for (int ui = 0; S5.next(ui, u5); ++ui) {
        const int h = u5.pn, tb = u5.pm * 8 + wave, tok = tb * 32 + r32;
        if (!qlds) {
            __syncthreads();
            for (int i = tid; i < 256 * 32; i += NTHREADS) { const int row = i >> 5, ch = i & 31;
                *(LAS u32x4*)(lds + row * QPT_PITCH + ch * 16) = *(const u32x4*)(QP + (size_t)(u5.pm * 256 + row) * DM + h * 256 + ch * 8); }
            __syncthreads();
        }
        unsigned lst[2][16];
#pragma unroll
        for (int half = 0; half < 2; ++half) {
            const bf16_t* qp = QP + (size_t)tok * DM + h * 256 + half * 128 + 8 * hh;
            const bf16_t* kp = K12 + ((size_t)(half * 8 + h) * 128 + r32) * 128 + 8 * hh;
            bf16x8 qf[8];
#pragma unroll
            for (int ds = 0; ds < 8; ++ds) qf[ds] = *(const LAS bf16x8*)(lds + (wave * 32 + r32) * QPT_PITCH + (half * 128 + 16 * ds + 8 * hh) * 2);
            f32x16 sc[4];
#pragma unroll
            for (int kb = 0; kb < 4; ++kb) {
#pragma unroll
                for (int r = 0; r < 16; ++r) sc[kb][r] = 0.f;
#pragma unroll
                for (int ds = 0; ds < 8; ++ds) { const bf16x8 kf = *(const bf16x8*)(kp + (size_t)kb * 32 * 128 + 16 * ds); sc[kb] = __builtin_amdgcn_mfma_f32_32x32x16_bf16(kf, qf[ds], sc[kb], 0, 0, 0); }
            }
            unsigned g0[16], g1[16];
#pragma unroll
            for (int r = 0; r < 16; ++r) { const int kc = (r & 3) + 8 * (r >> 2) + 4 * hh; g0[r] = (fkey(sc[0][r]) & ~127u) | (unsigned)(127 - kc); g1[r] = (fkey(sc[1][r]) & ~127u) | (unsigned)(127 - 32 - kc); }
            sort_desc<16>(g0); sort_desc<16>(g1); merge_top16(g0, g1);
#pragma unroll
            for (int r = 0; r < 16; ++r) { const int kc = (r & 3) + 8 * (r >> 2) + 4 * hh; lst[half][r] = (fkey(sc[2][r]) & ~127u) | (unsigned)(127 - 64 - kc); g1[r] = (fkey(sc[3][r]) & ~127u) | (unsigned)(127 - 96 - kc); }
            sort_desc<16>(lst[half]); sort_desc<16>(g1); merge_top16(lst[half], g1); merge_top16(lst[half], g0);
        }
        unsigned mine[16], oth[16];
#pragma unroll
        for (int i = 0; i < 16; ++i) { const unsigned send = hh ? lst[0][i] : lst[1][i]; mine[i] = hh ? lst[1][i] : lst[0][i]; oth[i] = (unsigned)__shfl_xor((int)send, 32); }
        merge_top16(mine, oth);
#pragma unroll
        for (int i = 0; i < 16; ++i) tl[(16 * hh + i) * 64 + r32] = mine[i];
        asm volatile("s_waitcnt lgkmcnt(0)" ::: "memory");
        float v1[16], v2[16];
#pragma unroll
        for (int i = 0; i < 16; ++i) { v1[i] = kval(tl[i * 64 + r32] & ~127u); v2[i] = kval(tl[(16 + i) * 64 + r32] & ~127u); }
#define CKEY(i, j) ((fkey(v1[i] + v2[j]) & ~255u) | (unsigned)(255 - (16 * (i) + (j))))
        unsigned c0[16], c1[16];
#pragma unroll
        for (int j = 0; j < 16; ++j) c0[j] = CKEY(0, j);
#pragma unroll
        for (int j = 0; j < 8; ++j) c1[j] = CKEY(1, j);
#pragma unroll
        for (int j = 0; j < 5; ++j) c1[8 + j] = CKEY(2, j);
        c1[13] = CKEY(3, 0); c1[14] = CKEY(3, 1); c1[15] = CKEY(3, 2);
        sort_desc<16>(c1); merge_top16(c0, c1);
        c1[0] = CKEY(3, 3); c1[1] = CKEY(4, 0); c1[2] = CKEY(4, 1); c1[3] = CKEY(4, 2); c1[4] = CKEY(5, 0); c1[5] = CKEY(5, 1); c1[6] = CKEY(6, 0); c1[7] = CKEY(6, 1);
        c1[8] = CKEY(7, 0); c1[9] = CKEY(7, 1); c1[10] = CKEY(8, 0); c1[11] = CKEY(9, 0); c1[12] = CKEY(10, 0); c1[13] = CKEY(11, 0); c1[14] = CKEY(12, 0); c1[15] = CKEY(13, 0);
        sort_desc<16>(c1); merge_top16(c0, c1);
        c1[0] = CKEY(14, 0); c1[1] = CKEY(15, 0);
#pragma unroll
        for (int i = 2; i < 16; ++i) c1[i] = 0u;
        sort_desc<16>(c1); merge_top16(c0, c1);
#undef CKEY
        float ev[16], se = 0.f; const float mx = kval(c0[0] & ~255u);
#pragma unroll
        for (int k = 0; k < 16; ++k) { ev[k] = __expf(kval(c0[k] & ~255u) - mx); se += ev[k]; }
        const float inv = 1.0f / se;
        if (hh == 0) {
            int ex[16];
#pragma unroll
            for (int k = 0; k < 16; ++k) { const int cid = 255 - (int)(c0[k] & 255u), i = cid >> 4, j = cid & 15;
                const int e1 = 127 - (int)(tl[i * 64 + r32] & 127u), e2 = 127 - (int)(tl[(16 + j) * 64 + r32] & 127u); ex[k] = e1 * 128 + e2; }
            int* ip = IDX + (size_t)tok * 128 + h * 16;
#pragma unroll
            for (int k = 0; k < 16; k += 4) *(u32x4*)(ip + k) = (u32x4){(unsigned)ex[k], (unsigned)ex[k + 1], (unsigned)ex[k + 2], (unsigned)ex[k + 3]};
        } else {
            float* gp = GW + (size_t)tok * 128 + h * 16;
#pragma unroll
            for (int k = 0; k < 16; k += 4) *(f32x4*)(gp + k) = (f32x4){ev[k] * inv, ev[k + 1] * inv, ev[k + 2] * inv, ev[k + 3] * inv};
        }
        asm volatile("s_waitcnt lgkmcnt(0)" ::: "memory");
    }
}
}

#define XB_TMO      128
#define XB_XCNT(j)  (256  + 64 * (j))
#define XB_XSUB(j)  (1280 + 64 * (j))
#define XB_XGEN(j)  (2304 + 64 * (j))
#define XB_TOP      3328
#define XB_TOPGEN   3392
#define XCD_BAR_WORDS 3456
#define XB_SPIN_CAP (1u << 18)
__device__ __forceinline__ unsigned xb_ld(unsigned* p)              { return __hip_atomic_load(p, __ATOMIC_RELAXED, __HIP_MEMORY_SCOPE_AGENT); }
__device__ __forceinline__ unsigned xb_add(unsigned* p, unsigned v) { return __hip_atomic_fetch_add(p, v, __ATOMIC_RELAXED, __HIP_MEMORY_SCOPE_AGENT); }
__device__ __forceinline__ unsigned xb_xcc_id() { return (unsigned)__builtin_amdgcn_s_getreg((3 << 11) | 20) & 0xFu; }
#define XB_SPIN(cond, bar) do { unsigned _sp = 0; while (cond) { __builtin_amdgcn_s_sleep(1); \
    if ((++_sp & 255u) == 0u) { if (xb_ld(&(bar)[XB_TMO])) break; if (_sp > XB_SPIN_CAP) { atomicAdd(&(bar)[XB_TMO], 1u); break; } } } } while (0)
struct XcdBarrier { unsigned* bar; unsigned x; volatile LAS unsigned* st; };
__device__ __forceinline__ XcdBarrier xcd_barrier_post(unsigned* bar, volatile LAS unsigned* st) {
    XcdBarrier b; b.bar = bar; b.x = xb_xcc_id(); b.st = st;
    if (threadIdx.x == 0) (void)xb_add(&bar[XB_XCNT(b.x)], 1u);
    return b;
}
__device__ __forceinline__ void xcd_barrier_complete(unsigned* bar, unsigned x, unsigned& nloc, unsigned& nx) {
    const unsigned G = gridDim.x * gridDim.y * gridDim.z;
    unsigned sum, cnt, mine, sp = 0u;
    for (;;) {
        sum = 0u; cnt = 0u; mine = 0u;
#pragma unroll
        for (unsigned j = 0; j < 16; ++j) { const unsigned c = xb_ld(&bar[XB_XCNT(j)]); sum += c; cnt += (c > 0u) ? 1u : 0u; mine = (j == x) ? c : mine; }
        if (sum == G) break;
        __builtin_amdgcn_s_sleep(1);
        if ((++sp & 255u) == 0u) { if (xb_ld(&bar[XB_TMO])) break; if (sp > XB_SPIN_CAP) { atomicAdd(&bar[XB_TMO], 1u); break; } }
    }
    nloc = mine > 0u ? mine : 1u; nx = cnt > 0u ? cnt : 1u;
}
__device__ __forceinline__ void xcd_barrier(const XcdBarrier& b) {
    asm volatile("s_waitcnt vmcnt(0)" ::: "memory");
    __syncthreads();
    if (threadIdx.x == 0) {
        unsigned* bar = b.bar;
        __builtin_amdgcn_s_waitcnt(0);
        unsigned nloc = b.st[0], nx = b.st[1];
        if (nloc == 0u) { xcd_barrier_complete(bar, b.x, nloc, nx); b.st[0] = nloc; b.st[1] = nx; }
        const unsigned old = xb_add(&bar[XB_XSUB(b.x)], 1u);
        const unsigned gen = old / nloc;
        if (old + 1u == (gen + 1u) * nloc) {
            __builtin_amdgcn_fence(__ATOMIC_RELEASE, "agent");
            asm volatile("s_waitcnt vmcnt(0)" ::: "memory");
            const unsigned og = xb_add(&bar[XB_TOP], 1u);
            const unsigned tg = og / nx;
            if (og + 1u == (tg + 1u) * nx) xb_add(&bar[XB_TOPGEN], 1u);
            else XB_SPIN(xb_ld(&bar[XB_TOPGEN]) == tg, bar);
            __builtin_amdgcn_fence(__ATOMIC_ACQUIRE, "agent");
            xb_add(&bar[XB_XGEN(b.x)], 1u);
            asm volatile("s_waitcnt vmcnt(0)" ::: "memory");
        } else {
            XB_SPIN(xb_ld(&bar[XB_XGEN(b.x)]) == gen, bar);
            __builtin_amdgcn_fence(__ATOMIC_ACQUIRE, "agent");
            asm volatile("s_waitcnt vmcnt(0)" ::: "memory");
        }
    }
    __syncthreads();
}

namespace sg {
constexpr int NSL = 16, SLW = 128, TBK = 32, NTB = MTOK / TBK;
constexpr int CW_U = 8192, CW_V = 8192 + 64 * NSL;
template <int D> __device__ __forceinline__ float xsl(float a, float b, bool bit, int ln) { const float send = bit ? a : b, keep = bit ? b : a;
    return keep + __builtin_bit_cast(float, __builtin_amdgcn_ds_bpermute((ln ^ D) << 2, __builtin_bit_cast(int, send))); }
template <int D> __device__ __forceinline__ float xs(float a, float b, bool bit) { const float send = bit ? a : b, keep = bit ? b : a; return keep + __shfl_xor(send, D); }
__device__ __forceinline__ void quant_rows(const Args& A, int G) {
    const int tid = otid(), lane = tid & 63, wave = __builtin_amdgcn_readfirstlane(tid >> 6);
    unsigned char* ws = A.ws; const bf16_t* H2G = (const bf16_t*)(ws + WS_XN); const float* PARTSS = (const float*)(ws + WS_PARTSS);
    const int NW = G * NWAVES;
    for (int r0 = blockIdx.x * NWAVES + wave; r0 < MTOK; r0 += 4 * NW) {
        u32x4 hb[4][4]; float ssq[4];
#pragma unroll
        for (int q = 0; q < 4; ++q) { const int r = r0 + q * NW; const bool ok = r < MTOK; const u32x4* hp = (const u32x4*)(H2G + (size_t)(ok ? r : r0) * DM) + lane;
#pragma unroll
            for (int j = 0; j < 4; ++j) hb[q][j] = hp[64 * j];
            ssq[q] = (lane < 32) ? PARTSS[(size_t)lane * MTOK + (ok ? r : r0)] : 0.f; }
        asm volatile("" ::: "memory");
#pragma unroll
        for (int q = 0; q < 4; ++q) {
            const int r = r0 + q * NW; if (r >= MTOK) break;
            const float rs = rsqrtf(wave_sum(ssq[q]) * (1.0f / DM) + EPS);
            float hm = 0.f;
#pragma unroll
            for (int j = 0; j < 4; ++j) { hm = fmaxf(hm, fmaxf(fmaxf(fabsf(bflo(hb[q][j].x)), fabsf(bfhi(hb[q][j].x))), fmaxf(fabsf(bflo(hb[q][j].y)), fabsf(bfhi(hb[q][j].y)))));
                hm = fmaxf(hm, fmaxf(fmaxf(fabsf(bflo(hb[q][j].z)), fabsf(bfhi(hb[q][j].z))), fmaxf(fabsf(bflo(hb[q][j].w)), fabsf(bfhi(hb[q][j].w))))); }
            hm = wave_max(hm);
            const float hinv = hm > 0.f ? 127.0f / hm : 0.f;
            u32x2* dst = (u32x2*)(ws + WS_HQ + (size_t)r * DM) + lane;
#pragma unroll
            for (int j = 0; j < 4; ++j) { const unsigned wd[4] = {hb[q][j].x, hb[q][j].y, hb[q][j].z, hb[q][j].w}; u32x2 o;
#pragma unroll
                for (int h2 = 0; h2 < 2; ++h2) { const int q0 = (int)rintf(bflo(wd[2 * h2]) * hinv), q1 = (int)rintf(bfhi(wd[2 * h2]) * hinv), q2 = (int)rintf(bflo(wd[2 * h2 + 1]) * hinv), q3 = (int)rintf(bfhi(wd[2 * h2 + 1]) * hinv);
                    const unsigned pk = (unsigned)(q0 & 255) | ((unsigned)(q1 & 255) << 8) | ((unsigned)(q2 & 255) << 16) | ((unsigned)(q3 & 255) << 24); if (h2 == 0) o.x = pk; else o.y = pk; }
                dst[64 * j] = o; }
            if (lane == 0) ((float*)(ws + WS_HT))[r] = hm * (1.0f / 127.0f) * rs;
        }
    }
}
template <int NCOL>
__device__ __forceinline__ void quant_pass(const bf16_t* src, unsigned char* dst, float* sc, int G) {
    const int tid = otid(), lane = tid & 63, wave = __builtin_amdgcn_readfirstlane(tid >> 6);
    constexpr int NL = NCOL / 512;
    const int NW = G * NWAVES;
    for (int r0 = blockIdx.x * NWAVES + wave; r0 < MTOK; r0 += 4 * NW) {
        u32x4 hb[4][NL];
#pragma unroll
        for (int q = 0; q < 4; ++q) { const int r = r0 + q * NW; const bool ok = r < MTOK; const u32x4* hp = (const u32x4*)(src + (size_t)(ok ? r : r0) * NCOL) + lane;
#pragma unroll
            for (int j = 0; j < NL; ++j) hb[q][j] = hp[64 * j]; }
        asm volatile("" ::: "memory");
#pragma unroll
        for (int q = 0; q < 4; ++q) {
            const int r = r0 + q * NW; if (r >= MTOK) break;
            float hm = 0.f;
#pragma unroll
            for (int j = 0; j < NL; ++j) { hm = fmaxf(hm, fmaxf(fmaxf(fabsf(bflo(hb[q][j].x)), fabsf(bfhi(hb[q][j].x))), fmaxf(fabsf(bflo(hb[q][j].y)), fabsf(bfhi(hb[q][j].y)))));
                hm = fmaxf(hm, fmaxf(fmaxf(fabsf(bflo(hb[q][j].z)), fabsf(bfhi(hb[q][j].z))), fmaxf(fabsf(bflo(hb[q][j].w)), fabsf(bfhi(hb[q][j].w))))); }
            hm = wave_max(hm);
            const float hinv = hm > 0.f ? 127.0f / hm : 0.f;
            u32x2* d = (u32x2*)(dst + (size_t)r * NCOL) + lane;
#pragma unroll
            for (int j = 0; j < NL; ++j) { const unsigned wd[4] = {hb[q][j].x, hb[q][j].y, hb[q][j].z, hb[q][j].w}; u32x2 o;
#pragma unroll
                for (int h2 = 0; h2 < 2; ++h2) { const int q0 = (int)rintf(bflo(wd[2 * h2]) * hinv), q1 = (int)rintf(bfhi(wd[2 * h2]) * hinv), q2 = (int)rintf(bflo(wd[2 * h2 + 1]) * hinv), q3 = (int)rintf(bfhi(wd[2 * h2 + 1]) * hinv);
                    const unsigned pk = (unsigned)(q0 & 255) | ((unsigned)(q1 & 255) << 8) | ((unsigned)(q2 & 255) << 16) | ((unsigned)q3 << 24); if (h2 == 0) o.x = pk; else o.y = pk; }
                d[64 * j] = o; }
            if (lane == 0) sc[r] = hm * (1.0f / 127.0f);
        }
    }
}
__device__ __forceinline__ bool pop_item(unsigned* ctr, int xcd, int& si, int& slice, int& tb, volatile LAS int* bc) {
    for (;;) {
        if (si >= NSL) return false;
        const int s = (2 * xcd + si) & (NSL - 1);
        __syncthreads();
        if (threadIdx.x == 0) { const int pre = bc[1]; bc[0] = pre >= 0 ? pre : (int)__hip_atomic_fetch_add(ctr + 64 * s, 1u, __ATOMIC_RELAXED, __HIP_MEMORY_SCOPE_AGENT); bc[1] = -1; }
        __syncthreads();
        const int t = bc[0];
        if (t < NTB) { slice = s; tb = t;
            if (threadIdx.x == 0) bc[1] = (int)__hip_atomic_fetch_add(ctr + 64 * s, 1u, __ATOMIC_RELAXED, __HIP_MEMORY_SCOPE_AGENT);
            return true; }
        ++si;
    }
}
__device__ __forceinline__ void upass_phase(const Args& A, LAS unsigned char* lds, int G) {
    const int tid = otid(), lane = tid & 63, wave = __builtin_amdgcn_readfirstlane(tid >> 6), sub = lane >> 3, piece = lane & 7;
    unsigned char* ws = A.ws; const unsigned char* UQ = ws + WS_UE; const unsigned char* HQ = ws + WS_HQ; const int* IDX = (const int*)(ws + WS_IDX); float* AP = (float*)(ws + WS_APART);
    const bool b0 = (lane & 1) != 0, b1 = (lane & 2) != 0, b2 = (lane & 4) != 0;
    const int j0 = (b2 ? 2 : 0) + (b1 ? 4 : 0) + (b0 ? 8 : 0);
    const int xcd = (int)(xb_xcc_id() & 7u); int si = 0, slice, tb;
    volatile LAS int* bc = (volatile LAS int*)(lds + LDS_BYTES - 128);
    if (threadIdx.x == 0) bc[1] = -1;
    LAS unsigned* sidx = (LAS unsigned*)(lds + 16384 + wave * 4096);
    LAS u32x4* shq = (LAS u32x4*)(lds + 16384 + wave * 4096 + 2048);
    while (pop_item((unsigned*)(ws + WS_CTL) + CW_U, xcd, si, slice, tb, bc)) {
        { const int t0 = tb * TBK + wave;
#pragma unroll
          for (int i = 0; i < 4; ++i) { const u32x2 v = *((const u32x2*)(IDX + (size_t)(t0 + NWAVES * i) * 128) + lane); *(LAS u32x2*)(sidx + i * 128 + 2 * lane) = v; }
          if (lane < 32) { const int i = lane >> 3, pc = lane & 7; shq[lane] = *(const u32x4*)(HQ + (size_t)(t0 + NWAVES * i) * DM + slice * SLW + 16 * pc); }
          asm volatile("s_waitcnt vmcnt(0) lgkmcnt(0)" ::: "memory"); }
#define UP_G(buf, I, H) do { const u32x4 i0_ = *(const LAS u32x4*)(sidx + (I) * 128 + 16 * sub + 8 * (H)), i1_ = *(const LAS u32x4*)(sidx + (I) * 128 + 16 * sub + 8 * (H) + 4); \
            const unsigned ex_[8] = {i0_.x, i0_.y, i0_.z, i0_.w, i1_.x, i1_.y, i1_.z, i1_.w}; \
            _Pragma("unroll") for (int j_ = 0; j_ < 8; ++j_) buf[j_] = *(const u32x4*)(UQ + (size_t)ex_[j_] * DM + slice * SLW + 16 * piece); \
            asm volatile("" ::: "memory"); } while (0)
#define UP_C(vv, buf, I) do { const u32x4 hq_ = shq[(I) * 8 + piece]; _Pragma("unroll") for (int j_ = 0; j_ < 8; ++j_) { \
            int sd_ = __builtin_amdgcn_sdot4((int)buf[j_].x, (int)hq_.x, 0, false); sd_ = __builtin_amdgcn_sdot4((int)buf[j_].y, (int)hq_.y, sd_, false); \
            sd_ = __builtin_amdgcn_sdot4((int)buf[j_].z, (int)hq_.z, sd_, false); sd_ = __builtin_amdgcn_sdot4((int)buf[j_].w, (int)hq_.w, sd_, false); vv[j_] = (float)sd_; } } while (0)
#define UP_F(I) do { float w8_[8], w4_[4], w2_[2]; \
            _Pragma("unroll") for (int q_ = 0; q_ < 8; ++q_) w8_[q_] = xs<1>(vlo[q_], vhi[q_], b0); \
            _Pragma("unroll") for (int q_ = 0; q_ < 4; ++q_) w4_[q_] = xs<2>(w8_[q_], w8_[q_ + 4], b1); \
            _Pragma("unroll") for (int q_ = 0; q_ < 2; ++q_) w2_[q_] = xs<4>(w4_[q_], w4_[q_ + 2], b2); \
            *(f32x2*)(AP + ((size_t)slice * MTOK + tb * TBK + wave + NWAVES * (I)) * 128 + 16 * sub + j0) = (f32x2){w2_[0], w2_[1]}; } while (0)
        { u32x4 bufA[8], bufB[8]; float vlo[8], vhi[8];
          UP_G(bufA, 0, 0); UP_G(bufB, 0, 1);
          UP_C(vlo, bufA, 0); UP_G(bufA, 1, 0);
          UP_C(vhi, bufB, 0); UP_G(bufB, 1, 1); UP_F(0);
          UP_C(vlo, bufA, 1); UP_G(bufA, 2, 0);
          UP_C(vhi, bufB, 1); UP_G(bufB, 2, 1); UP_F(1);
          UP_C(vlo, bufA, 2); UP_G(bufA, 3, 0);
          UP_C(vhi, bufB, 2); UP_G(bufB, 3, 1); UP_F(2);
          UP_C(vlo, bufA, 3);
          UP_C(vhi, bufB, 3); UP_F(3); }
#undef UP_G
#undef UP_C
#undef UP_F
    }
}
__device__ __forceinline__ void combine_phase(const Args& A, int G) {
    const int tid = otid(), lane = tid & 63, wave = __builtin_amdgcn_readfirstlane(tid >> 6);
    unsigned char* ws = A.ws; const float* AP = (const float*)(ws + WS_APART); const int* IDX = (const int*)(ws + WS_IDX); float* GW = (float*)(ws + WS_GW);
    const float* SU = (const float*)(ws + WS_SU); const float* SV = (const float*)(ws + WS_SV); const float* HT = (const float*)(ws + WS_HT);
    for (int tok = blockIdx.x * NWAVES + wave; tok < MTOK; tok += G * NWAVES) {
        const float tsc = HT[tok];
#pragma unroll
        for (int hf = 0; hf < 2; ++hf) { const int k = lane + 64 * hf; float a = 0.f;
#pragma unroll
            for (int sl = 0; sl < NSL; ++sl) a += __builtin_nontemporal_load(AP + ((size_t)sl * MTOK + tok) * 128 + k);
            const int e = IDX[(size_t)tok * 128 + k];
            GW[(size_t)tok * 128 + k] = GW[(size_t)tok * 128 + k] * gelu_exact(a * SU[e] * tsc) * SV[e]; }
    }
}
__device__ __forceinline__ void vpass_phase(const Args& A, LAS unsigned char* lds, int G) {
    const int tid = otid(), lane = tid & 63, wave = __builtin_amdgcn_readfirstlane(tid >> 6);
    unsigned char* ws = A.ws; const unsigned char* VQ = ws + WS_VE; const int* IDX = (const int*)(ws + WS_IDX); const float* GW = (const float*)(ws + WS_GW);
    const bf16_t* H2B = (const bf16_t*)(ws + WS_XN); float* OUT = A.out;
    const int xcd = (int)(xb_xcc_id() & 7u); int si = 0, slice, tb;
    volatile LAS int* bc = (volatile LAS int*)(lds + LDS_BYTES - 128);
    if (threadIdx.x == 0) bc[1] = -1;
    LAS unsigned* sidx = (LAS unsigned*)(lds + 16384 + wave * 4096);
    LAS float* sw = (LAS float*)(lds + 16384 + wave * 4096 + 2048);
    while (pop_item((unsigned*)(ws + WS_CTL) + CW_V, xcd, si, slice, tb, bc)) {
        int ln = (int)threadIdx.x; asm volatile("" : "+v"(ln)); ln &= 63;
        const int sub = ln >> 3, piece = ln & 7; const bool b3 = (ln & 8) != 0, b4 = (ln & 16) != 0, b5 = (ln & 32) != 0;
        const int c0 = (b5 ? 2 : 0) + (b4 ? 4 : 0) + (b3 ? 8 : 0);
        { const int t0 = tb * TBK + wave;
#pragma unroll
          for (int i = 0; i < 4; ++i) { const u32x2 v = *((const u32x2*)(IDX + (size_t)(t0 + NWAVES * i) * 128) + ln); *(LAS u32x2*)(sidx + i * 128 + 2 * ln) = v;
              const f32x2 g = *((const f32x2*)(GW + (size_t)(t0 + NWAVES * i) * 128) + ln); *(LAS f32x2*)(sw + i * 128 + 2 * ln) = g; }
          asm volatile("s_waitcnt vmcnt(0) lgkmcnt(0)" ::: "memory"); }
        const unsigned colb = (unsigned)(slice * SLW + 16 * piece);
#define VP_G(buf, I, H) do { const u32x4 i0_ = *(const LAS u32x4*)(sidx + (I) * 128 + 16 * sub + 8 * (H)), i1_ = *(const LAS u32x4*)(sidx + (I) * 128 + 16 * sub + 8 * (H) + 4); \
            const unsigned ex_[8] = {i0_.x, i0_.y, i0_.z, i0_.w, i1_.x, i1_.y, i1_.z, i1_.w}; \
            _Pragma("unroll") for (int j_ = 0; j_ < 8; ++j_) buf[j_] = *(const u32x4*)(VQ + (ex_[j_] * (unsigned)DM + colb)); \
            asm volatile("" ::: "memory"); } while (0)
#define VP_H(hv, I) do { hv = *(const unsigned*)((const unsigned char*)H2B + (((unsigned)(tb * TBK + wave + NWAVES * (I)) * (unsigned)DM + colb + c0) * 2u)); asm volatile("" ::: "memory"); } while (0)
#define VP_C(buf, I, H) do { const f32x4 w0_ = *(const LAS f32x4*)(sw + (I) * 128 + 16 * sub + 8 * (H)), w1_ = *(const LAS f32x4*)(sw + (I) * 128 + 16 * sub + 8 * (H) + 4); \
            const float wk_[8] = {w0_[0], w0_[1], w0_[2], w0_[3], w1_[0], w1_[1], w1_[2], w1_[3]}; \
            _Pragma("unroll") for (int j_ = 0; j_ < 8; ++j_) { const unsigned wd_[4] = {buf[j_].x, buf[j_].y, buf[j_].z, buf[j_].w}; \
                _Pragma("unroll") for (int d_ = 0; d_ < 4; ++d_) { const f32x2 lo_ = __builtin_amdgcn_cvt_pk_f32_fp8((int)wd_[d_], false), hi_ = __builtin_amdgcn_cvt_pk_f32_fp8((int)wd_[d_], true); \
                    acc[4 * d_] += wk_[j_] * lo_.x; acc[4 * d_ + 1] += wk_[j_] * lo_.y; acc[4 * d_ + 2] += wk_[j_] * hi_.x; acc[4 * d_ + 3] += wk_[j_] * hi_.y; } } } while (0)
#define VP_F(hv, I) do { float w8_[8], w4_[4], w2_[2]; \
            _Pragma("unroll") for (int q_ = 0; q_ < 8; ++q_) w8_[q_] = xsl<8>(acc[q_], acc[q_ + 8], b3, ln); \
            _Pragma("unroll") for (int q_ = 0; q_ < 4; ++q_) w4_[q_] = xsl<16>(w8_[q_], w8_[q_ + 4], b4, ln); \
            _Pragma("unroll") for (int q_ = 0; q_ < 2; ++q_) w2_[q_] = xsl<32>(w4_[q_], w4_[q_ + 2], b5, ln); \
            *(f32x2*)((unsigned char*)OUT + (((unsigned)(tb * TBK + wave + NWAVES * (I)) * (unsigned)DM + colb + c0) * 4u)) = (f32x2){bflo(hv) + w2_[0], bfhi(hv) + w2_[1]}; \
            _Pragma("unroll") for (int c_ = 0; c_ < 16; ++c_) acc[c_] = 0.f; } while (0)
        { u32x4 bufA[8], bufB[8]; unsigned hv; float acc[16];
#pragma unroll
          for (int c = 0; c < 16; ++c) acc[c] = 0.f;
          VP_G(bufA, 0, 0); VP_G(bufB, 0, 1);
          VP_C(bufA, 0, 0); VP_G(bufA, 1, 0);
          VP_C(bufB, 0, 1); VP_H(hv, 0); VP_G(bufB, 1, 1); VP_F(hv, 0);
          VP_C(bufA, 1, 0); VP_G(bufA, 2, 0);
          VP_C(bufB, 1, 1); VP_H(hv, 1); VP_G(bufB, 2, 1); VP_F(hv, 1);
          VP_C(bufA, 2, 0); VP_G(bufA, 3, 0);
          VP_C(bufB, 2, 1); VP_H(hv, 2); VP_G(bufB, 3, 1); VP_F(hv, 2);
          VP_C(bufA, 3, 0);
          VP_C(bufB, 3, 1); VP_H(hv, 3); VP_F(hv, 3); }
#undef VP_G
#undef VP_H
#undef VP_C
#undef VP_F
    }
}
}


#ifndef GATHER_VER
#define GATHER_VER 2
#endif
constexpr int NPHASE = (GATHER_VER == 2) ? 10 : 8;
__global__ void __launch_bounds__(NTHREADS, 2) mega_fwd(Args args) {
    extern __shared__ __attribute__((aligned(16))) unsigned char lds_raw[];
    LAS unsigned char* lds = (LAS unsigned char*)lds_raw;
    const int G = gridDim.x;
    unsigned char* ws = args.ws;
    const int lo = args.ph_lo, hi = args.ph_hi;
#ifndef PHASE_MASK
#define PHASE_MASK 0x3FF
#endif
#ifndef REPEAT_MASK
#define REPEAT_MASK 0x00
#endif
#define NREP(k) (((REPEAT_MASK >> (k)) & 1) ? 2 : 1)
#define IN(k) (lo <= (k) && (k) < hi && ((PHASE_MASK >> (k)) & 1))
#ifndef CG_SEAMS
#define CG_SEAMS 0
#endif
    volatile LAS unsigned* xst = (volatile LAS unsigned*)(lds + LDS_BYTES - 64);
    if (threadIdx.x < 2) xst[threadIdx.x] = 0u;
    __syncthreads();
    XcdBarrier xbar = xcd_barrier_post((unsigned*)(ws + WS_CTL) + 64, xst);
#define SEAM_IN(k) do { if (IN(k)) { if (CG_SEAMS) cg::this_grid().sync(); else xcd_barrier(xbar); } } while (0)
#define SEAM(k) do { if (IN(k) && IN((k) + 1)) { if (CG_SEAMS) cg::this_grid().sync(); else xcd_barrier(xbar); } } while (0)
    if (IN(0)) for (int rep_ = 0; rep_ < NREP(0); ++rep_) { p0_prologue<0>(args, lds, G, args.probe); }
    SEAM(0);
    if (IN(1)) for (int rep_ = 0; rep_ < NREP(1); ++rep_) {
        p1_meta_finish(args, lds, G);
        __syncthreads();
        pg8::Gemm g{(const bf16_t*)(ws + WS_XN), (const bf16_t*)(ws + WS_WTIN), MTOK, INW, DM / 2, nullptr, nullptr, (const float*)(ws + WS_SXA), (const float*)(ws + WS_SWB)}; pg8::StaticOrder S; S.init(MTOK, INW, G, (int)blockIdx.x);
        Epi1 E{(bf16_t*)(ws + WS_Q), (bf16_t*)(ws + WS_K), (bf16_t*)(ws + WS_V), (bf16_t*)(ws + WS_GA), (bf16_t*)(ws + WS_GB), nullptr, (const float*)(ws + WS_CS), args.in[I_QNG], args.in[I_KNG], (bf16_t*)(ws + WS_UB)};
        pg8::gemm_phase<Epi1, pg8::StaticOrder, true, GEMM_SP2>(lds, g, S, E);
    }
    SEAM(1);
    if (IN(2)) for (int rep_ = 0; rep_ < NREP(2); ++rep_) {
#ifndef REP_SSM
#define REP_SSM 1
#endif
#ifndef REP_ATT
#define REP_ATT 1
#endif
        if (args.probe == 0 && blockIdx.x >= 128) p0_prologue<1>(args, lds, G, 0);
        if (args.probe != 2) for (int q_ = 0; q_ < REP_SSM; ++q_) ssm::ssm_mm_phase(args, lds, G, args.probe);
        __syncthreads();
        if (args.probe == 0 || args.probe == 2) for (int q_ = 0; q_ < REP_ATT; ++q_) att::attn_phase(args, lds, G);
    }
    SEAM(2);
    if (IN(3)) {
        sg::quant_pass<SW>((const bf16_t*)(ws + WS_YS), ws + WS_YS8, (float*)(ws + WS_SYS), G);
        sg::quant_pass<AW>((const bf16_t*)(ws + WS_ATT), ws + WS_AT8, (float*)(ws + WS_SAT), G);
        SEAM_IN(3);
    }
    if (IN(3)) for (int rep_ = 0; rep_ < NREP(3); ++rep_) {
        pg8::Gemm g{(const bf16_t*)(ws + WS_YS8), (const bf16_t*)(ws + WS_WTGLU), MTOK, 2 * DM, SW / 2, (const bf16_t*)(ws + WS_AT8), (const bf16_t*)(ws + WS_WTATT),
                    (const float*)(ws + WS_SYS), (const float*)(ws + WS_SWG), (const float*)(ws + WS_SAT), (const float*)(ws + WS_SWA)};
        pg8::P3Order S; S.base.init(MTOK, DM, G, (int)blockIdx.x);
        EpiP3 E{EpiGlu{(const bf16_t*)(ws + WS_GB), (bf16_t*)(ws + WS_YB)}, EpiMix{(const bf16_t*)(ws + WS_GA), (const bf16_t*)(ws + WS_YB), (bf16_t*)(ws + WS_MIX)}};
        pg8::gemm_phase<EpiP3, pg8::P3Order, true, GEMM_SP2>(lds, g, S, E);
    }
    SEAM(3);
    if (IN(4)) { sg::quant_pass<DM>((const bf16_t*)(ws + WS_MIX), ws + WS_MIX8, (float*)(ws + WS_SMX), G); SEAM_IN(4); }
    if (IN(4)) for (int rep_ = 0; rep_ < NREP(4); ++rep_) {
        pg8::Gemm g{(const bf16_t*)(ws + WS_MIX8), (const bf16_t*)(ws + WS_WTOUT), MTOK, DM, DM / 2, nullptr, nullptr, (const float*)(ws + WS_SMX), (const float*)(ws + WS_SWO)}; pg8::StaticOrder S; S.init(MTOK, DM, G, (int)blockIdx.x);
        EpiOut E{args.in[I_X], (bf16_t*)(ws + WS_XN), (float*)(ws + WS_PARTSS)};
        pg8::gemm_phase<EpiOut, pg8::StaticOrder, true, GEMM_SP2>(lds, g, S, E);
    }
    SEAM(4);
    if (IN(6)) { sg::quant_rows(args, G); }
    SEAM(5);
    if (IN(5)) for (int rep_ = 0; rep_ < NREP(5); ++rep_) {
        pg8::Gemm g{(const bf16_t*)(ws + WS_HQ), (const bf16_t*)(ws + WS_WTQ), MTOK, DM, DM / 2, nullptr, nullptr, (const float*)(ws + WS_HT), (const float*)(ws + WS_SWQ)}; pg8::StaticOrder S; S.init(MTOK, DM, G, (int)blockIdx.x);
        const bool qlds = (G == MTOK / 256 * (DM / 256));
        EpiQP E{(bf16_t*)(ws + WS_QP), lds, qlds};
        pg8::gemm_phase<EpiQP, pg8::StaticOrder, true, GEMM_SP2>(lds, g, S, E);
        asm volatile("s_waitcnt vmcnt(0)" ::: "memory");
        __syncthreads();
        tk::peer_topk_phase(args, lds, G, qlds);
    }
    SEAM(6);
#if GATHER_VER == 2
    if (IN(7)) { sg::upass_phase(args, lds, G); }
    SEAM(7);
    if (IN(8)) for (int rep_ = 0; rep_ < NREP(8); ++rep_) { sg::combine_phase(args, G); }
    SEAM(8);
    if (IN(9)) { sg::vpass_phase(args, lds, G); }
#endif
#undef IN
#undef SEAM
}

extern "C" void kernel_launch(void* const* d_in, const int* in_sizes, int n_in, void* d_out, int out_size, void* d_ws, size_t ws_size, hipStream_t stream) {
    static int grid = 0;
    if (grid == 0) {
        if (n_in != 28 || out_size != MTOK * DM || ws_size < WS_END) { fprintf(stderr, "kernel_launch: unexpected problem (n_in %d out %d ws %zu, need %zu)\n", n_in, out_size, ws_size, (size_t)WS_END); grid = -1; return; }
        int dev = 0, cus = 0, per_cu = 0;
        (void)hipGetDevice(&dev); (void)hipDeviceGetAttribute(&cus, hipDeviceAttributeMultiprocessorCount, dev);
        if (hipFuncSetAttribute((const void*)mega_fwd, hipFuncAttributeMaxDynamicSharedMemorySize, LDS_BYTES) != hipSuccess) { fprintf(stderr, "kernel_launch: hipFuncSetAttribute failed\n"); grid = -1; return; }
        (void)hipOccupancyMaxActiveBlocksPerMultiprocessor(&per_cu, (const void*)mega_fwd, NTHREADS, LDS_BYTES);
        (void)hipGetLastError();
        if (per_cu < 1) { fprintf(stderr, "kernel_launch: occupancy query says %d blocks/CU\n", per_cu); per_cu = 1; }
        if (cus < 192) { fprintf(stderr, "kernel_launch: needs >= 192 CUs (SSM items on workgroups 0..127, deferred prologue work on the rest)\n"); grid = -1; return; }
        grid = cus;
        fprintf(stderr, "kernel_launch: grid %d (cus %d, per_cu %d), ws %zu MiB\n", grid, cus, per_cu, ws_size >> 20);
    }
    if (grid < 0) return;
    if (hipMemsetAsync((char*)d_ws + WS_CTL, 0, 64 * 1024, stream) != hipSuccess) { fprintf(stderr, "kernel_launch: memset of the control words failed\n"); return; }
    Args a{};
    for (int i = 0; i < 28; ++i) a.in[i] = (const float*)d_in[i];
    a.out = (float*)d_out; a.ws = (unsigned char*)d_ws;
#if MK_SINGLE
    a.ph_lo = 0; a.ph_hi = NPHASE;
    void* kargs[] = {&a};
    hipError_t e = hipLaunchCooperativeKernel((const void*)mega_fwd, dim3(grid), dim3(NTHREADS), kargs, LDS_BYTES, stream);
    if (e != hipSuccess) fprintf(stderr, "cooperative launch failed: %s (grid %d)\n", hipGetErrorString(e), grid);
#else
#ifndef PROBE_PHASE
#define PROBE_PHASE -1
#endif
    for (int p = 0; p < NPHASE; ++p) {
        a.ph_lo = p; a.ph_hi = p + 1;
#ifndef PROBE_SUB
#define PROBE_SUB 0
#endif
        for (int rep = 0; rep < (p == PROBE_PHASE ? 2 : 1); ++rep) { a.probe = (rep == 1) ? PROBE_SUB : 0;
            if (rep == 1) (void)hipMemsetAsync((char*)d_ws + WS_CTL + 32768, 0, 16384, stream);
            hipLaunchKernelGGL(mega_fwd, dim3(grid), dim3(NTHREADS), LDS_BYTES, stream, a); }
    }
#endif
}
```

```cpp
#include <hip/hip_runtime.h>
#include <hip/hip_cooperative_groups.h>
#include <cstdio>
#include <cstdint>
namespace cg = cooperative_groups;

#ifndef GEMM_SP2
#define GEMM_SP2 true
#endif
#ifndef MK_SINGLE
#define MK_SINGLE 1
#endif

#define LAS __attribute__((address_space(3)))
typedef unsigned short bf16_t;
typedef short bf16x8 __attribute__((ext_vector_type(8)));
typedef float f32x4 __attribute__((ext_vector_type(4)));
typedef float f32x2 __attribute__((ext_vector_type(2)));
typedef unsigned u32x4 __attribute__((ext_vector_type(4)));
typedef int i32x4 __attribute__((ext_vector_type(4)));
typedef unsigned u32x2 __attribute__((ext_vector_type(2)));
typedef __bf16 bf16x2_t __attribute__((ext_vector_type(2)));

constexpr int DM = 2048, SEQ = 4096, NMETA = 16, MTOK = 2 * SEQ, NPOS = SEQ + NMETA;
constexpr int AW = 1024, SW = 1024, INW = 8192;
constexpr float EPS = 1e-6f;
constexpr float LOG2E = 1.4426950408889634f;
constexpr float QSCALE = 0.125f * LOG2E;
constexpr float LAM_INIT = 0.2f;
constexpr int NEXP = 16384;

constexpr size_t MiB = 1u << 20;
constexpr size_t WS_CTL = 0;
constexpr size_t WS_WTIN = 1 * MiB;
constexpr size_t WS_WTATT = WS_WTIN + 32 * MiB;
constexpr size_t WS_WTGLU = WS_WTATT + 4 * MiB;
constexpr size_t WS_WTOUT = WS_WTGLU + 8 * MiB;
constexpr size_t WS_WTQ = WS_WTOUT + 8 * MiB;
constexpr size_t WS_UE = WS_WTQ + 8 * MiB;
constexpr size_t WS_VE = WS_UE + 64 * MiB;
constexpr size_t WS_XN = WS_VE + 64 * MiB;
constexpr size_t WS_Q = WS_XN + 32 * MiB;
constexpr size_t WS_K = WS_Q + 16 * MiB;
constexpr size_t WS_V = WS_K + 16 * MiB;
constexpr size_t WS_MIX = WS_Q;
constexpr size_t WS_U = WS_V + 16 * MiB;
constexpr size_t WS_QP = WS_U;
constexpr size_t WS_GA = WS_U + 32 * MiB;
constexpr size_t WS_GB = WS_GA + 32 * MiB;
constexpr size_t WS_ATT = WS_GB + 32 * MiB;
constexpr size_t WS_YS = WS_ATT + 16 * MiB;
constexpr size_t WS_YB = WS_YS + 16 * MiB;
constexpr size_t WS_IDX = WS_YB + 32 * MiB;
constexpr size_t WS_GW = WS_IDX + 4 * MiB;
constexpr size_t WS_MISC = WS_GW + 4 * MiB;
constexpr size_t WS_PARTSS = WS_MISC;
constexpr size_t WS_CS = WS_PARTSS + 1 * MiB;
constexpr size_t WS_MPART = WS_CS + 2 * MiB;
constexpr size_t WS_KM = WS_MPART + 2 * MiB;
constexpr size_t WS_VM = WS_KM + 128 * 1024;
constexpr size_t WS_UM = WS_VM + 128 * 1024;
constexpr size_t WS_ABAR = WS_UM + 64 * 1024;
constexpr size_t WS_BBAR = WS_ABAR + 32 * 1024;
constexpr size_t WS_PAR = WS_BBAR + 512 * 1024;
constexpr size_t WS_SU = WS_PAR + 64 * 1024;
constexpr size_t WS_SV = WS_SU + 64 * 1024;
constexpr size_t WS_K12 = WS_SV + 64 * 1024;
constexpr size_t WS_UMB = WS_K12 + 512 * 1024;
constexpr size_t WS_UB = WS_UMB + 64 * 1024;
constexpr size_t WS_HT = WS_UB + 16 * MiB;
constexpr size_t WS_MP32 = WS_HT + 64 * 1024;
constexpr size_t WS_SXA = WS_MP32 + 6 * MiB;
constexpr size_t WS_SWB = WS_SXA + 64 * 1024;
constexpr size_t WS_SWQ = WS_SWB + 64 * 1024;
constexpr size_t WS_SWG = WS_SWQ + 64 * 1024;
constexpr size_t WS_SWA = WS_SWG + 64 * 1024;
constexpr size_t WS_SWO = WS_SWA + 64 * 1024;
constexpr size_t WS_SYS = WS_SWO + 64 * 1024;
constexpr size_t WS_SAT = WS_SYS + 64 * 1024;
constexpr size_t WS_SMX = WS_SAT + 64 * 1024;
constexpr size_t WS_WB = WS_SMX + 64 * 1024;
constexpr size_t WS_QG = WS_WB + 2 * MiB;
constexpr size_t WS_END = WS_QG + 4 * MiB;
constexpr size_t WS_YS8 = WS_V;
constexpr size_t WS_AT8 = WS_V + 8 * MiB;
constexpr size_t WS_MIX8 = WS_V;
constexpr size_t WS_HQ = WS_ATT;
constexpr size_t WS_APART = WS_Q;
constexpr size_t WS_H2 = WS_GA;

__device__ __forceinline__ unsigned f2bf(float f) { unsigned u = __builtin_bit_cast(unsigned, f); return (u + 0x7fffu + ((u >> 16) & 1u)) >> 16; }
__device__ __forceinline__ unsigned pk2(float lo, float hi) { return f2bf(lo) | (f2bf(hi) << 16); }
__device__ __forceinline__ float bf2f(unsigned short h) { return __builtin_bit_cast(float, (unsigned)h << 16); }
__device__ __forceinline__ float bflo(unsigned w) { return __builtin_bit_cast(float, w << 16); }
__device__ __forceinline__ float bfhi(unsigned w) { return __builtin_bit_cast(float, w & 0xffff0000u); }
__device__ __forceinline__ int otid() { int t = threadIdx.x; asm volatile("" : "+v"(t)); return t; }
template <int CTRL> __device__ __forceinline__ float dpp_f(float v) { return __builtin_bit_cast(float, __builtin_amdgcn_update_dpp(0, __builtin_bit_cast(int, v), CTRL, 0xF, 0xF, true)); }
__device__ __forceinline__ float row_sum16(float v) { v += dpp_f<0x128>(v); v += dpp_f<0x124>(v); v += dpp_f<0x122>(v); v += dpp_f<0x121>(v); return v; }
__device__ __forceinline__ float wave_sum(float v) { v = row_sum16(v); v += __shfl_xor(v, 16); v += __shfl_xor(v, 32); return v; }
__device__ __forceinline__ float wave_max(float v) {
#pragma unroll
    for (int o = 1; o < 64; o <<= 1) v = fmaxf(v, __shfl_xor(v, o));
    return v;
}
__device__ __forceinline__ float sigmoidf_(float x) { return __builtin_amdgcn_rcpf(1.0f + __builtin_amdgcn_exp2f(x * -1.4426950408889634f)); }
__device__ __forceinline__ float gelu_exact(float x) { return 0.5f * x * (1.0f + erff(x * 0.70710678118654752f)); }
__device__ __forceinline__ float dot2bf(unsigned a, unsigned b, float acc) { return __builtin_amdgcn_fdot2_f32_bf16(__builtin_bit_cast(bf16x2_t, a), __builtin_bit_cast(bf16x2_t, b), acc, false); }

namespace pg8 {
#define PG8_LAS __attribute__((address_space(3)))
constexpr int BM = 256, BK = 64, HALF = 128, HTB = HALF * BK * 2, STAGE_BYTES = 8 * HTB, NXCD = 8, WGM = 8;
__host__ __device__ __forceinline__ int lds_byte(int r, int c) { const int st = (r >> 4) * 2 + (c >> 5), rr = r & 15, cc = c & 31, ob = rr * 64 + cc * 2; return st * 1024 + (ob ^ (((ob >> 9) & 1) << 5)); }
__host__ __device__ __forceinline__ void stage_rc(int b, int& R, int& C) { const int st = b / 1024, sb = b % 1024, swz = sb ^ (((sb >> 9) & 1) << 5); R = (st >> 1) * 16 + swz / 64; C = (st & 1) * 32 + (swz % 64) / 2; }
__host__ __device__ __forceinline__ int perm32(int rho) { const int n = rho >> 4, i = rho & 15; return 8 * (i >> 2) + 4 * n + (i & 3); }
struct Unit { int pm, pn, sel; };
struct Gemm { const bf16_t* A; const bf16_t* Bt; int M, N, K; const bf16_t* A2 = nullptr; const bf16_t* Bt2 = nullptr; const float* sa = nullptr; const float* sb = nullptr; const float* sa2 = nullptr; const float* sb2 = nullptr; };
struct StaticOrder {
    int nM, nN, nwg, G, c;
    __host__ __device__ __forceinline__ void init(int M, int N, int G_, int c_) { nM = M / BM; nN = N / BM; nwg = nM * nN; G = G_; c = c_; }
    __host__ __device__ __forceinline__ bool next(int i, Unit& u) const {
        const long L = (long)i * G + c; if (L >= nwg) return false;
        int wgid = (int)L; { const int q = nwg / NXCD, r = nwg % NXCD, xcd = wgid % NXCD, off = wgid / NXCD; wgid = (xcd < r ? xcd * (q + 1) : r * (q + 1) + (xcd - r) * q) + off; }
        const int nig = WGM * nN, gid = wgid / nig, fm = gid * WGM, gsz = (nM - fm) < WGM ? (nM - fm) : WGM;
        u.pm = fm + ((wgid % nig) % gsz); u.pn = (wgid % nig) / gsz; u.sel = 0; return true;
    }
    __device__ __forceinline__ void a_ready(const Unit&) const {}
    __device__ __forceinline__ void done(const Unit&) const {}
};
struct GluOrder {
    StaticOrder base;
    __device__ __forceinline__ bool next(int i, Unit& u) const { Unit b; if (!base.next(i >> 1, b)) return false; u.pm = b.pm; u.pn = 2 * b.pn + (i & 1); u.sel = 0; return true; }
    __device__ __forceinline__ void a_ready(const Unit&) const {}
    __device__ __forceinline__ void done(const Unit&) const {}
};

struct PanelOrder {
    StaticOrder base; int panel, pm, pn;
    __device__ __forceinline__ bool next(int i, Unit& u) const { if (!panel) return base.next(i, u); if (i) return false; u.pm = pm; u.pn = pn; u.sel = 0; return true; }
    __device__ __forceinline__ void a_ready(const Unit&) const {}
    __device__ __forceinline__ void done(const Unit&) const {}
};
struct P3Order {
    PanelOrder base;
    __device__ __forceinline__ bool next(int i, Unit& u) const { Unit b; const int r = i / 3, j = i - 3 * r; if (!base.next(r, b)) return false;
        u.pm = b.pm; u.pn = (j < 2) ? 2 * b.pn + j : b.pn; u.sel = (j == 2) ? 1 : 0; return true; }
    __device__ __forceinline__ void a_ready(const Unit&) const {}
    __device__ __forceinline__ void done(const Unit&) const {}
};
template <class Epi, class Sched, bool ALIGN_EPI = false, bool SP2 = false>
__device__ __forceinline__ void gemm_phase(PG8_LAS unsigned char* lds, const Gemm g, const Sched& S, const Epi& E) {
    const int tid = threadIdx.x, wid = __builtin_amdgcn_readfirstlane(tid >> 6), lane = tid & 63, wr = wid >> 2, wc = wid & 3, fr = lane & 15, fq = lane >> 4;
    const int K = g.K, nt = K / BK;
    unsigned voffA[2], voffB[2];
#pragma unroll
    for (int i = 0; i < 2; ++i) { int R, C; stage_rc(tid * 16 + i * 8192, R, C); const int Rb = Epi::PERM ? ((R & ~31) + perm32(R & 31)) : R;
        voffA[i] = (unsigned)(R * K + C) * 2u; voffB[i] = (unsigned)(Rb * K + C) * 2u; }
    const size_t kstep = (size_t)(BK * 2);
    const size_t hstep = (size_t)HALF * K * 2;
    const size_t tstep = 2 * hstep;
    const unsigned ldsw = (unsigned)wid * 1024u;
    const int aoff = lds_byte(wr * 64 + fr, fq * 8), boff = lds_byte(wc * 32 + fr, fq * 8);
#define PG8_SA(b, h) (((b) * 2 + (h)) * HTB)
#define PG8_SB(b, h) ((4 + (b) * 2 + (h)) * HTB)
#define PG8_STAGE(bufoff, gbase, voff) do { _Pragma("unroll") for (int _i = 0; _i < 2; ++_i) \
        __builtin_amdgcn_global_load_lds((const unsigned*)((const char*)(gbase) + (voff)[_i]), (PG8_LAS unsigned*)(lds + (bufoff) + ldsw + _i * 8192), 16, 0, 0); } while (0)
#define PG8_LDA(dst, b, h) do { _Pragma("unroll") for (int m = 0; m < 4; ++m) _Pragma("unroll") for (int k = 0; k < 2; ++k) dst[m][k] = *(const PG8_LAS bf16x8*)(lds + PG8_SA(b, h) + aoff + m * 2048 + k * 1024); } while (0)
#define PG8_LDB(dst, b, h) do { _Pragma("unroll") for (int n = 0; n < 2; ++n) _Pragma("unroll") for (int k = 0; k < 2; ++k) dst[n][k] = *(const PG8_LAS bf16x8*)(lds + PG8_SB(b, h) + boff + n * 2048 + k * 1024); } while (0)
#define PG8_MMA(ai, bj, At, Bt) do { __builtin_amdgcn_s_setprio(1); _Pragma("unroll") for (int m = 0; m < 4; ++m) _Pragma("unroll") for (int n = 0; n < 2; ++n) _Pragma("unroll") for (int k = 0; k < 2; ++k) \
        { if constexpr (Epi::I8) acc[ai][bj][m][n] = __builtin_bit_cast(f32x4, __builtin_amdgcn_mfma_i32_16x16x64_i8(__builtin_bit_cast(i32x4, Bt[n][k]), __builtin_bit_cast(i32x4, At[m][k]), __builtin_bit_cast(i32x4, acc[ai][bj][m][n]), 0, 0, 0)); \
          else acc[ai][bj][m][n] = __builtin_amdgcn_mfma_f32_16x16x32_bf16(Bt[n][k], At[m][k], acc[ai][bj][m][n], 0, 0, 0); } __builtin_amdgcn_s_setprio(0); } while (0)
#define PG8_WAIT_V(n) asm volatile("s_waitcnt vmcnt(" #n ")" ::: "memory")
#define PG8_WAIT_L(n) asm volatile("s_waitcnt lgkmcnt(" #n ")" ::: "memory")
#define PG8_BAR __builtin_amdgcn_s_barrier()
#define PG8_SCHED __builtin_amdgcn_sched_barrier(0)
    Unit cur, nxt; int ui = 0;
    if (!S.next(0, cur)) return;
    f32x4 acc[2][2][4][2];
#pragma unroll
    for (int a = 0; a < 2; ++a)
#pragma unroll
        for (int b = 0; b < 2; ++b)
#pragma unroll
            for (int m = 0; m < 4; ++m)
#pragma unroll
                for (int n = 0; n < 2; ++n) acc[a][b][m][n] = (f32x4){0.f, 0.f, 0.f, 0.f};
    bf16x8 At[4][2], B0[2][2], B1[2][2];
    const char* cA = (const char*)(cur.sel ? g.A2 : g.A) + (size_t)cur.pm * tstep; const char* cB = (const char*)(cur.sel ? g.Bt2 : g.Bt) + (size_t)cur.pn * tstep;
    S.a_ready(cur);
    if constexpr (SP2) {
        PG8_STAGE(PG8_SB(0, 0), cB, voffB); PG8_STAGE(PG8_SB(0, 1), cB + hstep, voffB); PG8_STAGE(PG8_SA(0, 0), cA, voffA); PG8_STAGE(PG8_SA(0, 1), cA + hstep, voffA);
        if (wr == 1) PG8_BAR;
        PG8_WAIT_V(2); PG8_BAR;
        PG8_STAGE(PG8_SB(1, 0), cB + kstep, voffB); PG8_STAGE(PG8_SA(1, 0), cA + kstep, voffA); PG8_STAGE(PG8_SB(1, 1), cB + hstep + kstep, voffB);
        PG8_WAIT_V(6); PG8_BAR;
    } else {
        PG8_STAGE(PG8_SB(0, 0), cB, voffB); PG8_STAGE(PG8_SA(0, 0), cA, voffA); PG8_STAGE(PG8_SB(0, 1), cB + hstep, voffB); PG8_STAGE(PG8_SA(0, 1), cA + hstep, voffA);
        if (wr == 1) PG8_BAR;
        PG8_WAIT_V(4); PG8_BAR;
        PG8_STAGE(PG8_SB(1, 0), cB + kstep, voffB); PG8_STAGE(PG8_SA(1, 0), cA + kstep, voffA); PG8_STAGE(PG8_SB(1, 1), cB + hstep + kstep, voffB);
        PG8_WAIT_V(6); PG8_BAR;
    }
    for (;;) {
        const bool has_next = S.next(ui + 1, nxt);
        const char* nA = has_next ? (const char*)(nxt.sel ? g.A2 : g.A) + (size_t)nxt.pm * tstep : cA; const char* nB = has_next ? (const char*)(nxt.sel ? g.Bt2 : g.Bt) + (size_t)nxt.pn * tstep : cB;
        for (int t = 0; t < nt; t += 2) {
            const bool last = (t == nt - 2);
            const char* a1 = cA + (size_t)(t + 1) * kstep;
            const char* a2 = last ? nA : cA + (size_t)(t + 2) * kstep; const char* b2 = last ? nB : cB + (size_t)(t + 2) * kstep;
            const char* a3 = a2 + kstep; const char* b3 = b2 + kstep;
            if (last && has_next) S.a_ready(nxt);
            if constexpr (SP2) {
            PG8_LDB(B0, 0, 0); PG8_LDB(B1, 0, 1); PG8_SCHED; PG8_LDA(At, 0, 0); PG8_STAGE(PG8_SA(1, 1), a1 + hstep, voffA);
            PG8_WAIT_V(8); PG8_WAIT_L(0); PG8_BAR; PG8_MMA(0, 0, At, B0); PG8_MMA(0, 1, At, B1); PG8_BAR; PG8_SCHED;
            PG8_LDA(At, 0, 1); PG8_STAGE(PG8_SB(0, 0), b2, voffB); PG8_STAGE(PG8_SB(0, 1), b2 + hstep, voffB); PG8_STAGE(PG8_SA(0, 0), a2, voffA);
            PG8_WAIT_V(8); PG8_WAIT_L(0); PG8_BAR; PG8_MMA(1, 0, At, B0); PG8_MMA(1, 1, At, B1); PG8_BAR; PG8_SCHED;
            PG8_LDB(B0, 1, 0); PG8_LDB(B1, 1, 1); PG8_SCHED; PG8_LDA(At, 1, 0); PG8_STAGE(PG8_SA(0, 1), a2 + hstep, voffA);
            PG8_WAIT_V(8); PG8_WAIT_L(0); PG8_BAR; PG8_MMA(0, 0, At, B0); PG8_MMA(0, 1, At, B1); PG8_BAR; PG8_SCHED;
            PG8_LDA(At, 1, 1); PG8_STAGE(PG8_SB(1, 0), b3, voffB); PG8_STAGE(PG8_SB(1, 1), b3 + hstep, voffB); PG8_STAGE(PG8_SA(1, 0), a3, voffA);
            PG8_WAIT_V(8); PG8_WAIT_L(0); PG8_BAR; PG8_MMA(1, 0, At, B0); PG8_MMA(1, 1, At, B1); PG8_BAR; PG8_SCHED;
            } else {
            PG8_LDB(B0, 0, 0); PG8_SCHED; PG8_LDA(At, 0, 0); PG8_STAGE(PG8_SA(1, 1), a1 + hstep, voffA);
            PG8_WAIT_L(8); PG8_BAR; PG8_WAIT_L(0); PG8_MMA(0, 0, At, B0); PG8_BAR; PG8_SCHED;
            PG8_LDB(B1, 0, 1); PG8_STAGE(PG8_SB(0, 0), b2, voffB);
            PG8_BAR; PG8_WAIT_L(0); PG8_MMA(0, 1, At, B1); PG8_BAR;
            PG8_LDA(At, 0, 1); PG8_STAGE(PG8_SA(0, 0), a2, voffA);
            PG8_BAR; PG8_WAIT_L(0); PG8_MMA(1, 0, At, B0); PG8_BAR; PG8_SCHED;
            PG8_STAGE(PG8_SB(0, 1), b2 + hstep, voffB);
            PG8_WAIT_V(6); PG8_BAR; PG8_MMA(1, 1, At, B1); PG8_BAR;
            PG8_LDB(B0, 1, 0); PG8_SCHED; PG8_LDA(At, 1, 0); PG8_STAGE(PG8_SA(0, 1), a2 + hstep, voffA);
            PG8_WAIT_L(8); PG8_BAR; PG8_WAIT_L(0); PG8_MMA(0, 0, At, B0); PG8_BAR; PG8_SCHED;
            PG8_LDB(B1, 1, 1); PG8_STAGE(PG8_SB(1, 0), b3, voffB);
            PG8_BAR; PG8_WAIT_L(0); PG8_MMA(0, 1, At, B1); PG8_BAR;
            PG8_LDA(At, 1, 1); PG8_STAGE(PG8_SA(1, 0), a3, voffA);
            PG8_BAR; PG8_WAIT_L(0); PG8_MMA(1, 0, At, B0); PG8_BAR; PG8_SCHED;
            PG8_STAGE(PG8_SB(1, 1), b3 + hstep, voffB);
            PG8_WAIT_V(6); PG8_BAR; PG8_MMA(1, 1, At, B1); PG8_BAR;
            }
        }
        if constexpr (ALIGN_EPI) { if (wr == 0) PG8_BAR; }
        if constexpr (Epi::I8) {
            int ln_ = (int)__builtin_amdgcn_mbcnt_hi(~0u, __builtin_amdgcn_mbcnt_lo(~0u, 0u)); asm volatile("" : "+v"(ln_));
            const int fr_ = ln_ & 15, fq_ = ln_ >> 4;
            float sxr[2][4];
#pragma unroll
            for (int ai = 0; ai < 2; ++ai)
#pragma unroll
                for (int m = 0; m < 4; ++m) sxr[ai][m] = (cur.sel ? g.sa2 : g.sa)[cur.pm * 256 + ai * 128 + wr * 64 + m * 16 + fr_];
#pragma unroll
            for (int bj = 0; bj < 2; ++bj)
#pragma unroll
                for (int n = 0; n < 2; ++n) { const f32x4 swv = *(const f32x4*)((cur.sel ? g.sb2 : g.sb) + cur.pn * 256 + bj * 128 + wc * 32 + 8 * fq_ + 4 * n);
#pragma unroll
                    for (int ai = 0; ai < 2; ++ai)
#pragma unroll
                        for (int m = 0; m < 4; ++m) { const i32x4 iv = __builtin_bit_cast(i32x4, acc[ai][bj][m][n]);
                            acc[ai][bj][m][n] = (f32x4){(float)iv[0], (float)iv[1], (float)iv[2], (float)iv[3]} * sxr[ai][m] * swv; } }
            if constexpr (Epi::OPQ) E(acc, cur, wr, wc, fr_, fq_);
            else E(acc, cur, wr, wc, fr, fq);
        } else
        E(acc, cur, wr, wc, fr, fq);
        S.done(cur);
        if (!has_next) break;
#pragma unroll
        for (int a = 0; a < 2; ++a)
#pragma unroll
            for (int b = 0; b < 2; ++b)
#pragma unroll
                for (int m = 0; m < 4; ++m)
#pragma unroll
                    for (int n = 0; n < 2; ++n) acc[a][b][m][n] = (f32x4){0.f, 0.f, 0.f, 0.f};
        cur = nxt; cA = nA; cB = nB; ++ui;
        if constexpr (ALIGN_EPI) { if (wr == 1) PG8_BAR; }
    }
    PG8_WAIT_V(0);
    if constexpr (!ALIGN_EPI) { if (wr == 0) PG8_BAR; }
    PG8_BAR;
#undef PG8_SA
#undef PG8_SB
#undef PG8_STAGE
#undef PG8_LDA
#undef PG8_LDB
#undef PG8_MMA
#undef PG8_WAIT_V
#undef PG8_WAIT_L
#undef PG8_BAR
#undef PG8_SCHED
}
}
using pg8::Unit;

__device__ __forceinline__ u32x4 pack8(const f32x4 a, const f32x4 b) { u32x4 w; w.x = pk2(a[0], a[1]); w.y = pk2(a[2], a[3]); w.z = pk2(b[0], b[1]); w.w = pk2(b[2], b[3]); return w; }

__device__ __forceinline__ unsigned pk_u8x4(const f32x4 v) { unsigned w = 0; w = __builtin_amdgcn_cvt_pk_u8_f32(v[0] * 255.0f, 0, w); w = __builtin_amdgcn_cvt_pk_u8_f32(v[1] * 255.0f, 1, w); w = __builtin_amdgcn_cvt_pk_u8_f32(v[2] * 255.0f, 2, w); w = __builtin_amdgcn_cvt_pk_u8_f32(v[3] * 255.0f, 3, w); return w; }
__device__ __forceinline__ f32x4 un_u8x4(unsigned w) { return (f32x4){(float)(w & 255u), (float)((w >> 8) & 255u), (float)((w >> 16) & 255u), (float)(w >> 24)} * (1.0f / 255.0f); }
struct Epi1 {
    static constexpr bool PERM = true; static constexpr bool I8 = true; static constexpr bool OPQ = true;
    bf16_t *Q, *K, *V, *GA, *GB; float* U; const float* cs; const float *gq, *gk; bf16_t* UB;
    __device__ __forceinline__ void operator()(const f32x4 (&acc)[2][2][4][2], const Unit& u, int wr, int wc, int fr, int fq) const {
        const int type = u.pn >> 2;
        const int row0 = u.pm * 256 + wr * 64 + fr;
        if (type <= 1) {
            const int sh = (u.pn & 3) * 4 + wc;
            bf16_t* dst = type == 0 ? Q : K; const float* g = type == 0 ? gq : gk; const float osc = type == 0 ? QSCALE : 1.0f;
            f32x4 gv[2][2];
#pragma unroll
            for (int bj = 0; bj < 2; ++bj)
#pragma unroll
                for (int n = 0; n < 2; ++n) gv[bj][n] = *(const f32x4*)(g + 32 * bj + 8 * fq + 4 * n);
#pragma unroll
            for (int ai = 0; ai < 2; ++ai)
#pragma unroll
            for (int mh = 0; mh < 2; ++mh) {
                f32x4 cv[2][2], sv[2][2];
#pragma unroll
                for (int m = 0; m < 2; ++m) { const int pos = NMETA + ((row0 + ai * 128 + (2 * mh + m) * 16) & (SEQ - 1)); const float* csr = cs + (size_t)pos * 64 + 8 * fq;
                    cv[m][0] = *(const f32x4*)(csr); cv[m][1] = *(const f32x4*)(csr + 4); sv[m][0] = *(const f32x4*)(csr + 32); sv[m][1] = *(const f32x4*)(csr + 36); }
                asm volatile("" ::: "memory");
#pragma unroll
                for (int m = 0; m < 2; ++m) {
                    const int mm = 2 * mh + m, r = row0 + ai * 128 + mm * 16;
                    float ss = 0.f;
#pragma unroll
                    for (int bj = 0; bj < 2; ++bj)
#pragma unroll
                        for (int n = 0; n < 2; ++n) { const f32x4 x = acc[ai][bj][mm][n]; ss += (x[0] * x[0] + x[1] * x[1]) + (x[2] * x[2] + x[3] * x[3]); }
                    ss += __shfl_xor(ss, 16); ss += __shfl_xor(ss, 32);
                    const float rs = rsqrtf(ss * (1.0f / 64.0f) + EPS);
                    f32x4 olo[2], ohi[2];
#pragma unroll
                    for (int n = 0; n < 2; ++n) { const f32x4 lo = acc[ai][0][mm][n] * rs * gv[0][n], hi = acc[ai][1][mm][n] * rs * gv[1][n];
                        olo[n] = (lo * cv[m][n] - hi * sv[m][n]) * osc; ohi[n] = (hi * cv[m][n] + lo * sv[m][n]) * osc; }
                    bf16_t* p = dst + ((size_t)((r >> 12) * 8 + (sh >> 1)) * SEQ + (r & (SEQ - 1))) * 128 + (sh & 1) * 64 + 8 * fq;
                    *(u32x4*)(p) = pack8(olo[0], olo[1]); *(u32x4*)(p + 32) = pack8(ohi[0], ohi[1]);
                }
            }
        } else {
            const int colt = (u.pn & 3) * 256 + wc * 32 + 8 * fq;
#pragma unroll
            for (int ai = 0; ai < 2; ++ai)
#pragma unroll
                for (int m = 0; m < 4; ++m) {
                    const int r = row0 + ai * 128 + m * 16;
#pragma unroll
                    for (int bj = 0; bj < 2; ++bj) {
                        const f32x4 v0 = acc[ai][bj][m][0], v1 = acc[ai][bj][m][1];
                        if (type == 2) { const int col_ = colt + bj * 128; *(u32x4*)(V + ((size_t)((r >> 12) * 8 + (col_ >> 7)) * SEQ + (r & (SEQ - 1))) * 128 + (col_ & 127)) = pack8(v0, v1); }
                        else if (type == 3) { if (U) { float* p = U + (size_t)r * SW + colt + bj * 128; *(f32x4*)p = v0; *(f32x4*)(p + 4) = v1; } { const int col_ = colt + bj * 128; *(u32x4*)(UB + ((size_t)((r >> 12) * 64 + (col_ >> 4)) * SEQ + (r & (SEQ - 1))) * 16 + (col_ & 8)) = pack8(v0, v1); } }
                        else {
                            unsigned char* G = (unsigned char*)((type < 6) ? GA : GB); const int col = ((u.pn - (type < 6 ? 16 : 24)) * 256) + wc * 32 + 8 * fq + bj * 128;
                            f32x4 s0, s1;
#pragma unroll
                            for (int i = 0; i < 4; ++i) { s0[i] = sigmoidf_(v0[i]); s1[i] = sigmoidf_(v1[i]); }
                            *(u32x2*)(G + (size_t)r * DM + col) = (u32x2){pk_u8x4(s0), pk_u8x4(s1)};
                        }
                    }
                }
        }
    }
};
struct EpiGlu {
    static constexpr bool PERM = true; static constexpr bool I8 = false; static constexpr bool OPQ = false;
    const bf16_t* GB; bf16_t* YB;
    __device__ __forceinline__ void operator()(const f32x4 (&acc)[2][2][4][2], const Unit& u, int wr, int wc, int fr, int fq) const {
        const int row0 = u.pm * 256 + wr * 64 + fr, col = u.pn * 128 + wc * 32 + 8 * fq;
        u32x2 gbv[2][4];
#pragma unroll
        for (int ai = 0; ai < 2; ++ai)
#pragma unroll
            for (int m = 0; m < 4; ++m) gbv[ai][m] = __builtin_nontemporal_load((const u32x2*)((const unsigned char*)GB + (size_t)(row0 + ai * 128 + m * 16) * DM + col));
        asm volatile("" ::: "memory");
#pragma unroll
        for (int ai = 0; ai < 2; ++ai)
#pragma unroll
            for (int m = 0; m < 4; ++m) {
                const size_t off = (size_t)(row0 + ai * 128 + m * 16) * DM + col;
                const u32x2 gb = gbv[ai][m];
                f32x4 o0, o1;
#pragma unroll
                for (int i = 0; i < 4; ++i) { o0[i] = acc[ai][0][m][0][i] * sigmoidf_(acc[ai][1][m][0][i]); o1[i] = acc[ai][0][m][1][i] * sigmoidf_(acc[ai][1][m][1][i]); }
                o0 = o0 * un_u8x4(gb.x); o1 = o1 * un_u8x4(gb.y);
                *(u32x4*)(YB + off) = pack8(o0, o1);
            }
    }
};
struct EpiMix {
    static constexpr bool PERM = true; static constexpr bool I8 = false; static constexpr bool OPQ = false;
    const bf16_t *GA, *YB; bf16_t* MIX;
    __device__ __forceinline__ void operator()(const f32x4 (&acc)[2][2][4][2], const Unit& u, int wr, int wc, int fr, int fq) const {
        const int row0 = u.pm * 256 + wr * 64 + fr, col0 = u.pn * 256 + wc * 32 + 8 * fq;
#pragma unroll
        for (int ai = 0; ai < 2; ++ai)
#pragma unroll
        for (int mh = 0; mh < 2; ++mh) {
            u32x2 gav[2][2]; u32x4 ybv[2][2];
#pragma unroll
            for (int m = 0; m < 2; ++m)
#pragma unroll
                for (int bj = 0; bj < 2; ++bj) { const size_t off = (size_t)(row0 + ai * 128 + (2 * mh + m) * 16) * DM + col0 + bj * 128; gav[m][bj] = __builtin_nontemporal_load((const u32x2*)((const unsigned char*)GA + off)); ybv[m][bj] = *(const u32x4*)(YB + off); }
            asm volatile("" ::: "memory");
#pragma unroll
            for (int m = 0; m < 2; ++m)
#pragma unroll
                for (int bj = 0; bj < 2; ++bj) {
                    const size_t off = (size_t)(row0 + ai * 128 + (2 * mh + m) * 16) * DM + col0 + bj * 128;
                    const u32x2 ga = gav[m][bj]; const u32x4 yb = ybv[m][bj];
                    const f32x4 g0 = un_u8x4(ga.x), g1 = un_u8x4(ga.y);
                    f32x4 o0 = acc[ai][bj][2 * mh + m][0], o1 = acc[ai][bj][2 * mh + m][1];
                    o0[0] = o0[0] * g0[0] + bflo(yb.x); o0[1] = o0[1] * g0[1] + bfhi(yb.x); o0[2] = o0[2] * g0[2] + bflo(yb.y); o0[3] = o0[3] * g0[3] + bfhi(yb.y);
                    o1[0] = o1[0] * g1[0] + bflo(yb.z); o1[1] = o1[1] * g1[1] + bfhi(yb.z); o1[2] = o1[2] * g1[2] + bflo(yb.w); o1[3] = o1[3] * g1[3] + bfhi(yb.w);
                    *(u32x4*)(MIX + off) = pack8(o0, o1);
                }
        }
    }
};
struct EpiP3 {
    static constexpr bool PERM = true; static constexpr bool I8 = true; static constexpr bool OPQ = false;
    EpiGlu g; EpiMix m;
    __device__ __forceinline__ void operator()(const f32x4 (&acc)[2][2][4][2], const Unit& u, int wr, int wc, int fr, int fq) const { if (u.sel) m(acc, u, wr, wc, fr, fq); else g(acc, u, wr, wc, fr, fq); }
};
struct EpiOut {
    static constexpr bool PERM = true; static constexpr bool I8 = true; static constexpr bool OPQ = false;
    const float* X; bf16_t* H2B; float* PARTSS;
    __device__ __forceinline__ void operator()(const f32x4 (&acc)[2][2][4][2], const Unit& u, int wr, int wc, int fr, int fq) const {
        const int row0 = u.pm * 256 + wr * 64 + fr, col0 = u.pn * 256 + wc * 32 + 8 * fq;
#pragma unroll
        for (int ai = 0; ai < 2; ++ai)
#pragma unroll
        for (int mh = 0; mh < 2; ++mh) {
            f32x4 xv[2][2][2];
#pragma unroll
            for (int m = 0; m < 2; ++m)
#pragma unroll
                for (int bj = 0; bj < 2; ++bj)
#pragma unroll
                    for (int n = 0; n < 2; ++n) xv[m][bj][n] = __builtin_nontemporal_load((const f32x4*)(X + (size_t)(row0 + ai * 128 + (2 * mh + m) * 16) * DM + col0 + bj * 128 + n * 4));
            asm volatile("" ::: "memory");
#pragma unroll
            for (int m = 0; m < 2; ++m) {
                const int r = row0 + ai * 128 + (2 * mh + m) * 16; float ss = 0.f;
#pragma unroll
                for (int bj = 0; bj < 2; ++bj) {
                    const f32x4 h0 = xv[m][bj][0] + acc[ai][bj][2 * mh + m][0], h1 = xv[m][bj][1] + acc[ai][bj][2 * mh + m][1];
                    ss += ((h0[0] * h0[0] + h0[1] * h0[1]) + (h0[2] * h0[2] + h0[3] * h0[3])) + ((h1[0] * h1[0] + h1[1] * h1[1]) + (h1[2] * h1[2] + h1[3] * h1[3]));
                    *(u32x4*)(H2B + (size_t)r * DM + col0 + bj * 128) = pack8(h0, h1);
                }
                ss += __shfl_xor(ss, 16); ss += __shfl_xor(ss, 32);
                if (fq == 0) PARTSS[(size_t)(u.pn * 4 + wc) * MTOK + r] = ss;
            }
        }
    }
};
constexpr int QPT_PITCH = 528;
struct EpiQP {
    static constexpr bool PERM = true; static constexpr bool I8 = true; static constexpr bool OPQ = false;
    bf16_t* QP; LAS unsigned char* tile; bool in_lds;
    __device__ __forceinline__ void operator()(const f32x4 (&acc)[2][2][4][2], const Unit& u, int wr, int wc, int fr, int fq) const {
        const int rl0 = wr * 64 + fr, col0 = wc * 32 + 8 * fq;
        if (in_lds) { asm volatile("s_waitcnt vmcnt(0)" ::: "memory"); __builtin_amdgcn_s_barrier(); }
#pragma unroll
        for (int ai = 0; ai < 2; ++ai)
#pragma unroll
            for (int m = 0; m < 4; ++m) {
                const int rl = rl0 + ai * 128 + m * 16;
#pragma unroll
                for (int bj = 0; bj < 2; ++bj) { const u32x4 w = pack8(acc[ai][bj][m][0], acc[ai][bj][m][1]);
                    if (in_lds) *(LAS u32x4*)(tile + rl * QPT_PITCH + (col0 + bj * 128) * 2) = w;
                    else *(u32x4*)(QP + (size_t)(u.pm * 256 + rl) * DM + u.pn * 256 + col0 + bj * 128) = w; }
            }
        if (in_lds) asm volatile("s_waitcnt lgkmcnt(0)" ::: "memory");
    }
};

struct Args { const float* in[28]; float* out; unsigned char* ws; int ph_lo, ph_hi, probe, pad; };
enum { I_X = 0, I_META, I_N1G, I_WIN, I_QNG, I_KNG, I_LQ1, I_LK1, I_LQ2, I_LK2, I_SUBLN, I_WATT, I_ARE, I_AIM, I_LOGDT, I_BRE, I_BIM, I_CRE, I_CIM, I_SSMD, I_WGLU, I_WOUT, I_N2G, I_WQ, I_K1, I_K2, I_PU, I_PV };

constexpr int NWAVES = 8, NTHREADS = 512;
constexpr int RING_BYTES = 131072, LDS_EXTRA_OFF = RING_BYTES, LDS_BYTES = 147456;

template <class RowMap>
__device__ __forceinline__ void transpose_item(const float* W, int K, int N, bf16_t* WT, LAS float* scr, int item, int lane, RowMap rm, const float* kscale = nullptr) {
    const int nblk = N / 32, kb = item / nblk, nb = item % nblk, k0 = 64 * kb, n0 = 32 * nb;
    float tv[32];
#pragma unroll
    for (int i = 0; i < 32; ++i) { tv[i] = __builtin_nontemporal_load(W + (size_t)(k0 + 2 * i + (lane >> 5)) * N + n0 + (lane & 31)); if (kscale) tv[i] *= kscale[k0 + 2 * i + (lane >> 5)]; }
#pragma unroll
    for (int i = 0; i < 32; ++i) scr[(2 * i + (lane >> 5)) * 33 + (lane & 31)] = tv[i];
    asm volatile("s_waitcnt lgkmcnt(0)" ::: "memory");
    const int c = lane & 7;
#pragma unroll
    for (int j = 0; j < 4; ++j) { const int n = (lane >> 3) + 8 * j; const LAS float* s = scr + (8 * c) * 33 + n;
        u32x4 o; o.x = pk2(s[0 * 33], s[1 * 33]); o.y = pk2(s[2 * 33], s[3 * 33]); o.z = pk2(s[4 * 33], s[5 * 33]); o.w = pk2(s[6 * 33], s[7 * 33]);
        *(u32x4*)(WT + (size_t)rm(n0 + n) * K + k0 + 8 * c) = o; }
    asm volatile("s_waitcnt lgkmcnt(0)" ::: "memory");
}
struct MapId { __device__ __forceinline__ int operator()(int n) const { return n; } };
struct MapWin { __device__ __forceinline__ int operator()(int n) const { if (n >= 2048) return n; const int w = n & 255; return (n & ~255) + 128 * ((w >> 5) & 1) + 32 * (w >> 6) + (w & 31); } };
struct MapGlu { __device__ __forceinline__ int operator()(int n) const { const int hi = n >= 2048, j = n & 2047; return (j >> 7) * 256 + 128 * hi + (j & 127); } };

__device__ __forceinline__ void rms_row_to_bf16(const float* xrow, const float* g, bf16_t* orow, int lane) {
    const f32x4* xr = (const f32x4*)xrow + lane; const f32x4* gr = (const f32x4*)g + lane;
    f32x4 v[8]; float s = 0.f;
#pragma unroll
    for (int j = 0; j < 8; ++j) { v[j] = __builtin_nontemporal_load(xr + 64 * j); s += (v[j][0] * v[j][0] + v[j][1] * v[j][1]) + (v[j][2] * v[j][2] + v[j][3] * v[j][3]); }
    const float rs = rsqrtf(wave_sum(s) * (1.0f / DM) + EPS);
    u32x2* o = (u32x2*)orow + lane;
#pragma unroll
    for (int j = 0; j < 8; ++j) { const f32x4 y = v[j] * rs * gr[64 * j]; u32x2 w; w.x = pk2(y[0], y[1]); w.y = pk2(y[2], y[3]); o[64 * j] = w; }
}

__device__ __forceinline__ void rms_row_to_i8(const float* xrow, const float* g, unsigned char* qrow, float* sx, int lane) {
    const f32x4* xr = (const f32x4*)xrow + lane; const f32x4* gr = (const f32x4*)g + lane;
    f32x4 v[8]; float s = 0.f, mx = 0.f;
#pragma unroll
    for (int j = 0; j < 8; ++j) { v[j] = __builtin_nontemporal_load(xr + 64 * j); s += (v[j][0] * v[j][0] + v[j][1] * v[j][1]) + (v[j][2] * v[j][2] + v[j][3] * v[j][3]);
        v[j] = v[j] * gr[64 * j]; mx = fmaxf(mx, fmaxf(fmaxf(fabsf(v[j][0]), fabsf(v[j][1])), fmaxf(fabsf(v[j][2]), fabsf(v[j][3])))); }
    const float rs = rsqrtf(wave_sum(s) * (1.0f / DM) + EPS);
    mx = wave_max(mx);
    const float inv = mx > 0.f ? 127.0f / mx : 0.f;
    unsigned* o = (unsigned*)qrow + lane;
#pragma unroll
    for (int j = 0; j < 8; ++j) { const int q0 = (int)rintf(v[j][0] * inv), q1 = (int)rintf(v[j][1] * inv), q2 = (int)rintf(v[j][2] * inv), q3 = (int)rintf(v[j][3] * inv);
        o[64 * j] = (unsigned)(q0 & 255) | ((unsigned)(q1 & 255) << 8) | ((unsigned)(q2 & 255) << 16) | ((unsigned)q3 << 24); }
    if (lane == 0) *sx = mx * rs * (1.0f / 127.0f);
}
template <int K, class RowMap>
__device__ __forceinline__ void strip_item(const float* Wm, int N, const float* kscale, RowMap rm, unsigned char* WT8, float* sw, LAS unsigned char* lds, int strip) {
    const int tid = otid(), col = tid & 31, rp = tid >> 5;
    constexpr int CP = 2 * K + 16;
    const float* W = Wm + 32 * strip + col;
    float mx = 0.f;
#pragma unroll 1
    for (int i0 = 0; i0 < K / 32; i0 += 16) {
        float v[32];
#pragma unroll
        for (int i = 0; i < 16; ++i) { const int k = 2 * (rp + 16 * (i0 + i)); v[2 * i] = __builtin_nontemporal_load(W + (size_t)k * N); v[2 * i + 1] = __builtin_nontemporal_load(W + (size_t)(k + 1) * N); }
        asm volatile("" ::: "memory");
#pragma unroll
        for (int i = 0; i < 16; ++i) { const int k = 2 * (rp + 16 * (i0 + i)); if (kscale) { v[2 * i] *= kscale[k]; v[2 * i + 1] *= kscale[k + 1]; }
            mx = fmaxf(mx, fmaxf(fabsf(v[2 * i]), fabsf(v[2 * i + 1])));
            *(LAS unsigned*)(lds + col * CP + k * 2) = pk2(v[2 * i], v[2 * i + 1]); }
    }
    LAS float* smax = (LAS float*)(lds + 32 * CP);
    smax[rp * 32 + col] = mx;
    __syncthreads();
    constexpr int TPC = K / 16, CPP = 512 / TPC;
#pragma unroll 1
    for (int p = 0; p < 32 / CPP; ++p) {
        const int c = CPP * p + tid / TPC, kc = (tid % TPC) * 16;
        float cm = 0.f;
#pragma unroll
        for (int j = 0; j < 16; ++j) cm = fmaxf(cm, smax[j * 32 + c]);
        const float inv = cm > 0.f ? 127.0f / cm : 0.f;
        const u32x4 lo = *(const LAS u32x4*)(lds + c * CP + kc * 2), hi = *(const LAS u32x4*)(lds + c * CP + kc * 2 + 16);
        const unsigned wd[8] = {lo.x, lo.y, lo.z, lo.w, hi.x, hi.y, hi.z, hi.w}; u32x4 o;
#pragma unroll
        for (int q = 0; q < 4; ++q) { const int q0 = (int)rintf(bflo(wd[2 * q]) * inv), q1 = (int)rintf(bfhi(wd[2 * q]) * inv), q2 = (int)rintf(bflo(wd[2 * q + 1]) * inv), q3 = (int)rintf(bfhi(wd[2 * q + 1]) * inv);
            const unsigned pk = (unsigned)(q0 & 255) | ((unsigned)(q1 & 255) << 8) | ((unsigned)(q2 & 255) << 16) | ((unsigned)q3 << 24);
            if (q == 0) o.x = pk; else if (q == 1) o.y = pk; else if (q == 2) o.z = pk; else o.w = pk; }
        const int n = rm(32 * strip + c);
        *(u32x4*)(WT8 + (size_t)n * K + kc) = o;
        if ((tid % TPC) == 0) sw[n] = cm * (1.0f / 127.0f);
    }
    __syncthreads();
}

constexpr int XROWS = 2 * NEXP;
template <int MODE>
__device__ __forceinline__ void p0_prologue(const Args& A, LAS unsigned char* lds, int G, int probe = 0) {
    const int tid = otid(), lane = tid & 63, wave = __builtin_amdgcn_readfirstlane(tid >> 6);
    const int gw = MODE ? (blockIdx.x - 128) * NWAVES + wave : blockIdx.x * NWAVES + wave, NGW = MODE ? (G - 128) * NWAVES : G * NWAVES;
    unsigned char* ws = A.ws;
#pragma unroll 1
    for (int step = 0; step < 3; ++step) {
    const int part = (MODE == 0 && (blockIdx.x & 1)) ? (step + 2) % 3 : step;
    if (part == 0 && (probe == 0 || probe == 1)) {
        LAS float* scr = (LAS float*)(lds + wave * 16384);
        constexpr int I_IN = (DM / 64) * (INW / 32), I_AT = (AW / 64) * (DM / 32), I_GL = (SW / 64) * (2 * DM / 32), I_OU = (DM / 64) * (DM / 32), I_Q = I_OU;
        constexpr int NIT = I_IN + I_AT + I_GL + I_OU + I_Q;
        if (MODE == 0) { for (int st = blockIdx.x; st < INW / 32; st += G) strip_item<DM>(A.in[I_WIN], INW, nullptr, MapWin(), ws + WS_WTIN, (float*)(ws + WS_SWB), lds, st); }
        else {
            for (int it = (int)blockIdx.x - 128; it < 320; it += G - 128) {
                if (it < 64) strip_item<DM>(A.in[I_WQ], DM, A.in[I_N2G], MapId(), ws + WS_WTQ, (float*)(ws + WS_SWQ), lds, it);
                else if (it < 128) strip_item<DM>(A.in[I_WOUT], DM, nullptr, MapId(), ws + WS_WTOUT, (float*)(ws + WS_SWO), lds, it - 64);
                else if (it < 256) strip_item<SW>(A.in[I_WGLU], 2 * DM, nullptr, MapGlu(), ws + WS_WTGLU, (float*)(ws + WS_SWG), lds, it - 128);
                else strip_item<AW>(A.in[I_WATT], DM, nullptr, MapId(), ws + WS_WTATT, (float*)(ws + WS_SWA), lds, it - 256);
            }
        }
    }
    if (part == 1 && MODE == 0 && (probe == 0 || probe == 2)) for (int m = gw; m < MTOK; m += NGW) rms_row_to_i8(A.in[I_X] + (size_t)m * DM, A.in[I_N1G], ws + WS_XN + (size_t)m * DM, (float*)(ws + WS_SXA) + m, lane);
    if (part == 2 && (probe == 0 || probe == 3)) {
        float* su = (float*)(ws + WS_SU); float* sv = (float*)(ws + WS_SV);
        for (int it = MODE ? gw + XROWS : gw; it < (MODE ? 2 * NEXP : XROWS); it += NGW) {
            const int tb = it >= NEXP, e = it - tb * NEXP;
            const f32x4* src = (const f32x4*)(A.in[tb ? I_PV : I_PU] + (size_t)e * DM) + lane;
            f32x4 v[8]; float mx = 0.f;
#pragma unroll
            for (int j = 0; j < 8; ++j) { v[j] = __builtin_nontemporal_load(src + 64 * j); if (!tb) v[j] = v[j] * *((const f32x4*)A.in[I_N2G] + lane + 64 * j);
                mx = fmaxf(mx, fmaxf(fmaxf(fabsf(v[j][0]), fabsf(v[j][1])), fmaxf(fabsf(v[j][2]), fabsf(v[j][3])))); }
            mx = wave_max(mx);
            unsigned* dst = (unsigned*)(ws + (tb ? WS_VE : WS_UE) + ((size_t)(lane >> 5) * NEXP + e) * 128) + (lane & 31);
            if (!tb) {
                const float inv = mx > 0.f ? 127.0f / mx : 0.f;
#pragma unroll
                for (int j = 0; j < 8; ++j) { const int q0 = (int)rintf(v[j][0] * inv), q1 = (int)rintf(v[j][1] * inv), q2 = (int)rintf(v[j][2] * inv), q3 = (int)rintf(v[j][3] * inv);
                    dst[(size_t)(2 * j) * NEXP * 32] = (unsigned)(q0 & 255) | ((unsigned)(q1 & 255) << 8) | ((unsigned)(q2 & 255) << 16) | ((unsigned)(q3 & 255) << 24); }
                if (lane == 0) su[e] = mx * (1.0f / 127.0f);
            } else {
                const float inv = mx > 0.f ? 448.0f / mx : 0.f;
#pragma unroll
                for (int j = 0; j < 8; ++j) { int p = __builtin_amdgcn_cvt_pk_fp8_f32(v[j][0] * inv, v[j][1] * inv, 0, false); p = __builtin_amdgcn_cvt_pk_fp8_f32(v[j][2] * inv, v[j][3] * inv, p, true); dst[(size_t)(2 * j) * NEXP * 32] = (unsigned)p; }
                if (lane == 0) sv[e] = mx * (1.0f / 448.0f);
            }
        }
    }
    }
    if (MODE == 0 && (probe == 0 || probe == 4)) {
        { bf16_t* k12 = (bf16_t*)(ws + WS_K12);
          for (int i = blockIdx.x * NTHREADS + tid; i < 2 * 8 * 128 * 128; i += G * NTHREADS) k12[i] = (bf16_t)f2bf(i < 131072 ? A.in[I_K1][i] : A.in[I_K2][i - 131072]); }
        float* cs = (float*)(ws + WS_CS);
        for (int i = blockIdx.x * NTHREADS + tid; i < NPOS * 32; i += G * NTHREADS) {
            const int pos = i >> 5, j = i & 31; const float invf = exp2f(-(float)j * (13.287712379549449f / 32.0f));
            const float ang = (float)pos * invf; float sn, cn; sincosf(ang, &sn, &cn); cs[pos * 64 + j] = cn; cs[pos * 64 + 32 + j] = sn;
        }
        { u32x4* qg = (u32x4*)(ws + WS_QG);
          for (int i = blockIdx.x * NTHREADS + tid; i < 64 * 8 * 8 * 64; i += G * NTHREADS) {
              const int ln = i & 63, ks = (i >> 6) & 7, mb = (i >> 9) & 7, g = i >> 12, r32_ = ln & 31, hh_ = ln >> 5, tl = r32_ >> 4, c = r32_ & 15;
              const float dtt = expf(A.in[I_LOGDT][g]) * (float)(2 * mb + tl + 1); float v[8];
#pragma unroll
              for (int i2 = 0; i2 < 4; ++i2) { const int p = 8 * ks + 4 * hh_ + i2;
                  const float mag = expf(A.in[I_ARE][g * 64 + p] * dtt); float sn, cn; sincosf(A.in[I_AIM][g * 64 + p] * dtt, &sn, &cn); const float ar = mag * cn, ai = mag * sn;
                  const float c_r = A.in[I_CRE][g * 1024 + c * 64 + p], c_i = A.in[I_CIM][g * 1024 + c * 64 + p];
                  v[2 * i2] = c_r * ar - c_i * ai; v[2 * i2 + 1] = -(c_r * ai + c_i * ar); }
              u32x4 wv; wv.x = pk2(v[0], v[1]); wv.y = pk2(v[2], v[3]); wv.z = pk2(v[4], v[5]); wv.w = pk2(v[6], v[7]); qg[i] = wv; } }
        float* abar = (float*)(ws + WS_ABAR); float* bbar = (float*)(ws + WS_BBAR);
        for (int i = blockIdx.x * NTHREADS + tid; i < 64 * 64; i += G * NTHREADS) {
            const int g = i >> 6; const float are = A.in[I_ARE][i], aim = A.in[I_AIM][i], dt = expf(A.in[I_LOGDT][g]);
            const float mag = expf(are * dt); float sn, cn; sincosf(aim * dt, &sn, &cn); const float br = mag * cn, bi = mag * sn;
            abar[2 * i] = br; abar[2 * i + 1] = bi;
            const float nr = br - 1.0f, ni = bi, den = 1.0f / (are * are + aim * aim);
            const float fr_ = (nr * are + ni * aim) * den, fi_ = (ni * are - nr * aim) * den;
            for (int c = 0; c < 16; ++c) { const float b_r = A.in[I_BRE][i * 16 + c], b_i = A.in[I_BIM][i * 16 + c];
                bbar[(i * 16 + c) * 2] = fr_ * b_r - fi_ * b_i; bbar[(i * 16 + c) * 2 + 1] = fr_ * b_i + fi_ * b_r; }
        }
        if (blockIdx.x == 0 && wave == 0) {
            const float s1 = wave_sum(A.in[I_LQ1][lane] * A.in[I_LK1][lane]), s2 = wave_sum(A.in[I_LQ2][lane] * A.in[I_LK2][lane]);
            const float gqm = wave_max(fabsf(A.in[I_QNG][lane])), gkm = wave_max(fabsf(A.in[I_KNG][lane]));
            if (lane == 0) { float* par = (float*)(ws + WS_PAR); par[0] = expf(s1) - expf(s2) + LAM_INIT; par[1] = 8.0f * gqm * gkm * LOG2E * 1.01f; }
        }
    }
    if (MODE == 0 && (probe == 0 || probe == 5)) {
        __syncthreads();
        LAS float* hm = (LAS float*)(lds + wave * 16384);
        float* macc = (float*)(ws + WS_MP32);
        for (int it = gw; it < 48 * 32; it += NGW) {
            const int cb = it % 48, ks = it / 48, k0 = ks * 64;
            float w[64];
            const float* wp = A.in[I_WIN] + (size_t)k0 * INW + 1024 + cb * 64 + lane;
#pragma unroll
            for (int q = 0; q < 64; ++q) w[q] = wp[(size_t)q * INW];
            const float gk = A.in[I_N1G][k0 + lane];
#pragma unroll
            for (int r = 0; r < 16; ++r) hm[r * 64 + lane] = A.in[I_META][(size_t)r * DM + k0 + lane] * gk;
            asm volatile("s_waitcnt lgkmcnt(0)" ::: "memory");
            float acc[16];
#pragma unroll
            for (int r = 0; r < 16; ++r) acc[r] = 0.f;
#pragma unroll
            for (int q4 = 0; q4 < 16; ++q4) {
#pragma unroll
                for (int r = 0; r < 16; ++r) { const f32x4 h = *(const LAS f32x4*)(hm + r * 64 + 4 * q4); acc[r] += (h[0] * w[4 * q4] + h[1] * w[4 * q4 + 1]) + (h[2] * w[4 * q4 + 2] + h[3] * w[4 * q4 + 3]); }
                if ((q4 & 3) == 3) __builtin_amdgcn_sched_barrier(0);
            }
#pragma unroll
            for (int r = 0; r < 16; ++r) macc[((size_t)ks * 16 + r) * 3072 + cb * 64 + lane] = acc[r];
            asm volatile("s_waitcnt lgkmcnt(0)" ::: "memory");
        }
    }
}
__device__ __forceinline__ void p1_meta_finish(const Args& A, LAS unsigned char* lds, int G) {
    const int tid = otid(), lane = tid & 63, wave = __builtin_amdgcn_readfirstlane(tid >> 6); unsigned char* ws = A.ws;
    const float* mp = (const float*)(ws + WS_MP32); const float* cs = (const float*)(ws + WS_CS);
    bf16_t* KM = (bf16_t*)(ws + WS_KM); bf16_t* VM = (bf16_t*)(ws + WS_VM); float* UM = (float*)(ws + WS_UM); bf16_t* UMB = (bf16_t*)(ws + WS_UMB);
    LAS float* rsm = (LAS float*)(lds + LDS_EXTRA_OFF + 12288);
    for (int r = wave; r < 16; r += NWAVES) { const f32x4* mr = (const f32x4*)(A.in[I_META] + (size_t)r * DM) + lane; float sq = 0.f;
#pragma unroll
        for (int j = 0; j < 8; ++j) { const f32x4 v = mr[64 * j]; sq += (v[0] * v[0] + v[1] * v[1]) + (v[2] * v[2] + v[3] * v[3]); }
        sq = wave_sum(sq); if (lane == 0) rsm[r] = rsqrtf(sq * (1.0f / DM) + EPS); }
    __syncthreads();
    for (int t = blockIdx.x * NWAVES + wave; t < 16 * 16; t += G * NWAVES) {
        const int r = t >> 4, sh = t & 15, d = lane; float kv = 0.f;
        for (int ks = 0; ks < 32; ++ks) kv += mp[((size_t)ks * 16 + r) * 3072 + sh * 64 + d];
        kv *= rsm[r];
        const float rs = rsqrtf(wave_sum(kv * kv) * (1.0f / 64.0f) + EPS);
        const float a = kv * rs * A.in[I_KNG][d], bq = __shfl_xor(a, 32);
        const int j = d & 31; const float cn = cs[r * 64 + j], sn = cs[r * 64 + 32 + j];
        KM[r * 1024 + sh * 64 + d] = (bf16_t)f2bf((d < 32) ? (a * cn - bq * sn) : (a * cn + bq * sn));
    }
    for (int i = blockIdx.x * NTHREADS + tid; i < 16 * 2048; i += G * NTHREADS) {
        const int r = i >> 11, c = i & 2047; float v = 0.f;
        for (int ks = 0; ks < 32; ++ks) v += mp[((size_t)ks * 16 + r) * 3072 + 1024 + c];
        v *= rsm[r];
        if (c < 1024) VM[r * 1024 + c] = (bf16_t)f2bf(v); else { UM[r * 1024 + c - 1024] = v; UMB[r * 1024 + c - 1024] = (bf16_t)f2bf(v); }
    }
    for (int i = blockIdx.x * NTHREADS + tid; i < 48 * 1024; i += G * NTHREADS) { KM[16 * 1024 + i] = 0; VM[16 * 1024 + i] = 0; }
}

namespace att {
typedef float f32x16 __attribute__((ext_vector_type(16)));
typedef short s16x4 __attribute__((ext_vector_type(4)));
typedef short v4i16_t __attribute__((ext_vector_type(4)));
constexpr int KP = 272, VP = 320, KBUF = 64 * KP, VBUF = 64 * VP, STG = KBUF + VBUF;
constexpr int X_OFF = 0, OST_OFF = 65536, QF_OFF = 2 * STG, WSL_OFF = QF_OFF + 32768;
__device__ __forceinline__ int crow(int r, int hi) { return (r & 3) + 8 * (r >> 2) + 4 * hi; }
__device__ __forceinline__ s16x4 vtr(const LAS unsigned char* p) { return __builtin_bit_cast(s16x4, __builtin_amdgcn_ds_read_tr16_b64_v4i16((LAS v4i16_t*)p)); }
__device__ __forceinline__ unsigned cvtpk(float lo, float hi) { f32x2 v = {lo, hi}; bf16x2_t b = __builtin_convertvector(v, bf16x2_t); return __builtin_bit_cast(unsigned, b); }

__device__ __forceinline__ void attn_unit(const Args& A, int b, int h, int qb, LAS unsigned char* lds, float lam, float Mb) {
    const int tid = otid(), lane = tid & 63, wave = __builtin_amdgcn_readfirstlane(tid >> 6);
    const int c = wave >> 2, w4 = wave & 3, r32 = lane & 31, hh = lane >> 5;
    unsigned char* ws = A.ws;
    const bf16_t* Q = (const bf16_t*)(ws + WS_Q); const bf16_t* K = (const bf16_t*)(ws + WS_K); const bf16_t* V = (const bf16_t*)(ws + WS_V);
    const bf16_t* KM = (const bf16_t*)(ws + WS_KM); const bf16_t* VM = (const bf16_t*)(ws + WS_VM); bf16_t* ATT = (bf16_t*)(ws + WS_ATT);
    const int tq = qb * 128 + 32 * w4 + r32;
    LAS unsigned char* qfl = lds + QF_OFF + wave * 4096 + lane * 16;
    { const bf16_t* qp = Q + ((size_t)(b * 8 + h) * SEQ + tq) * 128 + c * 64 + 8 * hh;
#pragma unroll
      for (int ds = 0; ds < 4; ++ds) *(LAS bf16x8*)(qfl + ds * 1024) = *(const bf16x8*)(qp + 16 * ds); }
    f32x16 o[4];
#pragma unroll
    for (int d = 0; d < 4; ++d)
#pragma unroll
        for (int r = 0; r < 16; ++r) o[d][r] = 0.f;
    float l = 0.f;
    const int ntile = 2 * qb + 3;
    const int srow = tid >> 3, sch = tid & 7;
    u32x4 st[4];
#define ATT_LOAD(kt) do { const bf16_t* kr; const bf16_t* vr; if ((kt) == 0) { kr = KM + (size_t)srow * AW + h * 128; vr = VM + (size_t)srow * AW + h * 128; } \
        else { const size_t row = ((size_t)(b * 8 + h) * SEQ + ((kt) - 1) * 64 + srow) * 128; kr = K + row; vr = V + row; } \
        kr += sch * 8; vr += sch * 8; st[0] = *(const u32x4*)kr; st[1] = *(const u32x4*)(kr + 64); st[2] = *(const u32x4*)vr; st[3] = *(const u32x4*)(vr + 64); } while (0)
#define ATT_STORE(buf) do { LAS unsigned char* kb_ = lds + (buf) * STG + srow * KP + sch * 16; LAS unsigned char* vb_ = lds + (buf) * STG + KBUF + srow * VP + sch * 16; \
        *(LAS u32x4*)kb_ = st[0]; *(LAS u32x4*)(kb_ + 128) = st[1]; *(LAS u32x4*)vb_ = st[2]; *(LAS u32x4*)(vb_ + 128) = st[3]; } while (0)
    ATT_LOAD(0); ATT_STORE(0);
    __syncthreads();
    const int koff = r32 * KP + (c * 64 + 8 * hh) * 2;
    const int voff = (4 * hh + ((lane & 15) >> 2)) * VP + (16 * ((lane >> 4) & 1) + 4 * (lane & 3)) * 2;
    const float NEG = -INFINITY;
#pragma unroll 1
    for (int kt = 0; kt < ntile; ++kt) {
        const int cur = kt & 1;
        if (kt + 1 < ntile) ATT_LOAD(kt + 1);
        const LAS unsigned char* Kb = lds + cur * STG + koff; const LAS unsigned char* Vb = lds + cur * STG + KBUF + voff;
        f32x16 p0, p1;
#pragma unroll
        for (int r = 0; r < 16; ++r) { p0[r] = -Mb; p1[r] = -Mb; }
#pragma unroll
        for (int ds = 0; ds < 4; ++ds) {
            const bf16x8 a0 = *(const LAS bf16x8*)(Kb + ds * 32), a1 = *(const LAS bf16x8*)(Kb + 32 * KP + ds * 32);
            const bf16x8 qv = *(const LAS bf16x8*)(qfl + ds * 1024);
            p0 = __builtin_amdgcn_mfma_f32_32x32x16_bf16(a0, qv, p0, 0, 0, 0);
            p1 = __builtin_amdgcn_mfma_f32_32x32x16_bf16(a1, qv, p1, 0, 0, 0);
        }
        if (kt == 0) {
#pragma unroll
            for (int r = 0; r < 16; ++r) { if (r >= 8) p0[r] = NEG; p1[r] = NEG; }
        } else if (kt - 1 >= 2 * qb) {
            const int lim = tq - (kt - 1) * 64 - 4 * hh;
#pragma unroll
            for (int r = 0; r < 16; ++r) { const int kc = (r & 3) + 8 * (r >> 2); if (kc > lim) p0[r] = NEG; if (kc + 32 > lim) p1[r] = NEG; }
        }
        float sacc = 0.f;
#pragma unroll
        for (int r = 0; r < 16; ++r) { p0[r] = __builtin_amdgcn_exp2f(p0[r]); p1[r] = __builtin_amdgcn_exp2f(p1[r]); sacc += p0[r] + p1[r]; }
        l += sacc;
        bf16x8 pa[4];
        { u32x4 w;
          w.x = cvtpk(p0[0], p0[1]); w.y = cvtpk(p0[2], p0[3]); w.z = cvtpk(p0[4], p0[5]); w.w = cvtpk(p0[6], p0[7]); pa[0] = __builtin_bit_cast(bf16x8, w);
          w.x = cvtpk(p0[8], p0[9]); w.y = cvtpk(p0[10], p0[11]); w.z = cvtpk(p0[12], p0[13]); w.w = cvtpk(p0[14], p0[15]); pa[1] = __builtin_bit_cast(bf16x8, w);
          w.x = cvtpk(p1[0], p1[1]); w.y = cvtpk(p1[2], p1[3]); w.z = cvtpk(p1[4], p1[5]); w.w = cvtpk(p1[6], p1[7]); pa[2] = __builtin_bit_cast(bf16x8, w);
          w.x = cvtpk(p1[8], p1[9]); w.y = cvtpk(p1[10], p1[11]); w.z = cvtpk(p1[12], p1[13]); w.w = cvtpk(p1[14], p1[15]); pa[3] = __builtin_bit_cast(bf16x8, w); }
        __builtin_amdgcn_sched_barrier(0);
        __builtin_amdgcn_s_setprio(1);
#pragma unroll
        for (int db = 0; db < 4; ++db) {
            s16x4 lo[4], hi[4];
#pragma unroll
            for (int ks = 0; ks < 4; ++ks) { lo[ks] = vtr(Vb + (16 * ks) * VP + db * 64); hi[ks] = vtr(Vb + (16 * ks + 8) * VP + db * 64); }
#pragma unroll
            for (int ks = 0; ks < 4; ++ks) {
                const bf16x8 vf = (bf16x8){lo[ks][0], lo[ks][1], lo[ks][2], lo[ks][3], hi[ks][0], hi[ks][1], hi[ks][2], hi[ks][3]};
                o[db] = __builtin_amdgcn_mfma_f32_32x32x16_bf16(pa[ks], vf, o[db], 0, 0, 0);
            }
        }
        __builtin_amdgcn_s_setprio(0);
        if (kt + 1 < ntile) ATT_STORE(cur ^ 1);
        __syncthreads();
    }
#undef ATT_LOAD
#undef ATT_STORE
    l += __shfl_xor(l, 32);
    LAS float* wsl = (LAS float*)(lds + WSL_OFF);
    LAS float* X = (LAS float*)(lds + X_OFF);
    if (hh == 0) wsl[c * 128 + 32 * w4 + r32] = (c == 0 ? 1.0f : lam) / l;
    __syncthreads();
    if (c == 1) {
#pragma unroll
        for (int r = 0; r < 16; ++r) { const int ql = 32 * w4 + crow(r, hh); const float sc = wsl[128 + ql];
#pragma unroll
            for (int db = 0; db < 4; ++db) X[ql * 128 + 32 * db + r32] = o[db][r] * sc;
            if ((r & 3) == 3) __builtin_amdgcn_sched_barrier(0); }
    }
    __syncthreads();
    if (c == 0) {
        LAS bf16_t* ost = (LAS bf16_t*)(lds + OST_OFF + w4 * 8192);
        float gsub[4];
#pragma unroll
        for (int db = 0; db < 4; ++db) gsub[db] = A.in[I_SUBLN][32 * db + r32] * (1.0f - LAM_INIT);
#pragma unroll
        for (int r = 0; r < 16; ++r) {
            const int qw = crow(r, hh), ql = 32 * w4 + qw; const float sc = wsl[ql];
            float d[4], ss = 0.f;
#pragma unroll
            for (int db = 0; db < 4; ++db) { d[db] = o[db][r] * sc - X[ql * 128 + 32 * db + r32]; ss += d[db] * d[db]; }
            ss = row_sum16(ss); ss += __shfl_xor(ss, 16);
            const float rs = rsqrtf(ss * (1.0f / 128.0f) + EPS);
#pragma unroll
            for (int db = 0; db < 4; ++db) ost[qw * 128 + 32 * db + r32] = (bf16_t)f2bf(d[db] * rs * gsub[db]);
            if ((r & 3) == 3) __builtin_amdgcn_sched_barrier(0);
        }
        asm volatile("s_waitcnt lgkmcnt(0)" ::: "memory");
#pragma unroll
        for (int it = 0; it < 8; ++it) { const int row = it * 4 + (lane >> 4), ch = lane & 15;
            const u32x4 v = *(const LAS u32x4*)(ost + row * 128 + ch * 8);
            *(u32x4*)(ATT + (size_t)(b * SEQ + qb * 128 + 32 * w4 + row) * AW + h * 128 + ch * 8) = v; }
    }
    __syncthreads();
}
__device__ __forceinline__ void attn_phase(const Args& A, LAS unsigned char* lds, int G) {
    const float* par = (const float*)(A.ws + WS_PAR); const float lam = par[0], Mb = par[1];
    const int bx = blockIdx.x, vcu = (G % 8 == 0) ? (bx % 8) * (G / 8) + bx / 8 : bx;
    for (int item = vcu; item < 256; item += G) {
        const int bh = item >> 4, pr = item & 15;
#pragma unroll 1
        for (int u2 = 0; u2 < 2; ++u2) attn_unit(A, bh >> 3, bh & 7, u2 ? pr : 31 - pr, lds, lam, Mb);
    }
}
}

__device__ __forceinline__ float gelu_as(float v) {
    const float av = fabsf(v), t = __builtin_amdgcn_rcpf(av * 0.2316418882f + 1.0f);
    float q = t * 0.5307027145f + (-0.7265760135f); q = q * t + 0.7107068705f; q = q * t + (-0.142248368f); q = q * t + 0.127414796f; q = q * t;
    const float e = __builtin_amdgcn_exp2f((v * v) * (-0.72134752044f)), m = v * (q * e);
    return v < 0.f ? m : v - m;
}

namespace ssm {
typedef float f32x16 __attribute__((ext_vector_type(16)));
constexpr int L_APOW = 0, L_BB = 8704, L_CC = L_BB + 8192, L_KT = L_CC + 8192, L_DS = L_KT + 16384, L_XIN = L_DS + 64, XPITCH = 272, XBLK = 32 * XPITCH;
static_assert(L_XIN + 8 * XBLK <= RING_BYTES, "ssm LDS map");
__device__ __forceinline__ unsigned cvtpk(float lo, float hi) { f32x2 v = {lo, hi}; bf16x2_t b = __builtin_convertvector(v, bf16x2_t); return __builtin_bit_cast(unsigned, b); }
__device__ __forceinline__ void ssm_mm_phase(const Args& A, LAS unsigned char* lds, int G, int probe = 0) {
    const int tid = otid(), lane = tid & 63, wave = __builtin_amdgcn_readfirstlane(tid >> 6), r32 = lane & 31, hh = lane >> 5;
    unsigned char* ws = A.ws;
    const bf16_t* UB = (const bf16_t*)(ws + WS_UB); const bf16_t* UMB = (const bf16_t*)(ws + WS_UMB); bf16_t* YS = (bf16_t*)(ws + WS_YS);
    const float* abar = (const float*)(ws + WS_ABAR); const float* bbar = (const float*)(ws + WS_BBAR);
    LAS float* apow = (LAS float*)(lds + L_APOW); LAS float* Bb = (LAS float*)(lds + L_BB); LAS float* Cc = (LAS float*)(lds + L_CC); LAS float* Kt = (LAS float*)(lds + L_KT);
    if (blockIdx.x < 128) {
        const int item = blockIdx.x, b = item >> 6, g = item & 63;
        __syncthreads();
        if (tid < 64) { const float ar = abar[(g * 64 + tid) * 2], ai = abar[(g * 64 + tid) * 2 + 1]; float pr = 1.f, pi = 0.f;
            for (int t = 0; t <= 16; ++t) { apow[(t * 64 + tid) * 2] = pr; apow[(t * 64 + tid) * 2 + 1] = pi; const float nr = pr * ar - pi * ai, ni = pr * ai + pi * ar; pr = nr; pi = ni; } }
        *(LAS f32x4*)(Bb + 4 * tid) = *(const f32x4*)(bbar + (size_t)g * 2048 + 4 * tid);
        if (tid < 16) ((LAS float*)(lds + L_DS))[tid] = A.in[I_SSMD][g * 16 + tid];
#pragma unroll
        for (int q = 0; q < 2; ++q) { const int idx = 2 * tid + q, cc_ = idx >> 6, pp_ = idx & 63;
            Cc[(pp_ * 16 + cc_) * 2] = A.in[I_CRE][g * 1024 + idx]; Cc[(pp_ * 16 + cc_) * 2 + 1] = A.in[I_CIM][g * 1024 + idx]; }
        __syncthreads();
        { const int tau = tid >> 5, c = (tid >> 1) & 15, ch = tid & 1; float acc[8];
#pragma unroll
          for (int i = 0; i < 8; ++i) acc[i] = 0.f;
          for (int p = 0; p < 64; ++p) {
              const float cr = Cc[(p * 16 + c) * 2], ci = Cc[(p * 16 + c) * 2 + 1], ar = apow[(tau * 64 + p) * 2], ai = apow[(tau * 64 + p) * 2 + 1];
              const float wr = cr * ar - ci * ai, wi = cr * ai + ci * ar;
              const LAS f32x4* bp = (const LAS f32x4*)(Bb + (p * 16 + 8 * ch) * 2);
#pragma unroll
              for (int q = 0; q < 4; ++q) { const f32x4 bv = bp[q]; acc[2 * q] += wr * bv[0] - wi * bv[1]; acc[2 * q + 1] += wr * bv[2] - wi * bv[3]; }
          }
#pragma unroll
          for (int i = 0; i < 8; ++i) Kt[(tau * 16 + c) * 16 + 8 * ch + i] = acc[i]; }
        __syncthreads();
        if (probe == 3) return;
        if (wave < 4) {
            const int mb = wave;
            bf16x8 pf[16];
            { const int p = 16 * mb + (r32 >> 1), ri = r32 & 1;
#pragma unroll
              for (int sstep = 0; sstep < 16; ++sstep) {
                  const float ar = apow[((15 - sstep) * 64 + p) * 2], ai = apow[((15 - sstep) * 64 + p) * 2 + 1];
                  const float ca = ri ? ai : ar, cb_ = ri ? ar : -ai;
                  const LAS f32x4* bp = (const LAS f32x4*)(Bb + (p * 16 + 8 * hh) * 2); float v[8];
#pragma unroll
                  for (int q = 0; q < 4; ++q) { const f32x4 bv = bp[q]; v[2 * q] = ca * bv[0] + cb_ * bv[1]; v[2 * q + 1] = ca * bv[2] + cb_ * bv[3]; }
                  u32x4 w; w.x = cvtpk(v[0], v[1]); w.y = cvtpk(v[2], v[3]); w.z = cvtpk(v[4], v[5]); w.w = cvtpk(v[6], v[7]); pf[sstep] = __builtin_bit_cast(bf16x8, w);
                  if ((sstep & 3) == 3) __builtin_amdgcn_sched_barrier(0); } }
            const int pst = 16 * mb + (r32 >> 1);
            const float sca = apow[(16 * 64 + pst) * 2], scb = (r32 & 1) ? apow[(16 * 64 + pst) * 2 + 1] : -apow[(16 * 64 + pst) * 2 + 1];
            const int sig = (r32 & 3) + 4 * (r32 >> 3) + 16 * ((r32 >> 2) & 1);
            float xc;
            { f32x16 acc;
#pragma unroll
              for (int r = 0; r < 16; ++r) acc[r] = 0.f;
#pragma unroll
              for (int sstep = 0; sstep < 16; ++sstep) { const bf16x8 bf = *(const bf16x8*)(UMB + (size_t)sstep * SW + g * 16 + 8 * hh); acc = __builtin_amdgcn_mfma_f32_32x32x16_bf16(bf, pf[sstep], acc, 0, 0, 0); }
              xc = acc[0]; }
            bf16x8 ufr[16];
            { const bf16_t* up = UB + ((size_t)(b * 64 + g) * SEQ + 16 * sig) * 16 + 8 * hh;
#pragma unroll
              for (int sstep = 0; sstep < 16; ++sstep) ufr[sstep] = *(const bf16x8*)(up + sstep * 16); }
#pragma unroll 1
            for (int cb = 0; cb < 8; ++cb) {
                f32x16 acc;
#pragma unroll
                for (int r = 0; r < 16; ++r) acc[r] = 0.f;
#pragma unroll
                for (int sstep = 0; sstep < 16; ++sstep) acc = __builtin_amdgcn_mfma_f32_32x32x16_bf16(ufr[sstep], pf[sstep], acc, 0, 0, 0);
                if (cb + 1 < 8) {
                    const bf16_t* up = UB + ((size_t)(b * 64 + g) * SEQ + 16 * (32 * (cb + 1) + sig)) * 16 + 8 * hh;
#pragma unroll
                    for (int sstep = 0; sstep < 16; ++sstep) ufr[sstep] = *(const bf16x8*)(up + sstep * 16);
                }
                float xin[16]; float xs_ = hh ? 0.f : xc;
#pragma unroll
                for (int r = 0; r < 16; ++r) { xin[r] = xs_; const float pv = dpp_f<0xB1>(xs_); xs_ = sca * xs_ + scb * pv + acc[r]; }
                float f = __shfl_xor(xs_, 32); if (!hh) f = 0.f;
#pragma unroll
                for (int r = 0; r < 16; ++r) { xin[r] += f; const float pv = dpp_f<0xB1>(f); f = sca * f + scb * pv; }
                xs_ += f;
                xc = __shfl_xor(xs_, 32);
                LAS bf16_t* xo = (LAS bf16_t*)(lds + L_XIN + cb * XBLK + (16 * hh) * XPITCH) + 32 * mb + r32;
#pragma unroll
                for (int r = 0; r < 16; ++r) xo[r * (XPITCH / 2)] = (bf16_t)f2bf(xin[r]);
            }
        }
        __syncthreads();
        if (probe == 4) return;
        {
            const int cb = wave, tl = r32 >> 4, c = r32 & 15;
            const size_t row0 = (size_t)(b * SEQ + 16 * (32 * cb + r32));
            bf16x8 ufr[16];
            { const bf16_t* up = UB + ((size_t)(b * 64 + g) * SEQ + 16 * (32 * cb + r32)) * 16 + 8 * hh;
#pragma unroll
              for (int ks = 0; ks < 16; ++ks) ufr[ks] = *(const bf16x8*)(up + ks * 16); }
            bf16x8 kl[16];
#pragma unroll
            for (int d1 = 0; d1 < 16; ++d1) {
                const int tau = d1 - 1 + tl; float v[8];
                if (tau >= 0) { const LAS f32x4* kp = (const LAS f32x4*)(Kt + (tau * 16 + c) * 16 + 8 * hh); const f32x4 k0 = kp[0], k1 = kp[1];
                    v[0] = k0[0]; v[1] = k0[1]; v[2] = k0[2]; v[3] = k0[3]; v[4] = k1[0]; v[5] = k1[1]; v[6] = k1[2]; v[7] = k1[3]; }
                else {
#pragma unroll
                    for (int i = 0; i < 8; ++i) v[i] = 0.f; }
                u32x4 wv; wv.x = cvtpk(v[0], v[1]); wv.y = cvtpk(v[2], v[3]); wv.z = cvtpk(v[4], v[5]); wv.w = cvtpk(v[6], v[7]); kl[d1] = __builtin_bit_cast(bf16x8, wv);
                if ((d1 & 3) == 3) __builtin_amdgcn_sched_barrier(0);
            }
            const LAS unsigned char* xi_ = lds + L_XIN + cb * XBLK + r32 * XPITCH + 16 * hh;
#pragma unroll
            for (int mb = 0; mb < 8; ++mb) {
                int dq = 4 * hh; asm volatile("" : "+v"(dq));
                const f32x4 d0 = *(const LAS f32x4*)((LAS float*)(lds + L_DS) + dq), d1 = *(const LAS f32x4*)((LAS float*)(lds + L_DS) + dq + 8);
                const float dsk[8] = {d0[0], d0[1], d0[2], d0[3], d1[0], d1[1], d1[2], d1[3]};
                f32x16 acc;
#pragma unroll
                for (int r = 0; r < 16; ++r) acc[r] = 0.f;
#pragma unroll
                for (int ks = 0; ks < 16; ++ks) if (ks <= 2 * mb + 1) acc = __builtin_amdgcn_mfma_f32_32x32x16_bf16(kl[2 * mb - ks + 1], ufr[ks], acc, 0, 0, 0);
                { const bf16x8* qg = (const bf16x8*)(ws + WS_QG) + ((size_t)(g * 8 + mb) * 8) * 64 + lane;
                  bf16x8 qf[8];
#pragma unroll
                  for (int ks = 0; ks < 8; ++ks) qf[ks] = qg[ks * 64];
#pragma unroll
                  for (int ks = 0; ks < 8; ++ks) acc = __builtin_amdgcn_mfma_f32_32x32x16_bf16(qf[ks], *(const LAS bf16x8*)(xi_ + 32 * ks), acc, 0, 0, 0); }
#pragma unroll
                for (int t2 = 0; t2 < 2; ++t2) {
                    const u32x4 uf = __builtin_bit_cast(u32x4, ufr[2 * mb + t2]);
                    const unsigned s0 = hh ? uf.x : uf.z, s1 = hh ? uf.y : uf.w;
                    const unsigned r0 = (unsigned)__shfl_xor((int)s0, 32), r1 = (unsigned)__shfl_xor((int)s1, 32);
                    const unsigned own0 = hh ? uf.z : uf.x, own1 = hh ? uf.w : uf.y;
                    const unsigned c0a = hh ? r0 : own0, c0b = hh ? r1 : own1, c1a = hh ? own0 : r0, c1b = hh ? own1 : r1;
                    const unsigned ua[2] = {c0a, c1a}, ub[2] = {c0b, c1b};
#pragma unroll
                    for (int ch = 0; ch < 2; ++ch) {
                        const size_t off = (row0 + 2 * mb + t2) * SW + g * 16 + 4 * hh + 8 * ch;
                        const float y0 = gelu_as(acc[8 * t2 + 4 * ch + 0] + dsk[4 * ch + 0] * bflo(ua[ch])), y1 = gelu_as(acc[8 * t2 + 4 * ch + 1] + dsk[4 * ch + 1] * bfhi(ua[ch]));
                        const float y2 = gelu_as(acc[8 * t2 + 4 * ch + 2] + dsk[4 * ch + 2] * bflo(ub[ch])), y3 = gelu_as(acc[8 * t2 + 4 * ch + 3] + dsk[4 * ch + 3] * bfhi(ub[ch]));
                        u32x2 o; o.x = cvtpk(y0, y1); o.y = cvtpk(y2, y3); *(u32x2*)(YS + off) = o;
                    }
                }
                __builtin_amdgcn_sched_barrier(0);
            }
        }
    }
}
}

namespace tk {
typedef float f32x16 __attribute__((ext_vector_type(16)));
__device__ __forceinline__ unsigned fkey(float f) { const unsigned u = __builtin_bit_cast(unsigned, f); return (u & 0x80000000u) ? ~u : (u | 0x80000000u); }
__device__ __forceinline__ float kval(unsigned k) { const unsigned u = (k & 0x80000000u) ? (k & 0x7fffffffu) : ~k; return __builtin_bit_cast(float, u); }
__device__ __forceinline__ void ce(unsigned& a, unsigned& b) { const unsigned hi = a > b ? a : b, lo = a > b ? b : a; a = hi; b = lo; }
template <int N> __device__ __forceinline__ void sort_desc(unsigned (&a)[N]) {
#pragma unroll
    for (int k = 2; k <= N; k <<= 1)
#pragma unroll
        for (int j = k >> 1; j > 0; j >>= 1)
#pragma unroll
            for (int i = 0; i < N; ++i) { const int l = i ^ j; if (l > i) { if ((i & k) == 0) ce(a[i], a[l]); else ce(a[l], a[i]); } }
}
__device__ __forceinline__ void merge_top16(unsigned (&a)[16], const unsigned (&b)[16]) {
#pragma unroll
    for (int i = 0; i < 16; ++i) a[i] = a[i] > b[15 - i] ? a[i] : b[15 - i];
#pragma unroll
    for (int j = 8; j > 0; j >>= 1)
#pragma unroll
        for (int i = 0; i < 16; ++i) { const int l = i ^ j; if (l > i) ce(a[i], a[l]); }
}
__device__ __forceinline__ void peer_topk_phase(const Args& A, LAS unsigned char* lds, int G, bool qlds, const pg8::PanelOrder& S5) {
    const int tid = otid(), lane = tid & 63, wave = __builtin_amdgcn_readfirstlane(tid >> 6), r32 = lane & 31, hh = lane >> 5;
    unsigned char* ws = A.ws;
    const bf16_t* QP = (const bf16_t*)(ws + WS_QP); const bf16_t* K12 = (const bf16_t*)(ws + WS_K12); int* IDX = (int*)(ws + WS_IDX); float* GW = (float*)(ws + WS_GW);
    LAS unsigned* tl = (LAS unsigned*)(lds + wave * 32 * QPT_PITCH);
    pg8::Unit u5;
    for (int ui = 0; S5.next(ui, u5); ++ui) {
        const int h = u5.pn, tb = u5.pm * 8 + wave, tok = tb * 32 + r32;
        if (!qlds) {
            __syncthreads();
            for (int i = tid; i < 256 * 32; i += NTHREADS) { const int row = i >> 5, ch = i & 31;
                *(LAS u32x4*)(lds + row * QPT_PITCH + ch * 16) = *(const u32x4*)(QP + (size_t)(u5.pm * 256 + row) * DM + h * 256 + ch * 8); }
            __syncthreads();
        }
        unsigned lst[2][16];
#pragma unroll
        for (int half = 0; half < 2; ++half) {
            const bf16_t* qp = QP + (size_t)tok * DM + h * 256 + half * 128 + 8 * hh;
            const bf16_t* kp = K12 + ((size_t)(half * 8 + h) * 128 + r32) * 128 + 8 * hh;
            bf16x8 qf[8];
#pragma unroll
            for (int ds = 0; ds < 8; ++ds) qf[ds] = *(const LAS bf16x8*)(lds + (wave * 32 + r32) * QPT_PITCH + (half * 128 + 16 * ds + 8 * hh) * 2);
            f32x16 sc[4];
#pragma unroll
            for (int kb = 0; kb < 4; ++kb) {
#pragma unroll
                for (int r = 0; r < 16; ++r) sc[kb][r] = 0.f;
#pragma unroll
                for (int ds = 0; ds < 8; ++ds) { const bf16x8 kf = *(const bf16x8*)(kp + (size_t)kb * 32 * 128 + 16 * ds); sc[kb] = __builtin_amdgcn_mfma_f32_32x32x16_bf16(kf, qf[ds], sc[kb], 0, 0, 0); }
            }
            unsigned g0[16], g1[16];
#pragma unroll
            for (int r = 0; r < 16; ++r) { const int kc = (r & 3) + 8 * (r >> 2) + 4 * hh; g0[r] = (fkey(sc[0][r]) & ~127u) | (unsigned)(127 - kc); g1[r] = (fkey(sc[1][r]) & ~127u) | (unsigned)(127 - 32 - kc); }
            sort_desc<16>(g0); sort_desc<16>(g1); merge_top16(g0, g1);
#pragma unroll
            for (int r = 0; r < 16; ++r) { const int kc = (r & 3) + 8 * (r >> 2) + 4 * hh; lst[half][r] = (fkey(sc[2][r]) & ~127u) | (unsigned)(127 - 64 - kc); g1[r] = (fkey(sc[3][r]) & ~127u) | (unsigned)(127 - 96 - kc); }
            sort_desc<16>(lst[half]); sort_desc<16>(g1); merge_top16(lst[half], g1); merge_top16(lst[half], g0);
        }
        unsigned mine[16], oth[16];
#pragma unroll
        for (int i = 0; i < 16; ++i) { const unsigned send = hh ? lst[0][i] : lst[1][i]; mine[i] = hh ? lst[1][i] : lst[0][i]; oth[i] = (unsigned)__shfl_xor((int)send, 32); }
        merge_top16(mine, oth);
#pragma unroll
        for (int i = 0; i < 16; ++i) tl[(16 * hh + i) * 64 + r32] = mine[i];
        asm volatile("s_waitcnt lgkmcnt(0)" ::: "memory");
        float v1[16], v2[16];
#pragma unroll
        for (int i = 0; i < 16; ++i) { v1[i] = kval(tl[i * 64 + r32] & ~127u); v2[i] = kval(tl[(16 + i) * 64 + r32] & ~127u); }
#define CKEY(i, j) ((fkey(v1[i] + v2[j]) & ~255u) | (unsigned)(255 - (16 * (i) + (j))))
        unsigned c0[16], c1[16];
#pragma unroll
        for (int j = 0; j < 16; ++j) c0[j] = CKEY(0, j);
#pragma unroll
        for (int j = 0; j < 8; ++j) c1[j] = CKEY(1, j);
#pragma unroll
        for (int j = 0; j < 5; ++j) c1[8 + j] = CKEY(2, j);
        c1[13] = CKEY(3, 0); c1[14] = CKEY(3, 1); c1[15] = CKEY(3, 2);
        sort_desc<16>(c1); merge_top16(c0, c1);
        c1[0] = CKEY(3, 3); c1[1] = CKEY(4, 0); c1[2] = CKEY(4, 1); c1[3] = CKEY(4, 2); c1[4] = CKEY(5, 0); c1[5] = CKEY(5, 1); c1[6] = CKEY(6, 0); c1[7] = CKEY(6, 1);
        c1[8] = CKEY(7, 0); c1[9] = CKEY(7, 1); c1[10] = CKEY(8, 0); c1[11] = CKEY(9, 0); c1[12] = CKEY(10, 0); c1[13] = CKEY(11, 0); c1[14] = CKEY(12, 0); c1[15] = CKEY(13, 0);
        sort_desc<16>(c1); merge_top16(c0, c1);
        c1[0] = CKEY(14, 0); c1[1] = CKEY(15, 0);
#pragma unroll
        for (int i = 2; i < 16; ++i) c1[i] = 0u;
        sort_desc<16>(c1); merge_top16(c0, c1);
#undef CKEY
        float ev[16], se = 0.f; const float mx = kval(c0[0] & ~255u);
#pragma unroll
        for (int k = 0; k < 16; ++k) { ev[k] = __expf(kval(c0[k] & ~255u) - mx); se += ev[k]; }
        const float inv = 1.0f / se;
        if (hh == 0) {
            int ex[16];
#pragma unroll
            for (int k = 0; k < 16; ++k) { const int cid = 255 - (int)(c0[k] & 255u), i = cid >> 4, j = cid & 15;
                const int e1 = 127 - (int)(tl[i * 64 + r32] & 127u), e2 = 127 - (int)(tl[(16 + j) * 64 + r32] & 127u); ex[k] = e1 * 128 + e2; }
            unsigned short* ip = (unsigned short*)IDX + (size_t)tok * 128 + h * 16;
#pragma unroll
            for (int k = 0; k < 16; k += 8) *(u32x4*)(ip + k) = (u32x4){(unsigned)ex[k] | ((unsigned)ex[k + 1] << 16), (unsigned)ex[k + 2] | ((unsigned)ex[k + 3] << 16), (unsigned)ex[k + 4] | ((unsigned)ex[k + 5] << 16), (unsigned)ex[k + 6] | ((unsigned)ex[k + 7] << 16)};
        } else {
            float* gp = GW + (size_t)tok * 128 + h * 16;
#pragma unroll
            for (int k = 0; k < 16; k += 4) *(f32x4*)(gp + k) = (f32x4){ev[k] * inv, ev[k + 1] * inv, ev[k + 2] * inv, ev[k + 3] * inv};
        }
        asm volatile("s_waitcnt lgkmcnt(0)" ::: "memory");
    }
}
}

#define XB_TMO      128
#define XB_XCNT(j)  (256  + 64 * (j))
#define XB_XSUB(j)  (1280 + 64 * (j))
#define XB_XGEN(j)  (2304 + 64 * (j))
#define XB_TOP      3328
#define XB_TOPGEN   3392
#define XCD_BAR_WORDS 3456
#define XB_SPIN_CAP (1u << 18)
__device__ __forceinline__ unsigned xb_ld(unsigned* p)              { return __hip_atomic_load(p, __ATOMIC_RELAXED, __HIP_MEMORY_SCOPE_AGENT); }
__device__ __forceinline__ unsigned xb_add(unsigned* p, unsigned v) { return __hip_atomic_fetch_add(p, v, __ATOMIC_RELAXED, __HIP_MEMORY_SCOPE_AGENT); }
__device__ __forceinline__ unsigned xb_xcc_id() { return (unsigned)__builtin_amdgcn_s_getreg((3 << 11) | 20) & 0xFu; }
#define XB_SPIN(cond, bar) do { unsigned _sp = 0; while (cond) { __builtin_amdgcn_s_sleep(0); \
    if ((++_sp & 255u) == 0u) { if (xb_ld(&(bar)[XB_TMO])) break; if (_sp > XB_SPIN_CAP) { atomicAdd(&(bar)[XB_TMO], 1u); break; } } } } while (0)
struct XcdBarrier { unsigned* bar; unsigned x; volatile LAS unsigned* st; };
__device__ __forceinline__ XcdBarrier xcd_barrier_post(unsigned* bar, volatile LAS unsigned* st) {
    XcdBarrier b; b.bar = bar; b.x = xb_xcc_id(); b.st = st;
    if (threadIdx.x == 0) st[3] = xb_add(&bar[XB_XCNT(b.x)], 1u);
    return b;
}
__device__ __forceinline__ void xcd_barrier_complete(unsigned* bar, unsigned x, unsigned& nloc, unsigned& nx) {
    const unsigned G = gridDim.x * gridDim.y * gridDim.z;
    unsigned sum, cnt, mine, sp = 0u;
    for (;;) {
        sum = 0u; cnt = 0u; mine = 0u;
#pragma unroll
        for (unsigned j = 0; j < 16; ++j) { const unsigned c = xb_ld(&bar[XB_XCNT(j)]); sum += c; cnt += (c > 0u) ? 1u : 0u; mine = (j == x) ? c : mine; }
        if (sum == G) break;
        __builtin_amdgcn_s_sleep(1);
        if ((++sp & 255u) == 0u) { if (xb_ld(&bar[XB_TMO])) break; if (sp > XB_SPIN_CAP) { atomicAdd(&bar[XB_TMO], 1u); break; } }
    }
    nloc = mine > 0u ? mine : 1u; nx = cnt > 0u ? cnt : 1u;
}
__device__ __forceinline__ void xcd_barrier(const XcdBarrier& b) {
    asm volatile("s_waitcnt vmcnt(0)" ::: "memory");
    __syncthreads();
    if (threadIdx.x == 0) {
        unsigned* bar = b.bar;
        __builtin_amdgcn_s_waitcnt(0);
        unsigned nloc = b.st[0], nx = b.st[1];
        if (nloc == 0u) { xcd_barrier_complete(bar, b.x, nloc, nx); b.st[0] = nloc; b.st[1] = nx; }
        const unsigned old = xb_add(&bar[XB_XSUB(b.x)], 1u);
        const unsigned gen = old / nloc;
        if (old + 1u == (gen + 1u) * nloc) {
            __builtin_amdgcn_fence(__ATOMIC_RELEASE, "agent");
            asm volatile("s_waitcnt vmcnt(0)" ::: "memory");
            const unsigned og = xb_add(&bar[XB_TOP], 1u);
            const unsigned tg = og / nx;
            if (og + 1u == (tg + 1u) * nx) xb_add(&bar[XB_TOPGEN], 1u);
            else XB_SPIN(xb_ld(&bar[XB_TOPGEN]) == tg, bar);
            __builtin_amdgcn_fence(__ATOMIC_ACQUIRE, "agent");
            xb_add(&bar[XB_XGEN(b.x)], 1u);
            asm volatile("s_waitcnt vmcnt(0)" ::: "memory");
        } else {
            XB_SPIN(xb_ld(&bar[XB_XGEN(b.x)]) == gen, bar);
            __builtin_amdgcn_fence(__ATOMIC_ACQUIRE, "agent");
            asm volatile("s_waitcnt vmcnt(0)" ::: "memory");
        }
    }
    __syncthreads();
}
__device__ __forceinline__ void xcc_local_barrier(unsigned* cnt, unsigned nloc, unsigned* bar) {
    asm volatile("s_waitcnt vmcnt(0)" ::: "memory");
    __syncthreads();
    if (threadIdx.x == 0) {
        const unsigned old = xb_add(cnt, 1u);
        const unsigned target = (old / nloc + 1u) * nloc;
        XB_SPIN(xb_ld(cnt) < target, bar);
        __builtin_amdgcn_fence(__ATOMIC_ACQUIRE, "agent");
        asm volatile("s_waitcnt vmcnt(0)" ::: "memory");
    }
    __syncthreads();
}

namespace sg {
constexpr int NSL = 16, SLW = 128, TBK = 64, NTB = MTOK / TBK, TPW = TBK / NWAVES;
constexpr int CW_U = 8192, CW_V = 8192 + 64 * NSL;
template <int D> __device__ __forceinline__ float xsl(float a, float b, bool bit, int ln) { const float send = bit ? a : b, keep = bit ? b : a;
    return keep + __builtin_bit_cast(float, __builtin_amdgcn_ds_bpermute((ln ^ D) << 2, __builtin_bit_cast(int, send))); }
template <int D> __device__ __forceinline__ float xs(float a, float b, bool bit) { const float send = bit ? a : b, keep = bit ? b : a; return keep + __shfl_xor(send, D); }
__device__ __forceinline__ void quant_rows(const Args& A, int G, int prow = -1) {
    const int tid = otid(), lane = tid & 63, wave = __builtin_amdgcn_readfirstlane(tid >> 6);
    unsigned char* ws = A.ws; const bf16_t* H2G = (const bf16_t*)(ws + WS_XN); const float* PARTSS = (const float*)(ws + WS_PARTSS);
    const int NW = G * NWAVES;
    const int rstep = prow >= 0 ? 1 : NW;
    for (int r0 = prow >= 0 ? prow : blockIdx.x * NWAVES + wave; r0 < MTOK; r0 += prow >= 0 ? MTOK : 4 * NW) {
        u32x4 hb[4][4]; float ssq[4];
#pragma unroll
        for (int q = 0; q < 4; ++q) { const int r = r0 + q * rstep; const bool ok = r < MTOK; const u32x4* hp = (const u32x4*)(H2G + (size_t)(ok ? r : r0) * DM) + lane;
#pragma unroll
            for (int j = 0; j < 4; ++j) hb[q][j] = hp[64 * j];
            ssq[q] = (lane < 32) ? PARTSS[(size_t)lane * MTOK + (ok ? r : r0)] : 0.f; }
        asm volatile("" ::: "memory");
#pragma unroll
        for (int q = 0; q < 4; ++q) {
            const int r = r0 + q * rstep; if (r >= MTOK) break;
            const float rs = rsqrtf(wave_sum(ssq[q]) * (1.0f / DM) + EPS);
            float hm = 0.f;
#pragma unroll
            for (int j = 0; j < 4; ++j) { hm = fmaxf(hm, fmaxf(fmaxf(fabsf(bflo(hb[q][j].x)), fabsf(bfhi(hb[q][j].x))), fmaxf(fabsf(bflo(hb[q][j].y)), fabsf(bfhi(hb[q][j].y)))));
                hm = fmaxf(hm, fmaxf(fmaxf(fabsf(bflo(hb[q][j].z)), fabsf(bfhi(hb[q][j].z))), fmaxf(fabsf(bflo(hb[q][j].w)), fabsf(bfhi(hb[q][j].w))))); }
            hm = wave_max(hm);
            const float hinv = hm > 0.f ? 127.0f / hm : 0.f;
            u32x2* dst = (u32x2*)(ws + WS_HQ + (size_t)r * DM) + lane;
#pragma unroll
            for (int j = 0; j < 4; ++j) { const unsigned wd[4] = {hb[q][j].x, hb[q][j].y, hb[q][j].z, hb[q][j].w}; u32x2 o;
#pragma unroll
                for (int h2 = 0; h2 < 2; ++h2) { const int q0 = (int)rintf(bflo(wd[2 * h2]) * hinv), q1 = (int)rintf(bfhi(wd[2 * h2]) * hinv), q2 = (int)rintf(bflo(wd[2 * h2 + 1]) * hinv), q3 = (int)rintf(bfhi(wd[2 * h2 + 1]) * hinv);
                    const unsigned pk = (unsigned)(q0 & 255) | ((unsigned)(q1 & 255) << 8) | ((unsigned)(q2 & 255) << 16) | ((unsigned)(q3 & 255) << 24); if (h2 == 0) o.x = pk; else o.y = pk; }
                dst[64 * j] = o; }
            if (lane == 0) ((float*)(ws + WS_HT))[r] = hm * (1.0f / 127.0f) * rs;
        }
    }
}
template <int NCOL>
__device__ __forceinline__ void quant_pass(const bf16_t* src, unsigned char* dst, float* sc, int G, int prow = -1) {
    const int tid = otid(), lane = tid & 63, wave = __builtin_amdgcn_readfirstlane(tid >> 6);
    constexpr int NL = NCOL / 512;
    const int NW = prow >= 0 ? 1 : G * NWAVES;
    for (int r0 = prow >= 0 ? prow : blockIdx.x * NWAVES + wave; r0 < MTOK; r0 += prow >= 0 ? MTOK : 4 * NW) {
        u32x4 hb[4][NL];
#pragma unroll
        for (int q = 0; q < 4; ++q) { const int r = r0 + q * NW; const bool ok = r < MTOK; const u32x4* hp = (const u32x4*)(src + (size_t)(ok ? r : r0) * NCOL) + lane;
#pragma unroll
            for (int j = 0; j < NL; ++j) hb[q][j] = hp[64 * j]; }
        asm volatile("" ::: "memory");
#pragma unroll
        for (int q = 0; q < 4; ++q) {
            const int r = r0 + q * NW; if (r >= MTOK) break;
            float hm = 0.f;
#pragma unroll
            for (int j = 0; j < NL; ++j) { hm = fmaxf(hm, fmaxf(fmaxf(fabsf(bflo(hb[q][j].x)), fabsf(bfhi(hb[q][j].x))), fmaxf(fabsf(bflo(hb[q][j].y)), fabsf(bfhi(hb[q][j].y)))));
                hm = fmaxf(hm, fmaxf(fmaxf(fabsf(bflo(hb[q][j].z)), fabsf(bfhi(hb[q][j].z))), fmaxf(fabsf(bflo(hb[q][j].w)), fabsf(bfhi(hb[q][j].w))))); }
            hm = wave_max(hm);
            const float hinv = hm > 0.f ? 127.0f / hm : 0.f;
            u32x2* d = (u32x2*)(dst + (size_t)r * NCOL) + lane;
#pragma unroll
            for (int j = 0; j < NL; ++j) { const unsigned wd[4] = {hb[q][j].x, hb[q][j].y, hb[q][j].z, hb[q][j].w}; u32x2 o;
#pragma unroll
                for (int h2 = 0; h2 < 2; ++h2) { const int q0 = (int)rintf(bflo(wd[2 * h2]) * hinv), q1 = (int)rintf(bfhi(wd[2 * h2]) * hinv), q2 = (int)rintf(bflo(wd[2 * h2 + 1]) * hinv), q3 = (int)rintf(bfhi(wd[2 * h2 + 1]) * hinv);
                    const unsigned pk = (unsigned)(q0 & 255) | ((unsigned)(q1 & 255) << 8) | ((unsigned)(q2 & 255) << 16) | ((unsigned)q3 << 24); if (h2 == 0) o.x = pk; else o.y = pk; }
                d[64 * j] = o; }
            if (lane == 0) sc[r] = hm * (1.0f / 127.0f);
        }
    }
}
__device__ __forceinline__ void qrow1024(const u32x4 (&hb)[2], unsigned char* drow, float* sc, int lane) {
    float hm = 0.f;
#pragma unroll
    for (int j = 0; j < 2; ++j) { hm = fmaxf(hm, fmaxf(fmaxf(fabsf(bflo(hb[j].x)), fabsf(bfhi(hb[j].x))), fmaxf(fabsf(bflo(hb[j].y)), fabsf(bfhi(hb[j].y)))));
        hm = fmaxf(hm, fmaxf(fmaxf(fabsf(bflo(hb[j].z)), fabsf(bfhi(hb[j].z))), fmaxf(fabsf(bflo(hb[j].w)), fabsf(bfhi(hb[j].w))))); }
    hm = wave_max(hm);
    const float hinv = hm > 0.f ? 127.0f / hm : 0.f;
    u32x2* d = (u32x2*)drow + lane;
#pragma unroll
    for (int j = 0; j < 2; ++j) { const unsigned wd[4] = {hb[j].x, hb[j].y, hb[j].z, hb[j].w}; u32x2 o;
#pragma unroll
        for (int h2 = 0; h2 < 2; ++h2) { const int q0 = (int)rintf(bflo(wd[2 * h2]) * hinv), q1 = (int)rintf(bfhi(wd[2 * h2]) * hinv), q2 = (int)rintf(bflo(wd[2 * h2 + 1]) * hinv), q3 = (int)rintf(bfhi(wd[2 * h2 + 1]) * hinv);
            const unsigned pk = (unsigned)(q0 & 255) | ((unsigned)(q1 & 255) << 8) | ((unsigned)(q2 & 255) << 16) | ((unsigned)q3 << 24); if (h2 == 0) o.x = pk; else o.y = pk; }
        d[64 * j] = o; }
    if (lane == 0) *sc = hm * (1.0f / 127.0f);
}
__device__ __forceinline__ void quant_pass_p3(const bf16_t* s0, unsigned char* d0, float* c0, const bf16_t* s1, unsigned char* d1, float* c1, int G, int prow = -1) {
    const int tid = otid(), lane = tid & 63, wave = __builtin_amdgcn_readfirstlane(tid >> 6);
    const int NW = prow >= 0 ? 1 : G * NWAVES;
    for (int r0 = prow >= 0 ? prow : blockIdx.x * NWAVES + wave; r0 < MTOK; r0 += prow >= 0 ? MTOK : 4 * NW) {
        u32x4 ha[4][2], hb[4][2];
#pragma unroll
        for (int q = 0; q < 4; ++q) { const int r = (r0 + q * NW < MTOK) ? r0 + q * NW : r0;
            const u32x4* pa = (const u32x4*)(s0 + (size_t)r * 1024) + lane; const u32x4* pb = (const u32x4*)(s1 + (size_t)r * 1024) + lane;
            ha[q][0] = __builtin_nontemporal_load(pa); ha[q][1] = __builtin_nontemporal_load(pa + 64); hb[q][0] = __builtin_nontemporal_load(pb); hb[q][1] = __builtin_nontemporal_load(pb + 64); }
        asm volatile("" ::: "memory");
#pragma unroll
        for (int q = 0; q < 4; ++q) { const int r = r0 + q * NW; if (r >= MTOK) break;
            qrow1024(ha[q], d0 + (size_t)r * 1024, c0 + r, lane); qrow1024(hb[q], d1 + (size_t)r * 1024, c1 + r, lane); }
    }
}
__device__ __forceinline__ bool deal_item(int xcd, int rank, int nloc, int& si, int& k, int& slice, int& tb) {
    for (;;) {
        if (si >= 2) return false;
        const int t = rank + nloc * k;
        if (t < NTB) { slice = (2 * xcd + si) & (NSL - 1); tb = t; ++k; __syncthreads(); return true; }
        ++si; k = 0;
    }
}
__device__ __forceinline__ bool pop_item(unsigned* ctr, int xcd, int& si, int& slice, int& tb, volatile LAS int* bc) {
    for (;;) {
        if (si >= NSL) return false;
        const int s = (2 * xcd + si) & (NSL - 1);
        __syncthreads();
        if (threadIdx.x == 0) { const int pre = bc[1]; bc[0] = pre >= 0 ? pre : (int)__hip_atomic_fetch_add(ctr + 64 * s, 1u, __ATOMIC_RELAXED, __HIP_MEMORY_SCOPE_AGENT); bc[1] = -1; }
        __syncthreads();
        const int t = bc[0];
        if (t < NTB) { slice = s; tb = t;
            if (threadIdx.x == 0) bc[1] = (int)__hip_atomic_fetch_add(ctr + 64 * s, 1u, __ATOMIC_RELAXED, __HIP_MEMORY_SCOPE_AGENT);
            return true; }
        ++si;
    }
}
__device__ __forceinline__ void upass_phase(const Args& A, LAS unsigned char* lds, int G) {
    const int tid = otid(), lane = tid & 63, wave = __builtin_amdgcn_readfirstlane(tid >> 6), sub = lane >> 3, piece = lane & 7;
    unsigned char* ws = A.ws; const unsigned char* UQ = ws + WS_UE; const unsigned char* HQ = ws + WS_HQ; const int* IDX = (const int*)(ws + WS_IDX); float* AP = (float*)(ws + WS_APART);
    const bool b0 = (lane & 1) != 0, b1 = (lane & 2) != 0, b2 = (lane & 4) != 0;
    const int j0 = (b2 ? 2 : 0) + (b1 ? 4 : 0) + (b0 ? 8 : 0);
    const int xcd = (int)(xb_xcc_id() & 7u); int si = 0, slice, tb;
    volatile LAS int* bc = (volatile LAS int*)(lds + LDS_BYTES - 128);
    if (threadIdx.x == 0) bc[1] = -1;
    LAS unsigned* sidx = (LAS unsigned*)(lds + 16384 + wave * 8192);
    LAS u32x4* shq = (LAS u32x4*)(lds + 16384 + wave * 8192 + 4096);
    const int rank = (int)((volatile LAS unsigned*)(lds + LDS_BYTES - 64))[3], nloc = (int)((volatile LAS unsigned*)(lds + LDS_BYTES - 64))[0]; int kd = 0;
    while (deal_item(xcd, rank, nloc, si, kd, slice, tb)) {
        { const int t0 = tb * TBK + wave;
#pragma unroll
          for (int i = 0; i < TPW; ++i) { const unsigned v = *((const unsigned*)((const unsigned short*)IDX + (size_t)(t0 + NWAVES * i) * 128) + lane); *(LAS u32x2*)(sidx + i * 128 + 2 * lane) = (u32x2){v & 0xffffu, v >> 16}; }
          { const int i = lane >> 3, pc = lane & 7; shq[lane] = *(const u32x4*)(HQ + (size_t)(t0 + NWAVES * i) * DM + slice * SLW + 16 * pc); }
          asm volatile("s_waitcnt vmcnt(0) lgkmcnt(0)" ::: "memory"); }
#define UP_G(buf, I, H) do { const u32x4 i0_ = *(const LAS u32x4*)(sidx + (I) * 128 + 16 * sub + 8 * (H)), i1_ = *(const LAS u32x4*)(sidx + (I) * 128 + 16 * sub + 8 * (H) + 4); \
            const unsigned ex_[8] = {i0_.x, i0_.y, i0_.z, i0_.w, i1_.x, i1_.y, i1_.z, i1_.w}; \
            _Pragma("unroll") for (int j_ = 0; j_ < 8; ++j_) buf[j_] = *(const u32x4*)(UQ + ((size_t)slice * NEXP + ex_[j_]) * SLW + 16 * piece); \
            asm volatile("" ::: "memory"); } while (0)
#define UP_C(vv, buf, I) do { const u32x4 hq_ = shq[(I) * 8 + piece]; _Pragma("unroll") for (int j_ = 0; j_ < 8; ++j_) { \
            int sd_ = __builtin_amdgcn_sdot4((int)buf[j_].x, (int)hq_.x, 0, false); sd_ = __builtin_amdgcn_sdot4((int)buf[j_].y, (int)hq_.y, sd_, false); \
            sd_ = __builtin_amdgcn_sdot4((int)buf[j_].z, (int)hq_.z, sd_, false); sd_ = __builtin_amdgcn_sdot4((int)buf[j_].w, (int)hq_.w, sd_, false); vv[j_] = (float)sd_; } } while (0)
#define UP_F(I) do { float w8_[8], w4_[4], w2_[2]; \
            _Pragma("unroll") for (int q_ = 0; q_ < 8; ++q_) w8_[q_] = xs<1>(vlo[q_], vhi[q_], b0); \
            _Pragma("unroll") for (int q_ = 0; q_ < 4; ++q_) w4_[q_] = xs<2>(w8_[q_], w8_[q_ + 4], b1); \
            _Pragma("unroll") for (int q_ = 0; q_ < 2; ++q_) w2_[q_] = xs<4>(w4_[q_], w4_[q_ + 2], b2); \
            *(f32x2*)(AP + ((size_t)slice * MTOK + tb * TBK + wave + NWAVES * (I)) * 128 + 16 * sub + j0) = (f32x2){w2_[0], w2_[1]}; } while (0)
        { u32x4 bufA[8], bufB[8]; float vlo[8], vhi[8];
          UP_G(bufA, 0, 0); UP_G(bufB, 0, 1);
          UP_C(vlo, bufA, 0); UP_G(bufA, 1, 0);
          UP_C(vhi, bufB, 0); UP_G(bufB, 1, 1); UP_F(0);
          UP_C(vlo, bufA, 1); UP_G(bufA, 2, 0);
          UP_C(vhi, bufB, 1); UP_G(bufB, 2, 1); UP_F(1);
          UP_C(vlo, bufA, 2); UP_G(bufA, 3, 0);
          UP_C(vhi, bufB, 2); UP_G(bufB, 3, 1); UP_F(2);
          UP_C(vlo, bufA, 3); UP_G(bufA, 4, 0);
          UP_C(vhi, bufB, 3); UP_G(bufB, 4, 1); UP_F(3);
          UP_C(vlo, bufA, 4); UP_G(bufA, 5, 0);
          UP_C(vhi, bufB, 4); UP_G(bufB, 5, 1); UP_F(4);
          UP_C(vlo, bufA, 5); UP_G(bufA, 6, 0);
          UP_C(vhi, bufB, 5); UP_G(bufB, 6, 1); UP_F(5);
          UP_C(vlo, bufA, 6); UP_G(bufA, 7, 0);
          UP_C(vhi, bufB, 6); UP_G(bufB, 7, 1); UP_F(6);
          UP_C(vlo, bufA, 7);
          UP_C(vhi, bufB, 7); UP_F(7); }
#undef UP_G
#undef UP_C
#undef UP_F
    }
}
__device__ __forceinline__ void combine_phase(const Args& A, int G) {
    const int tid = otid(), lane = tid & 63, wave = __builtin_amdgcn_readfirstlane(tid >> 6);
    unsigned char* ws = A.ws; const float* AP = (const float*)(ws + WS_APART); const int* IDX = (const int*)(ws + WS_IDX); const float* GW = (const float*)(ws + WS_GW); bf16_t* WB = (bf16_t*)(ws + WS_WB);
    const float* SU = (const float*)(ws + WS_SU); const float* SV = (const float*)(ws + WS_SV); const float* HT = (const float*)(ws + WS_HT);
    for (int tok = blockIdx.x * NWAVES + wave; tok < MTOK; tok += G * NWAVES) {
        const float tsc = HT[tok];
#pragma unroll
        for (int hf = 0; hf < 2; ++hf) { const int k = lane + 64 * hf; float a = 0.f;
#pragma unroll
            for (int sl = 0; sl < NSL; ++sl) a += __builtin_nontemporal_load(AP + ((size_t)sl * MTOK + tok) * 128 + k);
            const int e = ((const unsigned short*)IDX)[(size_t)tok * 128 + k];
            WB[(size_t)tok * 128 + k] = (bf16_t)f2bf(GW[(size_t)tok * 128 + k] * gelu_exact(a * SU[e] * tsc) * SV[e]); }
    }
}
__device__ __forceinline__ void vpass_phase(const Args& A, LAS unsigned char* lds, int G) {
    const int tid = otid(), lane = tid & 63, wave = __builtin_amdgcn_readfirstlane(tid >> 6);
    unsigned char* ws = A.ws; const unsigned char* VQ = ws + WS_VE; const int* IDX = (const int*)(ws + WS_IDX); const bf16_t* WB = (const bf16_t*)(ws + WS_WB);
    const bf16_t* H2B = (const bf16_t*)(ws + WS_XN); float* OUT = A.out;
    const int xcd = (int)(xb_xcc_id() & 7u); int si = 0, slice, tb;
    volatile LAS int* bc = (volatile LAS int*)(lds + LDS_BYTES - 128);
    if (threadIdx.x == 0) bc[1] = -1;
    LAS unsigned* sidx = (LAS unsigned*)(lds + 16384 + wave * 8192);
    LAS float* sw = (LAS float*)(lds + 16384 + wave * 8192 + 4096);
    const int rank = (int)((volatile LAS unsigned*)(lds + LDS_BYTES - 64))[3], nloc = (int)((volatile LAS unsigned*)(lds + LDS_BYTES - 64))[0]; int kd = 0;
    while (deal_item(xcd, rank, nloc, si, kd, slice, tb)) {
        int ln = (int)threadIdx.x; asm volatile("" : "+v"(ln)); ln &= 63;
        const int sub = ln >> 3, piece = ln & 7; const bool b3 = (ln & 8) != 0, b4 = (ln & 16) != 0, b5 = (ln & 32) != 0;
        const int c0 = (b5 ? 2 : 0) + (b4 ? 4 : 0) + (b3 ? 8 : 0);
        { const int t0 = tb * TBK + wave;
#pragma unroll
          for (int i = 0; i < TPW; ++i) { const unsigned v_ = *((const unsigned*)((const unsigned short*)IDX + (size_t)(t0 + NWAVES * i) * 128) + ln); const u32x2 v = {v_ & 0xffffu, v_ >> 16}; *(LAS u32x2*)(sidx + i * 128 + 2 * ln) = v;
              const unsigned g_ = *((const unsigned*)(WB + (size_t)(t0 + NWAVES * i) * 128) + ln); *(LAS f32x2*)(sw + i * 128 + 2 * ln) = (f32x2){bflo(g_), bfhi(g_)}; }
          asm volatile("s_waitcnt vmcnt(0) lgkmcnt(0)" ::: "memory"); }
        const unsigned colb = (unsigned)(slice * SLW + 16 * piece), tabb = (unsigned)(slice * (NEXP * SLW) + 16 * piece);
#define VP_G(buf, I, H) do { const u32x4 i0_ = *(const LAS u32x4*)(sidx + (I) * 128 + 16 * sub + 8 * (H)), i1_ = *(const LAS u32x4*)(sidx + (I) * 128 + 16 * sub + 8 * (H) + 4); \
            const unsigned ex_[8] = {i0_.x, i0_.y, i0_.z, i0_.w, i1_.x, i1_.y, i1_.z, i1_.w}; \
            _Pragma("unroll") for (int j_ = 0; j_ < 8; ++j_) buf[j_] = *(const u32x4*)(VQ + (ex_[j_] * (unsigned)SLW + tabb)); \
            asm volatile("" ::: "memory"); } while (0)
#define VP_H(hv, I) do { hv = *(const unsigned*)((const unsigned char*)H2B + (((unsigned)(tb * TBK + wave + NWAVES * (I)) * (unsigned)DM + colb + c0) * 2u)); asm volatile("" ::: "memory"); } while (0)
#define VP_C(buf, I, H) do { const f32x4 w0_ = *(const LAS f32x4*)(sw + (I) * 128 + 16 * sub + 8 * (H)), w1_ = *(const LAS f32x4*)(sw + (I) * 128 + 16 * sub + 8 * (H) + 4); \
            const float wk_[8] = {w0_[0], w0_[1], w0_[2], w0_[3], w1_[0], w1_[1], w1_[2], w1_[3]}; \
            _Pragma("unroll") for (int j_ = 0; j_ < 8; ++j_) { const unsigned wd_[4] = {buf[j_].x, buf[j_].y, buf[j_].z, buf[j_].w}; \
                _Pragma("unroll") for (int d_ = 0; d_ < 4; ++d_) { const f32x2 lo_ = __builtin_amdgcn_cvt_pk_f32_fp8((int)wd_[d_], false), hi_ = __builtin_amdgcn_cvt_pk_f32_fp8((int)wd_[d_], true); \
                    acc[4 * d_] += wk_[j_] * lo_.x; acc[4 * d_ + 1] += wk_[j_] * lo_.y; acc[4 * d_ + 2] += wk_[j_] * hi_.x; acc[4 * d_ + 3] += wk_[j_] * hi_.y; } } } while (0)
#define VP_F(hv, I) do { float w8_[8], w4_[4], w2_[2]; \
            _Pragma("unroll") for (int q_ = 0; q_ < 8; ++q_) w8_[q_] = xsl<8>(acc[q_], acc[q_ + 8], b3, ln); \
            _Pragma("unroll") for (int q_ = 0; q_ < 4; ++q_) w4_[q_] = xsl<16>(w8_[q_], w8_[q_ + 4], b4, ln); \
            _Pragma("unroll") for (int q_ = 0; q_ < 2; ++q_) w2_[q_] = xsl<32>(w4_[q_], w4_[q_ + 2], b5, ln); \
            *(f32x2*)((unsigned char*)OUT + (((unsigned)(tb * TBK + wave + NWAVES * (I)) * (unsigned)DM + colb + c0) * 4u)) = (f32x2){bflo(hv) + w2_[0], bfhi(hv) + w2_[1]}; \
            _Pragma("unroll") for (int c_ = 0; c_ < 16; ++c_) acc[c_] = 0.f; } while (0)
        { u32x4 bufA[8], bufB[8]; unsigned hv; float acc[16];
#pragma unroll
          for (int c = 0; c < 16; ++c) acc[c] = 0.f;
          VP_G(bufA, 0, 0); VP_G(bufB, 0, 1);
          VP_C(bufA, 0, 0); VP_G(bufA, 1, 0);
          VP_C(bufB, 0, 1); VP_H(hv, 0); VP_G(bufB, 1, 1); VP_F(hv, 0);
          VP_C(bufA, 1, 0); VP_G(bufA, 2, 0);
          VP_C(bufB, 1, 1); VP_H(hv, 1); VP_G(bufB, 2, 1); VP_F(hv, 1);
          VP_C(bufA, 2, 0); VP_G(bufA, 3, 0);
          VP_C(bufB, 2, 1); VP_H(hv, 2); VP_G(bufB, 3, 1); VP_F(hv, 2);
          VP_C(bufA, 3, 0); VP_G(bufA, 4, 0);
          VP_C(bufB, 3, 1); VP_H(hv, 3); VP_G(bufB, 4, 1); VP_F(hv, 3);
          VP_C(bufA, 4, 0); VP_G(bufA, 5, 0);
          VP_C(bufB, 4, 1); VP_H(hv, 4); VP_G(bufB, 5, 1); VP_F(hv, 4);
          VP_C(bufA, 5, 0); VP_G(bufA, 6, 0);
          VP_C(bufB, 5, 1); VP_H(hv, 5); VP_G(bufB, 6, 1); VP_F(hv, 5);
          VP_C(bufA, 6, 0); VP_G(bufA, 7, 0);
          VP_C(bufB, 6, 1); VP_H(hv, 6); VP_G(bufB, 7, 1); VP_F(hv, 6);
          VP_C(bufA, 7, 0);
          VP_C(bufB, 7, 1); VP_H(hv, 7); VP_F(hv, 7); }
#undef VP_G
#undef VP_H
#undef VP_C
#undef VP_F
    }
}
}


#ifndef GATHER_VER
#define GATHER_VER 2
#endif
constexpr int NPHASE = (GATHER_VER == 2) ? 10 : 8;
__global__ void __launch_bounds__(NTHREADS, 2) mega_fwd(Args args) {
    extern __shared__ __attribute__((aligned(16))) unsigned char lds_raw[];
    LAS unsigned char* lds = (LAS unsigned char*)lds_raw;
    const int G = gridDim.x;
    unsigned char* ws = args.ws;
    const int lo = args.ph_lo, hi = args.ph_hi;
#ifndef PHASE_MASK
#define PHASE_MASK 0x3FF
#endif
#ifndef REPEAT_MASK
#define REPEAT_MASK 0x00
#endif
#define NREP(k) (((REPEAT_MASK >> (k)) & 1) ? 2 : 1)
#define IN(k) (lo <= (k) && (k) < hi && ((PHASE_MASK >> (k)) & 1))
#ifndef CG_SEAMS
#define CG_SEAMS 0
#endif
    volatile LAS unsigned* xst = (volatile LAS unsigned*)(lds + LDS_BYTES - 64);
    if (threadIdx.x < 4) xst[threadIdx.x] = 0u;
    __syncthreads();
    XcdBarrier xbar = xcd_barrier_post((unsigned*)(ws + WS_CTL) + 64, xst);
#define SEAM_IN(k) do { if (IN(k)) { if (CG_SEAMS) cg::this_grid().sync(); else xcd_barrier(xbar); } } while (0)
#define SEAM(k) do { if (IN(k) && IN((k) + 1)) { if (CG_SEAMS) cg::this_grid().sync(); else xcd_barrier(xbar); } } while (0)
    if (IN(0)) for (int rep_ = 0; rep_ < NREP(0); ++rep_) { p0_prologue<0>(args, lds, G, args.probe); }
    SEAM(0);
    if (IN(1)) for (int rep_ = 0; rep_ < NREP(1); ++rep_) {
        p1_meta_finish(args, lds, G);
        __syncthreads();
        pg8::Gemm g{(const bf16_t*)(ws + WS_XN), (const bf16_t*)(ws + WS_WTIN), MTOK, INW, DM / 2, nullptr, nullptr, (const float*)(ws + WS_SXA), (const float*)(ws + WS_SWB)}; pg8::StaticOrder S; S.init(MTOK, INW, G, (int)blockIdx.x);
        Epi1 E{(bf16_t*)(ws + WS_Q), (bf16_t*)(ws + WS_K), (bf16_t*)(ws + WS_V), (bf16_t*)(ws + WS_GA), (bf16_t*)(ws + WS_GB), nullptr, (const float*)(ws + WS_CS), args.in[I_QNG], args.in[I_KNG], (bf16_t*)(ws + WS_UB)};
        pg8::gemm_phase<Epi1, pg8::StaticOrder, true, GEMM_SP2>(lds, g, S, E);
    }
    SEAM(1);
    if (IN(2)) for (int rep_ = 0; rep_ < NREP(2); ++rep_) {
#ifndef REP_SSM
#define REP_SSM 1
#endif
#ifndef REP_ATT
#define REP_ATT 1
#endif
        if (args.probe == 0 && blockIdx.x >= 128) p0_prologue<1>(args, lds, G, 0);
        if (args.probe != 2) for (int q_ = 0; q_ < REP_SSM; ++q_) ssm::ssm_mm_phase(args, lds, G, args.probe);
        __syncthreads();
        if (args.probe == 0 || args.probe == 2) for (int q_ = 0; q_ < REP_ATT; ++q_) att::attn_phase(args, lds, G);
    }
    SEAM(2);
    const unsigned nlocp = xst[0], rkp = xst[3], xcp = xbar.x & 7u; const bool panel = (G == 256 && nlocp == 32u && xst[1] == 8u && !CG_SEAMS);
    const int prow = panel ? (int)(xcp * 1024u + rkp * 32u) + 4 * (int)(threadIdx.x >> 6) : -1;
    unsigned* const lcnt = (unsigned*)(ws + WS_CTL) + 4096 + 64 * (4u * xcp + (rkp >> 3));
    if (IN(3)) {
        sg::quant_pass_p3((const bf16_t*)(ws + WS_YS), ws + WS_YS8, (float*)(ws + WS_SYS), (const bf16_t*)(ws + WS_ATT), ws + WS_AT8, (float*)(ws + WS_SAT), G, prow);
        if (panel) xcc_local_barrier(lcnt, 8u, (unsigned*)(ws + WS_CTL) + 64); else SEAM_IN(3);
    }
    if (IN(3)) for (int rep_ = 0; rep_ < NREP(3); ++rep_) {
        pg8::Gemm g{(const bf16_t*)(ws + WS_YS8), (const bf16_t*)(ws + WS_WTGLU), MTOK, 2 * DM, SW / 2, (const bf16_t*)(ws + WS_AT8), (const bf16_t*)(ws + WS_WTATT),
                    (const float*)(ws + WS_SYS), (const float*)(ws + WS_SWG), (const float*)(ws + WS_SAT), (const float*)(ws + WS_SWA)};
        pg8::P3Order S; S.base.base.init(MTOK, DM, G, (int)blockIdx.x); S.base.panel = panel ? 1 : 0; S.base.pm = (int)(4u * xcp + (rkp >> 3)); S.base.pn = (int)(rkp & 7u);
        EpiP3 E{EpiGlu{(const bf16_t*)(ws + WS_GB), (bf16_t*)(ws + WS_YB)}, EpiMix{(const bf16_t*)(ws + WS_GA), (const bf16_t*)(ws + WS_YB), (bf16_t*)(ws + WS_MIX)}};
        pg8::gemm_phase<EpiP3, pg8::P3Order, true, GEMM_SP2>(lds, g, S, E);
    }
    if (panel) { if (IN(3) && IN(4)) xcc_local_barrier(lcnt, 8u, (unsigned*)(ws + WS_CTL) + 64); } else SEAM(3);
    if (IN(4)) { sg::quant_pass<DM>((const bf16_t*)(ws + WS_MIX), ws + WS_MIX8, (float*)(ws + WS_SMX), G, prow); if (panel) xcc_local_barrier(lcnt, 8u, (unsigned*)(ws + WS_CTL) + 64); else SEAM_IN(4); }
    if (IN(4)) for (int rep_ = 0; rep_ < NREP(4); ++rep_) {
        pg8::Gemm g{(const bf16_t*)(ws + WS_MIX8), (const bf16_t*)(ws + WS_WTOUT), MTOK, DM, DM / 2, nullptr, nullptr, (const float*)(ws + WS_SMX), (const float*)(ws + WS_SWO)}; pg8::PanelOrder S; S.base.init(MTOK, DM, G, (int)blockIdx.x); S.panel = panel ? 1 : 0; S.pm = (int)(4u * xcp + (rkp >> 3)); S.pn = (int)(rkp & 7u);
        EpiOut E{args.in[I_X], (bf16_t*)(ws + WS_XN), (float*)(ws + WS_PARTSS)};
        pg8::gemm_phase<EpiOut, pg8::PanelOrder, true, GEMM_SP2>(lds, g, S, E);
    }
    if (panel) { if (IN(4) && IN(5)) xcc_local_barrier(lcnt, 8u, (unsigned*)(ws + WS_CTL) + 64); } else SEAM(4);
    if (IN(6)) { sg::quant_rows(args, G, prow); }
    if (panel) { if (IN(5) && IN(6)) xcc_local_barrier(lcnt, 8u, (unsigned*)(ws + WS_CTL) + 64); } else SEAM(5);
    if (IN(5)) for (int rep_ = 0; rep_ < NREP(5); ++rep_) {
        pg8::Gemm g{(const bf16_t*)(ws + WS_HQ), (const bf16_t*)(ws + WS_WTQ), MTOK, DM, DM / 2, nullptr, nullptr, (const float*)(ws + WS_HT), (const float*)(ws + WS_SWQ)}; pg8::PanelOrder S; S.base.init(MTOK, DM, G, (int)blockIdx.x); S.panel = panel ? 1 : 0; S.pm = (int)(4u * xcp + (rkp >> 3)); S.pn = (int)(rkp & 7u);
        const bool qlds = (G == MTOK / 256 * (DM / 256));
        EpiQP E{(bf16_t*)(ws + WS_QP), lds, qlds};
        pg8::gemm_phase<EpiQP, pg8::PanelOrder, true, GEMM_SP2>(lds, g, S, E);
        asm volatile("s_waitcnt vmcnt(0)" ::: "memory");
        __syncthreads();
        tk::peer_topk_phase(args, lds, G, qlds, S);
    }
    SEAM(6);
#if GATHER_VER == 2
    if (IN(7)) { sg::upass_phase(args, lds, G); }
    SEAM(7);
    if (IN(8)) for (int rep_ = 0; rep_ < NREP(8); ++rep_) { sg::combine_phase(args, G); }
    SEAM(8);
    if (IN(9)) { sg::vpass_phase(args, lds, G); }
#endif
#undef IN
#undef SEAM
}

extern "C" void kernel_launch(void* const* d_in, const int* in_sizes, int n_in, void* d_out, int out_size, void* d_ws, size_t ws_size, hipStream_t stream) {
    static int grid = 0;
    if (grid == 0) {
        if (n_in != 28 || out_size != MTOK * DM || ws_size < WS_END) { fprintf(stderr, "kernel_launch: unexpected problem (n_in %d out %d ws %zu, need %zu)\n", n_in, out_size, ws_size, (size_t)WS_END); grid = -1; return; }
        int dev = 0, cus = 0, per_cu = 0;
        (void)hipGetDevice(&dev); (void)hipDeviceGetAttribute(&cus, hipDeviceAttributeMultiprocessorCount, dev);
        if (hipFuncSetAttribute((const void*)mega_fwd, hipFuncAttributeMaxDynamicSharedMemorySize, LDS_BYTES) != hipSuccess) { fprintf(stderr, "kernel_launch: hipFuncSetAttribute failed\n"); grid = -1; return; }
        (void)hipOccupancyMaxActiveBlocksPerMultiprocessor(&per_cu, (const void*)mega_fwd, NTHREADS, LDS_BYTES);
        (void)hipGetLastError();
        if (per_cu < 1) { fprintf(stderr, "kernel_launch: occupancy query says %d blocks/CU\n", per_cu); per_cu = 1; }
        if (cus < 192) { fprintf(stderr, "kernel_launch: needs >= 192 CUs (SSM items on workgroups 0..127, deferred prologue work on the rest)\n"); grid = -1; return; }
        grid = cus;
        fprintf(stderr, "kernel_launch: grid %d (cus %d, per_cu %d), ws %zu MiB\n", grid, cus, per_cu, ws_size >> 20);
    }
    if (grid < 0) return;
    if (hipMemsetAsync((char*)d_ws + WS_CTL, 0, 64 * 1024, stream) != hipSuccess) { fprintf(stderr, "kernel_launch: memset of the control words failed\n"); return; }
    Args a{};
    for (int i = 0; i < 28; ++i) a.in[i] = (const float*)d_in[i];
    a.out = (float*)d_out; a.ws = (unsigned char*)d_ws;
#if MK_SINGLE
    a.ph_lo = 0; a.ph_hi = NPHASE;
    void* kargs[] = {&a};
    hipError_t e = hipLaunchCooperativeKernel((const void*)mega_fwd, dim3(grid), dim3(NTHREADS), kargs, LDS_BYTES, stream);
    if (e != hipSuccess) fprintf(stderr, "cooperative launch failed: %s (grid %d)\n", hipGetErrorString(e), grid);
#else
#ifndef PROBE_PHASE
#define PROBE_PHASE -1
#endif
    for (int p = 0; p < NPHASE; ++p) {
        a.ph_lo = p; a.ph_hi = p + 1;
#ifndef PROBE_SUB
#define PROBE_SUB 0
#endif
        for (int rep = 0; rep < (p == PROBE_PHASE ? 2 : 1); ++rep) { a.probe = (rep == 1) ? PROBE_SUB : 0;
            if (rep == 1) (void)hipMemsetAsync((char*)d_ws + WS_CTL + 32768, 0, 16384, stream);
            hipLaunchKernelGGL(mega_fwd, dim3(grid), dim3(NTHREADS), LDS_BYTES, stream, a); }
    }
#endif
}
```
